# Optimizing an MI355X kernel written in HIP

```python
import math
import jax
import jax.numpy as jnp
from jax import lax
import numpy as np

D_MODEL = 2048
BATCH = 4
SEQ = 2048
DEPTH = 2

CTX_LEN = 256
GRID_W = 64

HEAD_DIM = D_MODEL // 16
HY_GROUPS = 4
NA_HEADS = 6
GLA_HEADS = 6
HY_CH = HY_GROUPS * HEAD_DIM
NA_DIM = NA_HEADS * HEAD_DIM
GLA_DK = HEAD_DIM // 2
GLA_DV = HEAD_DIM
GLA_K = GLA_HEADS * GLA_DK
GLA_V = GLA_HEADS * GLA_DV
MIX_DIM = HY_CH + NA_DIM + GLA_V

SHORT_CONV = 3
HY_EMB_BANDS = 16
HY_EMB_DIM = 1 + 2 * HY_EMB_BANDS
HY_FILTER_WIDTH = 64
HY_DECAY_TARGET = 1e-2
HY_FAST_DECAY = 0.3
HY_SLOW_DECAY = 1.5
HY_MIN_DECAY = math.log(HY_DECAY_TARGET) / HY_SLOW_DECAY
HY_MAX_DECAY = math.log(HY_DECAY_TARGET) / HY_FAST_DECAY

NA_WIN_ROWS = 8
NA_WIN_COLS = 16
NEG_INF = -1e30

GLA_RANK = 16
GLA_GATE_NORM = 16.0
GLA_CHUNK = 64
ROPE_BASE = 10000.0

N_GROUPS = 4
EXPERTS_PER_GROUP = 8
TOP_K_IN_GROUP = 2
D_EXPERT = D_MODEL // 4

ALPHA = (2 * DEPTH) ** 0.25
BETA = (8 * DEPTH) ** -0.25
LN_EPS = 1e-6

IN_SPLITS = (3 * HY_CH, NA_DIM, NA_DIM, NA_DIM, GLA_K, GLA_K, GLA_V, GLA_V, 2 * GLA_RANK)
IN_COLS = sum(IN_SPLITS)

kernel_name = 'hybrid_hyena_natten_gla_hmoe_prefix_dit'


def layer_norm(x, g=None, b=None):
    xf = x.astype(jnp.float32)
    mu = jnp.mean(xf, axis=-1, keepdims=True)
    xc = xf - mu
    y = xc * lax.rsqrt(jnp.mean(xc * xc, axis=-1, keepdims=True) + LN_EPS)
    if g is not None:
        y = y * g.astype(jnp.float32) + b.astype(jnp.float32)
    return y.astype(x.dtype)


def rms_norm(x, w):
    xf = x.astype(jnp.float32)
    y = xf * lax.rsqrt(jnp.mean(xf * xf, axis=-1, keepdims=True) + LN_EPS) * w.astype(jnp.float32)
    return y.astype(x.dtype)


def split_columns(p):
    idx = [int(i) for i in np.cumsum(IN_SPLITS)[:-1]]
    return jnp.split(p, idx, axis=-1)


def to_heads(x, dh):
    b, l, _ = x.shape
    return x.reshape(b, l, -1, dh).transpose(0, 2, 1, 3)


def short_conv(u, w, b):
    l = u.shape[1]
    pad = SHORT_CONV // 2
    up = jnp.pad(u, ((0, 0), (pad, pad), (0, 0)))
    out = up[:, 0:l] * w[0]
    for j in range(1, SHORT_CONV):
        out = out + up[:, j:j + l] * w[j]
    return out + b


def hyena_filter(l, w1, b1, w2, b2, w3, sin_freq):
    f32 = jnp.float32
    n = jnp.arange(l, dtype=f32)
    t = n / max(l - 1, 1)
    bands = jnp.linspace(1e-4, HY_EMB_BANDS - 1, HY_EMB_BANDS, dtype=f32)
    ang = (2.0 * math.pi / l) * n[:, None] * bands[None, :]
    z = jnp.concatenate([t[:, None], jnp.cos(ang), -jnp.sin(ang)], axis=-1)
    fr = sin_freq.astype(f32)
    hid = jnp.sin(fr * (z @ w1.astype(f32) + b1.astype(f32)))
    hid = jnp.sin(fr * (hid @ w2.astype(f32) + b2.astype(f32)))
    h = (hid @ w3.astype(f32)).reshape(l, 2, HY_CH)
    deltas = jnp.abs(jnp.linspace(HY_MIN_DECAY, HY_MAX_DECAY, HY_CH, dtype=f32))
    h = h * jnp.exp(-t[:, None, None] * deltas)
    h_fwd = h[:, 0].T
    h_bwd = h[:, 1].T
    return jnp.concatenate([h_fwd, jnp.zeros((HY_CH, 1), f32), h_bwd[:, :0:-1]], axis=1)


def bidir_long_conv(u, k_circ, bias):
    l = u.shape[1]
    uf = u.astype(jnp.float32)
    u_f = jnp.fft.rfft(uf, n=2 * l, axis=1)
    k_f = jnp.fft.rfft(k_circ, axis=-1).T
    y = jnp.fft.irfft(u_f * k_f, n=2 * l, axis=1)[:, :l]
    return (y + uf * bias.astype(jnp.float32)).astype(u.dtype)


def hyena_branch(u, short_w, short_b, f_w1, f_b1, f_w2, f_b2, f_w3, sin_freq, bias):
    l = u.shape[1]
    u = short_conv(u, short_w, short_b)
    x0, x1, v = jnp.split(u, 3, axis=-1)
    k = hyena_filter(l, f_w1, f_b1, f_w2, f_b2, f_w3, sin_freq)
    return x0 * bidir_long_conv(x1 * v, k, bias)


def na_latent(q, k, v, k_ctx, v_ctx, rpb):
    b, l, _ = q.shape
    lc = k_ctx.shape[1]
    rows_n = l // GRID_W
    wr = min(NA_WIN_ROWS, rows_n)
    wc = NA_WIN_COLS
    scale = HEAD_DIM ** -0.5
    q = q.reshape(b, rows_n, GRID_W, NA_HEADS, HEAD_DIM) * scale
    k = k.reshape(b, rows_n, GRID_W, NA_HEADS, HEAD_DIM)
    v = v.reshape(b, rows_n, GRID_W, NA_HEADS, HEAD_DIM)
    k_ctx = k_ctx.reshape(b, lc, NA_HEADS, HEAD_DIM)
    v_ctx = v_ctx.reshape(b, lc, NA_HEADS, HEAD_DIM)
    r = jnp.arange(rows_n)
    r0 = jnp.clip(r - wr // 2, 0, rows_n - wr)
    rows = r0[:, None] + jnp.arange(wr)[None, :]
    col = jnp.arange(GRID_W)
    c0 = jnp.clip(col - wc // 2, 0, GRID_W - wc)
    col_ok = (col[None, :] >= c0[:, None]) & (col[None, :] < c0[:, None] + wc)
    k_blk = k[:, rows]
    v_blk = v[:, rows]
    s_loc = jnp.einsum('brqhd,brikhd->bhrqik', q, k_blk).astype(jnp.float32)
    rel_r = rows - r[:, None] + (NA_WIN_ROWS - 1)
    rel_c = jnp.clip(col[None, :] - col[:, None] + (wc - 1), 0, 2 * wc - 2)
    bias = rpb.astype(jnp.float32)[:, rel_r[:, None, :, None], rel_c[None, :, None, :]]
    s_loc = jnp.where(col_ok[None, None, None, :, None, :], s_loc + bias, NEG_INF)
    s_loc = s_loc.reshape(b, NA_HEADS, rows_n, GRID_W, wr * GRID_W)
    s_ctx = jnp.einsum('brqhd,bkhd->bhrqk', q, k_ctx).astype(jnp.float32)
    p = jax.nn.softmax(jnp.concatenate([s_loc, s_ctx], axis=-1), axis=-1).astype(v.dtype)
    p_loc = p[..., :wr * GRID_W].reshape(b, NA_HEADS, rows_n, GRID_W, wr, GRID_W)
    p_ctx = p[..., wr * GRID_W:]
    o = (jnp.einsum('bhrqik,brikhd->brqhd', p_loc, v_blk)
         + jnp.einsum('bhrqk,bkhd->brqhd', p_ctx, v_ctx))
    return o.reshape(b, l, NA_DIM)


def na_context(q, k, v):
    b, l, _ = q.shape
    q = q.reshape(b, l, NA_HEADS, HEAD_DIM) * (HEAD_DIM ** -0.5)
    k = k.reshape(b, l, NA_HEADS, HEAD_DIM)
    v = v.reshape(b, l, NA_HEADS, HEAD_DIM)
    s = jnp.einsum('bqhd,bkhd->bhqk', q, k).astype(jnp.float32)
    p = jax.nn.softmax(s, axis=-1).astype(v.dtype)
    return jnp.einsum('bhqk,bkhd->bqhd', p, v).reshape(b, l, NA_DIM)


def rope_2d(x, rows, cols):
    half = x.shape[-1] // 2
    quarter = half // 2
    inv = ROPE_BASE ** (-jnp.arange(quarter, dtype=jnp.float32) / quarter)

    def rot(xa, pos):
        ang = pos[:, None] * inv[None, :]
        cos = jnp.cos(ang).astype(x.dtype)
        sin = jnp.sin(ang).astype(x.dtype)
        x1, x2 = xa[..., :quarter], xa[..., quarter:]
        return jnp.concatenate([x1 * cos - x2 * sin, x1 * sin + x2 * cos], axis=-1)

    return jnp.concatenate([rot(x[..., :half], rows), rot(x[..., half:], cols)], axis=-1)


def gla_log_decay(a_lr, w2, b):
    outs = []
    for d in range(2):
        z = a_lr[..., d * GLA_RANK:(d + 1) * GLA_RANK] @ w2[d] + b[d]
        outs.append(to_heads(jax.nn.log_sigmoid(z.astype(jnp.float32)) / GLA_GATE_NORM, GLA_DK))
    return outs[0], outs[1]


def gla_scan(q, k, v, log_a, h0):
    b, h, l, _ = k.shape
    dv = v.shape[-1]
    n = l // GLA_CHUNK

    def chunks(a):
        return jnp.moveaxis(a.astype(jnp.float32).reshape(b, h, n, GLA_CHUNK, a.shape[-1]), 2, 0)

    with_out = q is not None
    causal = jnp.tril(jnp.ones((GLA_CHUNK, GLA_CHUNK), dtype=bool))
    xs = (chunks(k), chunks(v), chunks(log_a)) + ((chunks(q),) if with_out else ())

    def step(state, xs_i):
        k_i, v_i, a_i = xs_i[0], xs_i[1], xs_i[2]
        cum = jnp.cumsum(a_i, axis=-2)
        cum_last = cum[..., -1:, :]
        new_state = (state * jnp.exp(cum_last)[..., 0, :, None]
                     + jnp.einsum('bhck,bhcv->bhkv', k_i * jnp.exp(cum_last - cum), v_i))
        if not with_out:
            return new_state, None
        q_i = xs_i[3]
        diff = cum[..., :, None, :] - cum[..., None, :, :]
        decay = jnp.exp(jnp.where(causal[:, :, None], diff, -jnp.inf))
        att = jnp.einsum('bhtk,bhsk,bhtsk->bhts', q_i, k_i, decay)
        o = (jnp.einsum('bhck,bhkv->bhcv', q_i * jnp.exp(cum), state)
             + jnp.einsum('bhts,bhsv->bhtv', att, v_i))
        return new_state, o

    state, o = lax.scan(step, h0, xs)
    if with_out:
        o = jnp.moveaxis(o, 0, 2).reshape(b, h, l, dv).astype(v.dtype)
    return o, state


def gla_output(o, g, norm_w):
    b, _, l, _ = o.shape
    o = rms_norm(o.transpose(0, 2, 1, 3), norm_w).reshape(b, l, GLA_V)
    return o * jax.nn.silu(g)


def token_mixers(h, hc, w_in, hy_short_w, hy_short_b, hy_f_w1, hy_f_b1, hy_f_w2, hy_f_b2, hy_f_w3,
                 hy_sin_freq, hy_bias, hy_norm_w, na_rpb, na_norm_w, gla_a_w2, gla_a_b, gla_norm_w,
                 w_out, ctx_out):
    hy_l, nq_l, nk_l, nv_l, gq_l, gk_l, gv_l, gg_l, ga_l = split_columns(h @ w_in)
    hy_c, nq_c, nk_c, nv_c, gq_c, gk_c, gv_c, gg_c, ga_c = split_columns(hc @ w_in)
    hy_args = (hy_short_w, hy_short_b, hy_f_w1, hy_f_b1, hy_f_w2, hy_f_b2, hy_f_w3, hy_sin_freq, hy_bias)

    y_a = hyena_branch(hy_l, *hy_args)
    y_b = na_latent(nq_l, nk_l, nv_l, nk_c, nv_c, na_rpb)
    b, l, _ = h.shape
    t = jnp.arange(l)
    rows = (t // GRID_W).astype(jnp.float32)
    cols = (t % GRID_W).astype(jnp.float32)
    qs = GLA_DK ** -0.5
    q = rope_2d(to_heads(gq_l * qs, GLA_DK), rows, cols)
    k = rope_2d(to_heads(gk_l, GLA_DK), rows, cols)
    v = to_heads(gv_l, GLA_DV)
    la_f, la_b = gla_log_decay(ga_l, gla_a_w2, gla_a_b)
    k_c = to_heads(gk_c, GLA_DK)
    v_c = to_heads(gv_c, GLA_DV)
    la_fc, la_bc = gla_log_decay(ga_c, gla_a_w2, gla_a_b)
    q_c = to_heads(gq_c * qs, GLA_DK) if ctx_out else None
    q_cb = jnp.flip(q_c, 2) if ctx_out else None
    h0 = jnp.zeros((b, GLA_HEADS, GLA_DK, GLA_DV), jnp.float32)
    o_cf, s_f = gla_scan(q_c, k_c, v_c, la_fc, h0)
    o_cb, s_b = gla_scan(q_cb, jnp.flip(k_c, 2), jnp.flip(v_c, 2), jnp.flip(la_bc, 2), h0)
    o_f, _ = gla_scan(q, k, v, la_f, s_f)
    o_b, _ = gla_scan(jnp.flip(q, 2), jnp.flip(k, 2), jnp.flip(v, 2), jnp.flip(la_b, 2), s_b)
    y_c = gla_output(o_f + jnp.flip(o_b, 2), gg_l, gla_norm_w)

    y = jnp.concatenate([rms_norm(y_a, hy_norm_w), rms_norm(y_b, na_norm_w), y_c], axis=-1) @ w_out
    if not ctx_out:
        return y, None
    yc_a = hyena_branch(hy_c, *hy_args)
    yc_b = na_context(nq_c, nk_c, nv_c)
    yc_c = gla_output(o_cf + jnp.flip(o_cb, 2), gg_c, gla_norm_w)
    yc = jnp.concatenate([rms_norm(yc_a, hy_norm_w), rms_norm(yc_b, na_norm_w), yc_c], axis=-1) @ w_out
    return y, yc


def hier_moe(h, w_rg, b_rg, w_re, b_re, w_up, w_down):
    n = h.shape[0]
    p_group = jax.nn.softmax((h @ w_rg).astype(jnp.float32) + b_rg.astype(jnp.float32), axis=-1)
    top_pg, gidx = lax.top_k(p_group, 1)
    gsel = jax.nn.one_hot(gidx[:, 0], N_GROUPS, dtype=jnp.float32)
    le = ((h @ w_re).astype(jnp.float32) + b_re.astype(jnp.float32)).reshape(n, N_GROUPS, EXPERTS_PER_GROUP)
    le_sel = jnp.einsum('nge,ng->ne', le, gsel)
    top_v, eidx = lax.top_k(le_sel, TOP_K_IN_GROUP)
    w_sel = jax.nn.softmax(top_v, axis=-1) * top_pg
    e_gate = jnp.einsum('nke,nk->ne', jax.nn.one_hot(eidx, EXPERTS_PER_GROUP, dtype=jnp.float32), w_sel)
    gate = (gsel[:, :, None] * e_gate[:, None, :]).astype(h.dtype)
    out = jnp.zeros_like(h)
    for gi in range(N_GROUPS):
        gu = jnp.einsum('nd,edf->nef', h, w_up[gi])
        act = jax.nn.silu(gu[..., :D_EXPERT]) * gu[..., D_EXPERT:]
        out = out + jnp.einsum('nef,efd->nd', act * gate[:, gi, :, None], w_down[gi])
    return out


def trunk_layer(x, xc, c, c_ctx, w_ada, b_ada, w_in, hy_short_w, hy_short_b, hy_f_w1, hy_f_b1, hy_f_w2,
                hy_f_b2, hy_f_w3, hy_sin_freq, hy_bias, hy_norm_w, na_rpb, na_norm_w, gla_a_w2, gla_a_b,
                gla_norm_w, w_out, ln1_g, ln1_b, w_rg, b_rg, w_re, b_re, w_up, w_down, ln2_g, ln2_b, last):
    d = x.shape[-1]
    mod = jax.nn.silu(c) @ w_ada + b_ada
    mod_c = jax.nn.silu(c_ctx) @ w_ada + b_ada
    sh1, sc1, g1, sh2, sc2, g2 = [m[:, None, :] for m in jnp.split(mod, 6, axis=-1)]
    sh1c, sc1c, g1c, sh2c, sc2c, g2c = jnp.split(mod_c, 6)

    h = layer_norm(x) * (1 + sc1) + sh1
    hc = layer_norm(xc) * (1 + sc1c) + sh1c
    y, yc = token_mixers(h, hc, w_in, hy_short_w, hy_short_b, hy_f_w1, hy_f_b1, hy_f_w2, hy_f_b2, hy_f_w3,
                         hy_sin_freq, hy_bias, hy_norm_w, na_rpb, na_norm_w, gla_a_w2, gla_a_b, gla_norm_w,
                         w_out, not last)
    x = layer_norm(ALPHA * x + g1 * y, ln1_g, ln1_b)
    h2 = layer_norm(x) * (1 + sc2) + sh2
    b, l, _ = x.shape
    if last:
        f = hier_moe(h2.reshape(b * l, d), w_rg, b_rg, w_re, b_re, w_up, w_down).reshape(b, l, d)
        return layer_norm(ALPHA * x + g2 * f, ln2_g, ln2_b), xc
    xc = layer_norm(ALPHA * xc + g1c * yc, ln1_g, ln1_b)
    h2c = layer_norm(xc) * (1 + sc2c) + sh2c
    lc = xc.shape[1]
    f_all = hier_moe(jnp.concatenate([h2.reshape(b * l, d), h2c.reshape(b * lc, d)], axis=0),
                     w_rg, b_rg, w_re, b_re, w_up, w_down)
    f = f_all[:b * l].reshape(b, l, d)
    fc = f_all[b * l:].reshape(b, lc, d)
    x = layer_norm(ALPHA * x + g2 * f, ln2_g, ln2_b)
    xc = layer_norm(ALPHA * xc + g2c * fc, ln2_g, ln2_b)
    return x, xc


def setup_inputs(seed: int = 0) -> dict:
    key = jax.random.key(seed)
    ks = iter(jax.random.split(key, 48))
    d = D_MODEL
    ne = N_GROUPS * EXPERTS_PER_GROUP

    def nrm(shape, scale):
        return jax.random.normal(next(ks), shape, jnp.float32) * scale

    return {
        'x': nrm((BATCH, SEQ, d), 1.0),
        'c': nrm((BATCH, d), 1.0),
        'ctx': nrm((BATCH, CTX_LEN, d), 1.0),
        'c_ctx': nrm((d,), 1.0),
        'w_ada': nrm((DEPTH, d, 6 * d), d ** -0.5),
        'b_ada': nrm((DEPTH, 6 * d), 0.01),
        'w_in': nrm((DEPTH, d, IN_COLS), d ** -0.5),
        'hy_short_w': nrm((DEPTH, SHORT_CONV, 3 * HY_CH), SHORT_CONV ** -0.5),
        'hy_short_b': nrm((DEPTH, 3 * HY_CH), 0.01),
        'hy_f_w1': nrm((DEPTH, HY_EMB_DIM, HY_FILTER_WIDTH), HY_EMB_DIM ** -0.5),
        'hy_f_b1': nrm((DEPTH, HY_FILTER_WIDTH), 0.02),
        'hy_f_w2': nrm((DEPTH, HY_FILTER_WIDTH, HY_FILTER_WIDTH), HY_FILTER_WIDTH ** -0.5),
        'hy_f_b2': nrm((DEPTH, HY_FILTER_WIDTH), 0.02),
        'hy_f_w3': nrm((DEPTH, HY_FILTER_WIDTH, 2 * HY_CH), HY_FILTER_WIDTH ** -0.5),
        'hy_sin_freq': 1.0 + nrm((DEPTH, HY_FILTER_WIDTH), 0.01),
        'hy_bias': nrm((DEPTH, HY_CH), 0.1),
        'hy_norm_w': 1.0 + nrm((DEPTH, HY_CH), 0.01),
        'na_rpb': nrm((DEPTH, NA_HEADS, 2 * NA_WIN_ROWS - 1, 2 * NA_WIN_COLS - 1), 0.02),
        'na_norm_w': 1.0 + nrm((DEPTH, NA_DIM), 0.01),
        'gla_a_w2': nrm((DEPTH, 2, GLA_RANK, GLA_K), GLA_RANK ** -0.5),
        'gla_a_b': nrm((DEPTH, 2, GLA_K), 0.01),
        'gla_norm_w': 1.0 + nrm((DEPTH, GLA_DV), 0.01),
        'w_out': nrm((DEPTH, MIX_DIM, d), MIX_DIM ** -0.5 * BETA),
        'ln1_g': 1.0 + nrm((DEPTH, d), 0.01),
        'ln1_b': nrm((DEPTH, d), 0.01),
        'w_rg': nrm((DEPTH, d, N_GROUPS), d ** -0.5),
        'b_rg': nrm((DEPTH, N_GROUPS), 0.01),
        'w_re': nrm((DEPTH, d, ne), d ** -0.5),
        'b_re': nrm((DEPTH, ne), 0.01),
        'w_up': nrm((DEPTH, N_GROUPS, EXPERTS_PER_GROUP, d, 2 * D_EXPERT), d ** -0.5),
        'w_down': nrm((DEPTH, N_GROUPS, EXPERTS_PER_GROUP, D_EXPERT, d), D_EXPERT ** -0.5 * BETA),
        'ln2_g': 1.0 + nrm((DEPTH, d), 0.01),
        'ln2_b': nrm((DEPTH, d), 0.01),
    }


def reference(x, c, ctx, c_ctx, w_ada, b_ada, w_in, hy_short_w, hy_short_b, hy_f_w1, hy_f_b1, hy_f_w2,
              hy_f_b2, hy_f_w3, hy_sin_freq, hy_bias, hy_norm_w, na_rpb, na_norm_w, gla_a_w2, gla_a_b,
              gla_norm_w, w_out, ln1_g, ln1_b, w_rg, b_rg, w_re, b_re, w_up, w_down, ln2_g, ln2_b):
    xc = ctx
    for i in range(DEPTH):
        x, xc = trunk_layer(x, xc, c, c_ctx, w_ada[i], b_ada[i], w_in[i], hy_short_w[i], hy_short_b[i],
                            hy_f_w1[i], hy_f_b1[i], hy_f_w2[i], hy_f_b2[i], hy_f_w3[i], hy_sin_freq[i],
                            hy_bias[i], hy_norm_w[i], na_rpb[i], na_norm_w[i], gla_a_w2[i], gla_a_b[i],
                            gla_norm_w[i], w_out[i], ln1_g[i], ln1_b[i], w_rg[i], b_rg[i], w_re[i], b_re[i],
                            w_up[i], w_down[i], ln2_g[i], ln2_b[i], i == DEPTH - 1)
    return x
```

```cpp
#include <hip/hip_runtime.h>
#include <cstdio>
#include <cstdint>
#define MK_ONE_LAUNCH 1
namespace pg8 {
#define PG8_LAS __attribute__((address_space(3)))
typedef unsigned short bf16_t;
typedef short bf16x8 __attribute__((ext_vector_type(8)));
typedef float f32x4 __attribute__((ext_vector_type(4)));
typedef unsigned u32x4 __attribute__((ext_vector_type(4)));
constexpr int BM = 256, BK = 64, HALF = 128, HTB = HALF * BK * 2  , STAGE_BYTES = 8 * HTB, NXCD = 8, WGM = 8;

__host__ __device__ __forceinline__ int lds_byte(int r, int c) { const int st = (r >> 4) * 2 + (c >> 5), rr = r & 15, cc = c & 31, ob = rr * 64 + cc * 2; return st * 1024 + (ob ^ (((ob >> 9) & 1) << 5)); }
__host__ __device__ __forceinline__ void stage_rc(int b, int& R, int& C) { const int st = b / 1024, sb = b % 1024, swz = sb ^ (((sb >> 9) & 1) << 5); R = (st >> 1) * 16 + swz / 64; C = (st & 1) * 32 + (swz % 64) / 2; }
__host__ __device__ __forceinline__ int perm32(int rho) { const int n = rho >> 4, i = rho & 15; return 8 * (i >> 2) + 4 * n + (i & 3); }

struct Unit { int pm, pn; };
struct Gemm { const bf16_t* A; const bf16_t* Bt; int M, N, K; };

struct StaticOrder {
    int nM, nN, nwg, G, c;
    __host__ __device__ void init(int M, int N, int G_, int c_) { nM = M / BM; nN = N / BM; nwg = nM * nN; G = G_; c = c_; }
    __host__ __device__ bool next(int i, Unit& u) const {
        const long L = (long)i * G + c; if (L >= nwg) return false;
        int wgid = (int)L; { const int q = nwg / NXCD, r = nwg % NXCD, xcd = wgid % NXCD, off = wgid / NXCD; wgid = (xcd < r ? xcd * (q + 1) : r * (q + 1) + (xcd - r) * q) + off; }
        const int nig = WGM * nN, gid = wgid / nig, fm = gid * WGM, gsz = (nM - fm) < WGM ? (nM - fm) : WGM;
        u.pm = fm + ((wgid % nig) % gsz); u.pn = (wgid % nig) / gsz; return true;
    }
    __device__ __forceinline__ void a_ready(const Unit&) const {}
    __device__ __forceinline__ void done(const Unit&) const {}
};
__device__ __forceinline__ unsigned cvt_pk_bf16(float lo, float hi) { unsigned r; asm volatile("v_cvt_pk_bf16_f32 %0, %1, %2" : "=v"(r) : "v"(lo), "v"(hi)); return r; }
typedef float f32x2 __attribute__((ext_vector_type(2)));
struct EpiBf16P {
    static constexpr bool PERM = true, AFTER_DRAIN = false;
    bf16_t* O; int ldc;
    __device__ __forceinline__ void operator()(const f32x4 (&acc)[2][2][4][2], const Unit& u, int wr, int wc, int fr, int fq) const {
        const int row0 = u.pm * BM + wr * 64 + fr, col0 = u.pn * BM + wc * 32 + 8 * fq;
        bf16_t* Ob = O; asm volatile("" : "+s"(Ob));
#pragma unroll
        for (int ai = 0; ai < 2; ++ai)
#pragma unroll
            for (int m = 0; m < 4; ++m) { bf16_t* rowp = Ob + (size_t)(row0 + ai * HALF + m * 16) * ldc + col0;
#pragma unroll
                for (int bj = 0; bj < 2; ++bj) { const f32x4 v0 = acc[ai][bj][m][0], v1 = acc[ai][bj][m][1];
                    u32x4 w; w.x = cvt_pk_bf16(v0[0], v0[1]); w.y = cvt_pk_bf16(v0[2], v0[3]); w.z = cvt_pk_bf16(v1[0], v1[1]); w.w = cvt_pk_bf16(v1[2], v1[3]);
                    *(u32x4*)(rowp + bj * HALF) = w; } }
    }
};
struct EpiF32P {
    static constexpr bool PERM = false, AFTER_DRAIN = false;
    float* C; int ldc;
    __device__ __forceinline__ void operator()(const f32x4 (&acc)[2][2][4][2], const Unit& u, int wr, int wc, int fr, int fq) const {
        const int row0 = u.pm * BM + wr * 64 + fr, col0 = u.pn * BM + wc * 32 + 4 * fq;
        float* Cb = C; asm volatile("" : "+s"(Cb));
#pragma unroll
        for (int ai = 0; ai < 2; ++ai)
#pragma unroll
            for (int m = 0; m < 4; ++m) { float* rowp = Cb + (size_t)(row0 + ai * HALF + m * 16) * ldc + col0;
#pragma unroll
                for (int bj = 0; bj < 2; ++bj)
#pragma unroll
                    for (int n = 0; n < 2; ++n) *(f32x4*)(rowp + bj * HALF + n * 16) = acc[ai][bj][m][n]; }
    }
};
struct EpiAct {
    static constexpr bool PERM = true, AFTER_DRAIN = false;
    bf16_t* O; const float* gate;
    __device__ __forceinline__ void operator()(const f32x4 (&acc)[2][2][4][2], const Unit& u, int wr, int wc, int fr, int fq) const {
        const int row0 = u.pm * BM + wr * 64 + fr, col0 = (u.pn & 3) * 128 + wc * 32 + 8 * fq;
        bf16_t* Ob = O; const float* gb = gate; asm volatile("" : "+s"(Ob), "+s"(gb));
#pragma unroll
        for (int ai = 0; ai < 2; ++ai)
#pragma unroll
            for (int m = 0; m < 4; ++m) { const int row = row0 + ai * HALF + m * 16; const float gt = gb[row];
                float o[8];
#pragma unroll
                for (int n = 0; n < 2; ++n)
#pragma unroll
                    for (int i = 0; i < 4; ++i) { const float g = acc[ai][0][m][n][i], up = acc[ai][1][m][n][i]; o[n * 4 + i] = g / (1.0f + __expf(-g)) * up * gt; }
                u32x4 w; w.x = cvt_pk_bf16(o[0], o[1]); w.y = cvt_pk_bf16(o[2], o[3]); w.z = cvt_pk_bf16(o[4], o[5]); w.w = cvt_pk_bf16(o[6], o[7]);
                *(u32x4*)(Ob + (size_t)row * 512 + col0) = w; }
    }
};
struct EpiDn {
    static constexpr bool PERM = true, AFTER_DRAIN = false;
    bf16_t* O;
    __device__ __forceinline__ void operator()(const f32x4 (&acc)[2][2][4][2], const Unit& u, int wr, int wc, int fr, int fq) const {
        const int row0 = u.pm * BM + wr * 64 + fr, col0 = (u.pn & 7) * BM + wc * 32 + 8 * fq;
        bf16_t* Ob = O; asm volatile("" : "+s"(Ob));
#pragma unroll
        for (int ai = 0; ai < 2; ++ai)
#pragma unroll
            for (int m = 0; m < 4; ++m) { bf16_t* rowp = Ob + (size_t)(row0 + ai * HALF + m * 16) * 2048 + col0;
#pragma unroll
                for (int bj = 0; bj < 2; ++bj) { const f32x4 v0 = acc[ai][bj][m][0], v1 = acc[ai][bj][m][1];
                    u32x4 w; w.x = cvt_pk_bf16(v0[0], v0[1]); w.y = cvt_pk_bf16(v0[2], v0[3]); w.z = cvt_pk_bf16(v1[0], v1[1]); w.w = cvt_pk_bf16(v1[2], v1[3]);
                    *(u32x4*)(rowp + bj * HALF) = w; } }
    }
};
struct MoeOrder {
    const int* tile_e; int ntiles, nsub, G, c;
    __device__ __forceinline__ bool next(int i, Unit& u) const {
        const int L = i * G + c; if (L >= ntiles * nsub) return false;
        const int t = L / nsub, j = L - t * nsub; u.pm = t; u.pn = tile_e[t] * nsub + j; return true;
    }
    __device__ __forceinline__ void a_ready(const Unit&) const {}
    __device__ __forceinline__ void done(const Unit&) const {}
};
template <class Epi, class Sched, bool ALIGN_EPI = false, bool SP2 = false>
__device__ __forceinline__ void gemm_phase(PG8_LAS unsigned char* lds, const Gemm g, const Sched& S, const Epi& E) {
    int tid_ = threadIdx.x; asm volatile("" : "+v"(tid_));
    const int tid = tid_, wid = __builtin_amdgcn_readfirstlane(tid >> 6), lane = tid & 63, wr = wid >> 2, wc = wid & 3, fr = lane & 15, fq = lane >> 4;
    const int K = g.K, nt = K / BK;
    unsigned voffA[2], voffB[2];
#pragma unroll
    for (int i = 0; i < 2; ++i) { int R, C; stage_rc(tid * 16 + i * 8192, R, C); const int Rb = Epi::PERM ? ((R & ~31) + perm32(R & 31)) : R;
        voffA[i] = (unsigned)(R * K + C) * 2u; voffB[i] = (unsigned)(Rb * K + C) * 2u; }
    const size_t kstep = (size_t)(BK * 2);
    const size_t hstep = (size_t)HALF * K * 2;
    const size_t tstep = 2 * hstep;
    const unsigned ldsw = (unsigned)wid * 1024u;
    const int aoff = lds_byte(wr * 64 + fr, fq * 8), boff = lds_byte(wc * 32 + fr, fq * 8);
#define PG8_SA(b, h) (((b) * 2 + (h)) * HTB)
#define PG8_SB(b, h) ((4 + (b) * 2 + (h)) * HTB)
#define PG8_STAGE(bufoff, gbase, voff) do { _Pragma("unroll") for (int _i = 0; _i < 2; ++_i) \
        __builtin_amdgcn_global_load_lds((const unsigned*)((const char*)(gbase) + (voff)[_i]), (PG8_LAS unsigned*)(lds + (bufoff) + ldsw + _i * 8192), 16, 0, 0); } while (0)
#define PG8_LDA(dst, b, h) do { _Pragma("unroll") for (int m = 0; m < 4; ++m) _Pragma("unroll") for (int k = 0; k < 2; ++k) dst[m][k] = *(const PG8_LAS bf16x8*)(lds + PG8_SA(b, h) + aoff + m * 2048 + k * 1024); } while (0)
#define PG8_LDB(dst, b, h) do { _Pragma("unroll") for (int n = 0; n < 2; ++n) _Pragma("unroll") for (int k = 0; k < 2; ++k) dst[n][k] = *(const PG8_LAS bf16x8*)(lds + PG8_SB(b, h) + boff + n * 2048 + k * 1024); } while (0)
#define PG8_MMA(ai, bj, At, Bt) do { __builtin_amdgcn_s_setprio(1); _Pragma("unroll") for (int m = 0; m < 4; ++m) _Pragma("unroll") for (int n = 0; n < 2; ++n) _Pragma("unroll") for (int k = 0; k < 2; ++k) \
        acc[ai][bj][m][n] = __builtin_amdgcn_mfma_f32_16x16x32_bf16(Bt[n][k], At[m][k], acc[ai][bj][m][n], 0, 0, 0); __builtin_amdgcn_s_setprio(0); } while (0)
#define PG8_WAIT_V(n) asm volatile("s_waitcnt vmcnt(" #n ")" ::: "memory")
#define PG8_WAIT_L(n) asm volatile("s_waitcnt lgkmcnt(" #n ")" ::: "memory")
#define PG8_BAR __builtin_amdgcn_s_barrier()
#define PG8_SCHED __builtin_amdgcn_sched_barrier(0)
    Unit cur, nxt; int ui = 0;
    if (!S.next(0, cur)) return;
    f32x4 acc[2][2][4][2];
#pragma unroll
    for (int a = 0; a < 2; ++a)
#pragma unroll
        for (int b = 0; b < 2; ++b)
#pragma unroll
            for (int m = 0; m < 4; ++m)
#pragma unroll
                for (int n = 0; n < 2; ++n) acc[a][b][m][n] = (f32x4){0.f, 0.f, 0.f, 0.f};
    bf16x8 At[4][2], B0[2][2], B1[2][2];
    const char* cA = (const char*)g.A + (size_t)cur.pm * tstep; const char* cB = (const char*)g.Bt + (size_t)cur.pn * tstep;
    S.a_ready(cur);
    if constexpr (SP2) {
        PG8_STAGE(PG8_SB(0, 0), cB, voffB); PG8_STAGE(PG8_SB(0, 1), cB + hstep, voffB); PG8_STAGE(PG8_SA(0, 0), cA, voffA); PG8_STAGE(PG8_SA(0, 1), cA + hstep, voffA);
        if (wr == 1) PG8_BAR;
        PG8_WAIT_V(2); PG8_BAR;
        PG8_STAGE(PG8_SB(1, 0), cB + kstep, voffB); PG8_STAGE(PG8_SA(1, 0), cA + kstep, voffA); PG8_STAGE(PG8_SB(1, 1), cB + hstep + kstep, voffB);
        PG8_WAIT_V(6); PG8_BAR;
    } else {
        PG8_STAGE(PG8_SB(0, 0), cB, voffB); PG8_STAGE(PG8_SA(0, 0), cA, voffA); PG8_STAGE(PG8_SB(0, 1), cB + hstep, voffB); PG8_STAGE(PG8_SA(0, 1), cA + hstep, voffA);
        if (wr == 1) PG8_BAR;
        PG8_WAIT_V(4); PG8_BAR;
        PG8_STAGE(PG8_SB(1, 0), cB + kstep, voffB); PG8_STAGE(PG8_SA(1, 0), cA + kstep, voffA); PG8_STAGE(PG8_SB(1, 1), cB + hstep + kstep, voffB);
        PG8_WAIT_V(6); PG8_BAR;
    }
    for (;;) {
        const bool has_next = S.next(ui + 1, nxt);
        const char* nA = has_next ? (const char*)g.A + (size_t)nxt.pm * tstep : cA; const char* nB = has_next ? (const char*)g.Bt + (size_t)nxt.pn * tstep : cB;
        for (int t = 0; t < nt; t += 2) {
            const bool last = (t == nt - 2);
            const char* a1 = cA + (size_t)(t + 1) * kstep;
            const char* a2 = last ? nA : cA + (size_t)(t + 2) * kstep; const char* b2 = last ? nB : cB + (size_t)(t + 2) * kstep;
            const char* a3 = a2 + kstep; const char* b3 = b2 + kstep;
            if (last && has_next) S.a_ready(nxt);
            if constexpr (SP2) {
            PG8_LDB(B0, 0, 0); PG8_LDB(B1, 0, 1); PG8_SCHED; PG8_LDA(At, 0, 0); PG8_STAGE(PG8_SA(1, 1), a1 + hstep, voffA);
            PG8_WAIT_V(8); PG8_WAIT_L(0); PG8_BAR; PG8_MMA(0, 0, At, B0); PG8_MMA(0, 1, At, B1); PG8_BAR; PG8_SCHED;
            PG8_LDA(At, 0, 1); PG8_STAGE(PG8_SB(0, 0), b2, voffB); PG8_STAGE(PG8_SB(0, 1), b2 + hstep, voffB); PG8_STAGE(PG8_SA(0, 0), a2, voffA);
            PG8_WAIT_V(8); PG8_WAIT_L(0); PG8_BAR; PG8_MMA(1, 0, At, B0); PG8_MMA(1, 1, At, B1); PG8_BAR; PG8_SCHED;
            PG8_LDB(B0, 1, 0); PG8_LDB(B1, 1, 1); PG8_SCHED; PG8_LDA(At, 1, 0); PG8_STAGE(PG8_SA(0, 1), a2 + hstep, voffA);
            PG8_WAIT_V(8); PG8_WAIT_L(0); PG8_BAR; PG8_MMA(0, 0, At, B0); PG8_MMA(0, 1, At, B1); PG8_BAR; PG8_SCHED;
            PG8_LDA(At, 1, 1); PG8_STAGE(PG8_SB(1, 0), b3, voffB); PG8_STAGE(PG8_SB(1, 1), b3 + hstep, voffB); PG8_STAGE(PG8_SA(1, 0), a3, voffA);
            PG8_WAIT_V(8); PG8_WAIT_L(0); PG8_BAR; PG8_MMA(1, 0, At, B0); PG8_MMA(1, 1, At, B1); PG8_BAR; PG8_SCHED;
            } else {
            PG8_LDB(B0, 0, 0); PG8_SCHED; PG8_LDA(At, 0, 0); PG8_STAGE(PG8_SA(1, 1), a1 + hstep, voffA);
            PG8_WAIT_L(8); PG8_BAR; PG8_WAIT_L(0); PG8_MMA(0, 0, At, B0); PG8_BAR; PG8_SCHED;
            PG8_LDB(B1, 0, 1); PG8_STAGE(PG8_SB(0, 0), b2, voffB);
            PG8_BAR; PG8_WAIT_L(0); PG8_MMA(0, 1, At, B1); PG8_BAR;
            PG8_LDA(At, 0, 1); PG8_STAGE(PG8_SA(0, 0), a2, voffA);
            PG8_BAR; PG8_WAIT_L(0); PG8_MMA(1, 0, At, B0); PG8_BAR; PG8_SCHED;
            PG8_STAGE(PG8_SB(0, 1), b2 + hstep, voffB);
            PG8_WAIT_V(6); PG8_BAR; PG8_MMA(1, 1, At, B1); PG8_BAR;
            PG8_LDB(B0, 1, 0); PG8_SCHED; PG8_LDA(At, 1, 0); PG8_STAGE(PG8_SA(0, 1), a2 + hstep, voffA);
            PG8_WAIT_L(8); PG8_BAR; PG8_WAIT_L(0); PG8_MMA(0, 0, At, B0); PG8_BAR; PG8_SCHED;
            PG8_LDB(B1, 1, 1); PG8_STAGE(PG8_SB(1, 0), b3, voffB);
            PG8_BAR; PG8_WAIT_L(0); PG8_MMA(0, 1, At, B1); PG8_BAR;
            PG8_LDA(At, 1, 1); PG8_STAGE(PG8_SA(1, 0), a3, voffA);
            PG8_BAR; PG8_WAIT_L(0); PG8_MMA(1, 0, At, B0); PG8_BAR; PG8_SCHED;
            PG8_STAGE(PG8_SB(1, 1), b3 + hstep, voffB);
            PG8_WAIT_V(6); PG8_BAR; PG8_MMA(1, 1, At, B1); PG8_BAR;
            }
        }
        if constexpr (ALIGN_EPI) { if (wr == 0) PG8_BAR; }
        if constexpr (!Epi::AFTER_DRAIN) { E(acc, cur, wr, wc, fr, fq); S.done(cur); }
        if (!has_next) break;
#pragma unroll
        for (int a = 0; a < 2; ++a)
#pragma unroll
            for (int b = 0; b < 2; ++b)
#pragma unroll
                for (int m = 0; m < 4; ++m)
#pragma unroll
                    for (int n = 0; n < 2; ++n) acc[a][b][m][n] = (f32x4){0.f, 0.f, 0.f, 0.f};
        cur = nxt; cA = nA; cB = nB; ++ui;
        if constexpr (ALIGN_EPI) { if (wr == 1) PG8_BAR; }
    }
    PG8_WAIT_V(0);
    if constexpr (!ALIGN_EPI) { if (wr == 0) PG8_BAR; }
    PG8_BAR;
    if constexpr (Epi::AFTER_DRAIN) { E.fused(acc, cur, wr, wc, fr, fq, lds, wid, lane); S.done(cur); }
#undef PG8_SA
#undef PG8_SB
#undef PG8_STAGE
#undef PG8_LDA
#undef PG8_LDB
#undef PG8_MMA
#undef PG8_WAIT_V
#undef PG8_WAIT_L
#undef PG8_BAR
#undef PG8_SCHED
}
template <bool IS_UP, class Epi>
__device__ __forceinline__ void moe_gemm_phase(PG8_LAS unsigned char* lds, const bf16_t* A, const int* rlist, const float* W, const PG8_LAS int* tab, int ntiles, int G, int c, const Epi& E) {
    constexpr int MT_OFF = 0, MT_CNT = 33, MT_TILE = 66, CAP = 9216;
    constexpr int K = IS_UP ? 2048 : 512, NSUB = IS_UP ? 4 : 8, NT = K / 64, WN = IS_UP ? 1024 : 2048;
    int tid_ = threadIdx.x; asm volatile("" : "+v"(tid_));
    const int tid = tid_, wid = __builtin_amdgcn_readfirstlane(tid >> 6), lane = tid & 63, wr = wid >> 2, wc = wid & 3, fr = lane & 15, fq = lane >> 4;
    const int key = (fr >> 1) & 7;
    const int arow = 64 * wr + fr, brow = 32 * wc + fr;
    const int ch0 = ((fq) ^ key) << 4, ch1 = ((fq + 4) ^ key) << 4;
    int awo[4], bwo[4];
#pragma unroll
    for (int p = 0; p < 4; ++p) { const int row = (tid >> 3) + 64 * p; awo[p] = row * 128 + (((tid & 7) ^ ((row >> 1) & 7)) << 4); }
#pragma unroll
    for (int cc = 0; cc < 4; ++cc) { const int rho = 32 * (lane >> 3) + 16 * (lane & 1) + 4 * ((lane >> 1) & 3) + cc; bwo[cc] = rho * 128 + ((wid ^ ((rho >> 1) & 7) ^ ((rho >> 4) & 1)) << 4); }
    int t = 0, j = 0, e = 0, eoff = 0, ecnt = 0; const char* agp[4] = {nullptr, nullptr, nullptr, nullptr}; const float* wg = nullptr; bool have;
    u32x4 ar[4]; f32x4 wv[8];
#define MG_UNIT(ui_) do { const int L_ = (ui_) * G + c; have = L_ < ntiles * NSUB; if (have) { t = L_ / NSUB; j = L_ - t * NSUB; \
        e = __builtin_amdgcn_readfirstlane(tab[MT_TILE + t]); eoff = __builtin_amdgcn_readfirstlane(tab[MT_OFF + e]); ecnt = __builtin_amdgcn_readfirstlane(tab[MT_CNT + e]); \
        _Pragma("unroll") for (int p = 0; p < 4; ++p) { const int sr = t * 256 + (tid >> 3) + 64 * p, li = sr - eoff;     \
            const size_t ar_ = IS_UP ? (size_t)((li < ecnt) ? rlist[e * CAP + li] : 0) : (size_t)sr; agp[p] = (const char*)(A + ar_ * K) + (tid & 7) * 16; } \
        wg = W + (size_t)e * K * WN + (size_t)(8 * wid) * WN + (IS_UP ? ((lane < 32) ? j * 128 + 4 * lane : 512 + j * 128 + 4 * (lane - 32)) : j * 256 + 4 * lane); } } while (0)
#define MG_LOAD(kt) do { _Pragma("unroll") for (int p = 0; p < 4; ++p) ar[p] = *(const u32x4*)(agp[p] + (kt) * 128); \
        _Pragma("unroll") for (int i = 0; i < 8; ++i) wv[i] = *(const f32x4*)(wg + (size_t)((kt) * 64 + i) * WN); } while (0)
#define MG_WRITE(buf) do { PG8_LAS unsigned char* ab_ = lds + (buf) * 32768; PG8_LAS unsigned char* bb_ = lds + 65536 + (buf) * 32768; \
        _Pragma("unroll") for (int p = 0; p < 4; ++p) *(PG8_LAS u32x4*)(ab_ + awo[p]) = ar[p]; \
        _Pragma("unroll") for (int cc = 0; cc < 4; ++cc) { u32x4 o; o.x = cvt_pk_bf16(wv[0][cc], wv[1][cc]); o.y = cvt_pk_bf16(wv[2][cc], wv[3][cc]); o.z = cvt_pk_bf16(wv[4][cc], wv[5][cc]); o.w = cvt_pk_bf16(wv[6][cc], wv[7][cc]); \
            *(PG8_LAS u32x4*)(bb_ + bwo[cc]) = o; } } while (0)
    MG_UNIT(0);
    if (have) MG_LOAD(0);
    for (int ui = 0; have; ++ui) {
        f32x4 acc[2][2][4][2];
#pragma unroll
        for (int a = 0; a < 2; ++a)
#pragma unroll
            for (int b = 0; b < 2; ++b)
#pragma unroll
                for (int m = 0; m < 4; ++m)
#pragma unroll
                    for (int n = 0; n < 2; ++n) acc[a][b][m][n] = (f32x4){0.f, 0.f, 0.f, 0.f};
        MG_WRITE(0);
        __syncthreads();
#pragma unroll 1
        for (int kt = 0; kt < NT; ++kt) {
            const int cur = kt & 1;
            if (kt + 1 < NT) MG_LOAD(kt + 1);
            __builtin_amdgcn_sched_barrier(0);
            { const PG8_LAS unsigned char* ab = lds + cur * 32768; const PG8_LAS unsigned char* bb = lds + 65536 + cur * 32768;
#pragma unroll
              for (int k = 0; k < 2; ++k) { const int chk = k ? ch1 : ch0;
                  bf16x8 Bf[2][2];
#pragma unroll
                  for (int bj = 0; bj < 2; ++bj)
#pragma unroll
                      for (int n = 0; n < 2; ++n) Bf[bj][n] = *(const PG8_LAS bf16x8*)(bb + (128 * bj + 16 * n + brow) * 128 + (n ? chk ^ 16 : chk));
                  bf16x8 Ac = *(const PG8_LAS bf16x8*)(ab + arow * 128 + chk), An = *(const PG8_LAS bf16x8*)(ab + (16 + arow) * 128 + chk);
#pragma unroll
                  for (int im = 0; im < 8; ++im) { const int ai = im >> 2, m = im & 3; bf16x8 Af = An;
                      if (im + 2 < 8) Af = *(const PG8_LAS bf16x8*)(ab + (128 * ((im + 2) >> 2) + 16 * ((im + 2) & 3) + arow) * 128 + chk);
                      __builtin_amdgcn_sched_barrier(0);
#pragma unroll
                      for (int bj = 0; bj < 2; ++bj)
#pragma unroll
                          for (int n = 0; n < 2; ++n) acc[ai][bj][m][n] = __builtin_amdgcn_mfma_f32_16x16x32_bf16(Bf[bj][n], Ac, acc[ai][bj][m][n], 0, 0, 0);
                      __builtin_amdgcn_sched_barrier(0);
                      Ac = An; An = Af; } } }
            __builtin_amdgcn_sched_barrier(0);
            if (kt + 1 < NT) MG_WRITE(cur ^ 1);
            __syncthreads();
        }
        const Unit u{t, j}; const float* gbase = nullptr; if constexpr (IS_UP) gbase = E.gate + (size_t)e * CAP - eoff;
        MG_UNIT(ui + 1);
        if (have) MG_LOAD(0);
        if constexpr (IS_UP) { Epi E2 = E; E2.gate = gbase; E2(acc, u, wr, wc, fr, fq); }
        else E(acc, u, wr, wc, fr, fq);
    }
#undef MG_UNIT
#undef MG_LOAD
#undef MG_WRITE
    __syncthreads();
}
}
#define LAS __attribute__((address_space(3)))
#define XB_TMO      128
#define XB_XCNT(j)  (256  + 64 * (j))
#define XB_XSUB(j)  (1280 + 64 * (j))
#define XB_XGEN(j)  (2304 + 64 * (j))
#define XB_TOP      3328
#define XB_TOPGEN   3392
#define XCD_BAR_WORDS 3456
#define XB_SPIN_CAP (1u << 18)

__device__ __forceinline__ unsigned xb_ld(unsigned* p)              { return __hip_atomic_load(p, __ATOMIC_RELAXED, __HIP_MEMORY_SCOPE_AGENT); }
__device__ __forceinline__ unsigned xb_add(unsigned* p, unsigned v) { return __hip_atomic_fetch_add(p, v, __ATOMIC_RELAXED, __HIP_MEMORY_SCOPE_AGENT); }
__device__ __forceinline__ unsigned xb_xcc_id() { return (unsigned)__builtin_amdgcn_s_getreg((3 << 11) | 20) & 0xFu; }
#define XB_SPIN(cond, bar) do { unsigned _sp = 0; while (cond) { __builtin_amdgcn_s_sleep(1); \
    if ((++_sp & 255u) == 0u) { if (xb_ld(&(bar)[XB_TMO])) break; if (_sp > XB_SPIN_CAP) { atomicAdd(&(bar)[XB_TMO], 1u); break; } } } } while (0)

struct XcdBarrier {
    unsigned* bar; unsigned x;
    volatile LAS unsigned* st;
};

__device__ __forceinline__ XcdBarrier xcd_barrier_post(unsigned* bar, volatile LAS unsigned* st) {
    XcdBarrier b; b.bar = bar; b.x = xb_xcc_id(); b.st = st;
    if (threadIdx.x == 0) st[2] = xb_add(&bar[XB_XCNT(b.x)], 1u);
    return b;
}
__device__ __forceinline__ void xcd_barrier_complete(unsigned* bar, unsigned x, unsigned& nloc, unsigned& nx) {
    const unsigned G = gridDim.x * gridDim.y * gridDim.z;
    unsigned sum, cnt, mine, sp = 0u;
    for (;;) {
        sum = 0u; cnt = 0u; mine = 0u;
#pragma unroll
        for (unsigned j = 0; j < 16; ++j) { const unsigned c = xb_ld(&bar[XB_XCNT(j)]); sum += c; cnt += (c > 0u) ? 1u : 0u; mine = (j == x) ? c : mine; }
        if (sum == G) break;
        __builtin_amdgcn_s_sleep(1);
        if ((++sp & 255u) == 0u) { if (xb_ld(&bar[XB_TMO])) break; if (sp > XB_SPIN_CAP) { atomicAdd(&bar[XB_TMO], 1u); break; } }
    }
    nloc = mine > 0u ? mine : 1u; nx = cnt > 0u ? cnt : 1u;
}

__device__ __forceinline__ void xcd_barrier(const XcdBarrier& b) {
    asm volatile("s_waitcnt vmcnt(0)" ::: "memory");
    __syncthreads();
    if (threadIdx.x == 0) {
        unsigned* bar = b.bar;
        __builtin_amdgcn_s_waitcnt(0);
        unsigned nloc = b.st[0], nx = b.st[1];
        if (nloc == 0u) { xcd_barrier_complete(bar, b.x, nloc, nx); b.st[0] = nloc; b.st[1] = nx; }
        const unsigned old = xb_add(&bar[XB_XSUB(b.x)], 1u);
        const unsigned gen = old / nloc;
        if (old + 1u == (gen + 1u) * nloc) {
            __builtin_amdgcn_fence(__ATOMIC_RELEASE, "agent");
            asm volatile("s_waitcnt vmcnt(0)" ::: "memory");
            const unsigned og = xb_add(&bar[XB_TOP], 1u);
            const unsigned tg = og / nx;
            if (og + 1u == (tg + 1u) * nx) xb_add(&bar[XB_TOPGEN], 1u);
            else XB_SPIN(xb_ld(&bar[XB_TOPGEN]) == tg, bar);
            __builtin_amdgcn_fence(__ATOMIC_ACQUIRE, "agent");
            xb_add(&bar[XB_XGEN(b.x)], 1u);
            asm volatile("s_waitcnt vmcnt(0)" ::: "memory");
        } else {
            XB_SPIN(xb_ld(&bar[XB_XGEN(b.x)]) == gen, bar);
            __builtin_amdgcn_fence(__ATOMIC_ACQUIRE, "agent");
            asm volatile("s_waitcnt vmcnt(0)" ::: "memory");
        }
    }
    __syncthreads();
}
constexpr int DM = 2048, NB = 4, SEQ = 2048, CTXL = 256, TLAT = NB * SEQ, TCTX = NB * CTXL, TTOT = TLAT + TCTX;
constexpr int INC = 6176, INCP = 6400;
constexpr int C_HY = 0, C_NQ = 1536, C_NK = 2304, C_NV = 3072, C_GQ = 3840, C_GK = 4224, C_GV = 4608, C_GG = 5376, C_GA = 6144;
constexpr int M_NA = 512, M_GLA = 1280;
constexpr int HYC = 512, NAH = 6, GH = 6;
constexpr int NEXP = 32, DEXP = 512;
constexpr int NLAYER = 2;
constexpr float LN_EPS = 1e-6f;
constexpr float ALPHA = 1.41421356237f;
constexpr int MAXSLOTS = 26624;
constexpr int GSTEPS = 36;

constexpr size_t MiB = 1u << 20;
constexpr size_t WS_CTL = 0, CTL_ZERO_BYTES = 64 * 1024;
constexpr size_t WS_WIN = 2 * MiB;
constexpr size_t WS_WOUT = 52 * MiB;
constexpr size_t WS_WUP = 68 * MiB;
constexpr size_t WS_WDN = 324 * MiB;
constexpr size_t WS_KF = 452 * MiB;
constexpr size_t WS_KFC = 468 * MiB;
constexpr size_t WS_WRT = 469 * MiB;
constexpr size_t WS_H = 470 * MiB;
constexpr size_t WS_PROJ = 506 * MiB;
constexpr size_t WS_MIX = 620 * MiB;
constexpr size_t WS_Y = 656 * MiB;
constexpr size_t WS_X1 = 728 * MiB;
constexpr size_t WS_X2 = 800 * MiB;
constexpr size_t WS_XG = 872 * MiB;
constexpr size_t WS_ACT = 976 * MiB;
constexpr size_t WS_DN = 1002 * MiB;
constexpr size_t WS_ST = 1106 * MiB;
constexpr size_t WS_DEC = 1160 * MiB;
constexpr size_t WS_ASG = 1161 * MiB;
constexpr size_t WS_SLOT = 1162 * MiB;
constexpr size_t WS_GATE = 1162 * MiB + 512 * 1024;
constexpr size_t WS_TILE = 1163 * MiB;
constexpr size_t WS_VTL = 1164 * MiB;
constexpr size_t WS_VTC = 1177 * MiB;
constexpr size_t WS_KTL = 1206 * MiB;
constexpr size_t WS_KTC = 1219 * MiB;
constexpr size_t WS_ZT = 1179 * MiB;
constexpr size_t WS_X0T = 1187 * MiB;
constexpr size_t WS_YT = 1195 * MiB;
constexpr size_t WS_ZTC = 1203 * MiB, WS_X0TC = 1204 * MiB, WS_YTC = 1205 * MiB;
constexpr size_t WS_CF = 1221 * MiB;
constexpr size_t WS_END = 1250 * MiB;
constexpr int CW_BAR = 4096;
constexpr int CW_CNT = 8192;
constexpr int CW_MOD = 65536;

constexpr int RING_BYTES = 131072;
constexpr int LDSCTL_OFF = 143360, LDS_BYTES = 147456;
constexpr int NWAVES = 8, NTHR = 512;


typedef unsigned short bf16;
typedef unsigned v4u __attribute__((ext_vector_type(4)));
typedef unsigned v2u __attribute__((ext_vector_type(2)));
typedef float f32x4 __attribute__((ext_vector_type(4)));
typedef short bf16x8 __attribute__((ext_vector_type(8)));
#define LDS_WAIT() asm volatile("s_waitcnt lgkmcnt(0)" ::: "memory")
__device__ __forceinline__ unsigned f2bf(float f) { unsigned u = __builtin_bit_cast(unsigned, f); return (u + 0x7fffu + ((u >> 16) & 1u)) >> 16; }
__device__ __forceinline__ unsigned pk2(float lo, float hi) { return f2bf(lo) | (f2bf(hi) << 16); }
__device__ __forceinline__ float bf2f(unsigned short b) { return __builtin_bit_cast(float, (unsigned)b << 16); }
__device__ __forceinline__ float bflo(unsigned w) { return __builtin_bit_cast(float, w << 16); }
__device__ __forceinline__ float bfhi(unsigned w) { return __builtin_bit_cast(float, w & 0xffff0000u); }
__device__ __forceinline__ float wave_sum(float v) {
#pragma unroll
    for (int o = 1; o < 64; o <<= 1) v += __shfl_xor(v, o);
    return v;
}
__device__ __forceinline__ float wave_max(float v) {
#pragma unroll
    for (int o = 1; o < 64; o <<= 1) v = fmaxf(v, __shfl_xor(v, o));
    return v;
}
__device__ __forceinline__ float silu_f(float x) { return x / (1.0f + __expf(-x)); }
__device__ __forceinline__ float logsigmoid_f(float z) { return fminf(z, 0.f) - __logf(1.0f + __expf(-fabsf(z))); }

#define KAS __attribute__((address_space(4)))
#define GAS __attribute__((address_space(1)))
#define RELAUNDER(F) do { asm volatile("" : "+s"(F.ws), "+s"(F.in)); asm volatile("" : "+v"(F.tid)); F.lane = F.tid & 63; F.wave = __builtin_amdgcn_readfirstlane(F.tid >> 6); F.ctl = (GAS unsigned*)F.ws; } while (0)
#define INP(i) ((const float*)F.in[i])
struct Fr {
    LAS unsigned char* lds;
    int tid, lane, wave, G, bid;
    const GAS float* const KAS* in;
    GAS float* out; GAS unsigned char* ws;
    GAS unsigned* ctl;
};
#define IN_X 0
#define IN_C 1
#define IN_CTX 2
#define IN_CCTX 3
#define IN_WADA 4
#define IN_BADA 5
#define IN_WIN 6
#define IN_HYSW 7
#define IN_HYSB 8
#define IN_HYW1 9
#define IN_HYB1 10
#define IN_HYW2 11
#define IN_HYB2 12
#define IN_HYW3 13
#define IN_HYFR 14
#define IN_HYBIAS 15
#define IN_HYNW 16
#define IN_RPB 17
#define IN_NANW 18
#define IN_GAW2 19
#define IN_GAB 20
#define IN_GNW 21
#define IN_WOUT 22
#define IN_LN1G 23
#define IN_LN1B 24
#define IN_WRG 25
#define IN_BRG 26
#define IN_WRE 27
#define IN_BRE 28
#define IN_WUP 29
#define IN_WDN 30
#define IN_LN2G 31
#define IN_LN2B 32

__device__ __forceinline__ void transpose_item(const float* W, int ldw, bf16* WT, int ldt, int k0, int n0, int dst_row0, bool full, LAS float* scr, int lane) {
    const float* src = W + (size_t)k0 * ldw + n0 + lane; const bool ok = full || lane < 32;
    float v[64];
#pragma unroll
    for (int kk = 0; kk < 64; ++kk) v[kk] = ok ? src[(size_t)kk * ldw] : 0.f;
#pragma unroll
    for (int kk = 0; kk < 64; ++kk) scr[kk * 65 + lane] = v[kk];
    LDS_WAIT(); asm volatile("" ::: "memory");
    const int c = lane & 7;
#pragma unroll
    for (int j = 0; j < 8; ++j) { const int n = (lane >> 3) + 8 * j; const LAS float* s = scr + (8 * c) * 65 + n;
        v4u o; o.x = pk2(s[0 * 65], s[1 * 65]); o.y = pk2(s[2 * 65], s[3 * 65]); o.z = pk2(s[4 * 65], s[5 * 65]); o.w = pk2(s[6 * 65], s[7 * 65]);
        if (full || n < 32) *(v4u*)(WT + (size_t)(dst_row0 + n) * ldt + k0 + 8 * c) = o; }
    LDS_WAIT(); asm volatile("" ::: "memory");
}

__device__ __forceinline__ void hy_filter_item(const Fr& F, int L, int l, int pb, float* KFo) {
    LAS float* zf = (LAS float*)F.lds;
    LAS float* h1 = zf + 32 * 33;
    LAS float* h2 = h1 + 32 * 64;
    const int n0 = pb * 32, tid = F.tid;
    const float* w1 = INP(IN_HYW1) + L * 33 * 64; const float* b1 = INP(IN_HYB1) + L * 64;
    const float* w2 = INP(IN_HYW2) + L * 64 * 64; const float* b2 = INP(IN_HYB2) + L * 64;
    const float* w3 = INP(IN_HYW3) + L * 64 * 1024; const float* fr = INP(IN_HYFR) + L * 64;
    const float tden = 1.0f / (float)(l - 1);
    for (int idx = tid; idx < 32 * 33; idx += NTHR) {
        const int p = idx / 33, i = idx - p * 33; const float n = (float)(n0 + p); float val;
        if (i == 0) val = n * tden;
        else { const int j = (i - 1) & 15; const float band = 1e-4f + (float)j * ((15.0f - 1e-4f) / 15.0f);
            float turns = n * band * (1.0f / (float)l); turns -= floorf(turns);
            const float ang = 6.283185307179586f * turns;
            val = (i <= 16) ? __cosf(ang) : -__sinf(ang); }
        zf[idx] = val;
    }
    __syncthreads();
    for (int idx = tid; idx < 32 * 64; idx += NTHR) { const int p = idx >> 6, j = idx & 63; float s = b1[j];
        for (int i = 0; i < 33; ++i) s += zf[p * 33 + i] * w1[i * 64 + j];
        h1[idx] = __sinf(fr[j] * s); }
    __syncthreads();
    for (int idx = tid; idx < 32 * 64; idx += NTHR) { const int p = idx >> 6, j = idx & 63; float s = b2[j];
        for (int i = 0; i < 64; ++i) s += h1[p * 64 + i] * w2[i * 64 + j];
        h2[idx] = __sinf(fr[j] * s); }
    __syncthreads();
    const int c = tid;
    const float dmin = -3.0701134573253943f, dmax = -15.350567286626972f;
    const float delta = fabsf(dmin + (float)c * ((dmax - dmin) / 511.0f));
    const float hb = INP(IN_HYBIAS)[L * HYC + c];
#pragma unroll 1
    for (int dh = 0; dh < 4; ++dh) {
        const int dir = dh >> 1, p0 = (dh & 1) * 16; const int col = dir * 512 + c; float acc[16];
#pragma unroll
        for (int p = 0; p < 16; ++p) acc[p] = 0.f;
        float wv[64];
#pragma unroll
        for (int i = 0; i < 64; ++i) wv[i] = w3[i * 1024 + col];
#pragma unroll
        for (int i = 0; i < 64; ++i) { const float w = wv[i];
#pragma unroll
            for (int p = 0; p < 16; ++p) acc[p] += h2[(p0 + p) * 64 + i] * w;
            asm volatile("" : "+v"(acc[0]), "+v"(acc[1]), "+v"(acc[2]), "+v"(acc[3]), "+v"(acc[4]), "+v"(acc[5]), "+v"(acc[6]), "+v"(acc[7]));
            asm volatile("" : "+v"(acc[8]), "+v"(acc[9]), "+v"(acc[10]), "+v"(acc[11]), "+v"(acc[12]), "+v"(acc[13]), "+v"(acc[14]), "+v"(acc[15])); }
        float* kf = KFo + (size_t)c * (2 * l);
#pragma unroll
        for (int p = 0; p < 16; ++p) { const int n = n0 + p0 + p; const float t = (float)n * tden; float v = acc[p] * __expf(-t * delta);
            if (dir == 0) { if (n == 0) { v += hb; kf[0] = 0.f; } kf[l + n] = v; }
            else if (n >= 1) kf[l - n] = v; }
    }
    __syncthreads();
}

constexpr int I_IN = 32 * 97, I_OUT = 32 * 32, I_UP = 32 * 16, I_DN = 8 * 32;
constexpr int CONV_PER_LAYER = I_IN + I_OUT;
constexpr int CW_Q = 12288;
__device__ __forceinline__ void conv_item(const Fr& F, int L, int r, LAS float* scr) {
    const int lane = F.lane;
    bf16* WinT = (bf16*)(F.ws + WS_WIN); bf16* WoutT = (bf16*)(F.ws + WS_WOUT); bf16* WupT = (bf16*)(F.ws + WS_WUP); bf16* WdnT = (bf16*)(F.ws + WS_WDN);
    if (r < I_IN) { const int kb = r / 97, nb = r % 97;
        transpose_item(INP(IN_WIN) + (size_t)L * DM * INC, INC, WinT + (size_t)L * INCP * DM, DM, kb * 64, nb * 64, nb * 64, nb < 96, scr, lane); return; }
    r -= I_IN;
    if (r < I_OUT) { const int kb = r / 32, nb = r % 32;
        transpose_item(INP(IN_WOUT) + (size_t)L * DM * DM, DM, WoutT + (size_t)L * DM * DM, DM, kb * 64, nb * 64, nb * 64, true, scr, lane); return; }
    r -= I_OUT;
    if (r < NEXP * I_UP) { const int le = L * NEXP + r / I_UP, q = r % I_UP, kb = q / 16, nb = q % 16;
        const int n0 = nb * 64, bj = n0 / 512, rem = n0 % 512, j = rem / 128, cc = rem % 128;
        transpose_item(INP(IN_WUP) + (size_t)le * DM * 1024, 1024, WupT + (size_t)le * 1024 * DM, DM, kb * 64, n0, j * 256 + bj * 128 + cc, true, scr, lane); return; }
    r -= NEXP * I_UP;
    { const int le = L * NEXP + r / I_DN, q = r % I_DN, kb = q / 32, nb = q % 32;
        transpose_item(INP(IN_WDN) + (size_t)le * DEXP * DM, DM, WdnT + (size_t)le * DM * DEXP, DEXP, kb * 64, nb * 64, nb * 64, true, scr, lane); }
}
__device__ __forceinline__ void conv_bubble(Fr F, int quota) {
    RELAUNDER(F);
    LAS float* scr = (LAS float*)(F.lds + F.wave * 16640);
    LAS unsigned* slot = (LAS unsigned*)(F.lds + LDSCTL_OFF + 64);
    unsigned* q = (unsigned*)(F.ctl + CW_Q);
    for (int n = 0; quota < 0 || n < quota; ++n) {
        __syncthreads();
        if (F.tid == 0) *slot = __hip_atomic_fetch_add(q, 32u, __ATOMIC_RELAXED, __HIP_MEMORY_SCOPE_AGENT);
        __syncthreads();
        const unsigned base = *slot;
        if (base >= (unsigned)CONV_PER_LAYER) break;
#pragma unroll 1
        for (int j = 0; j < 4; ++j) { const unsigned it = base + 8 * j + F.wave; if (it < (unsigned)CONV_PER_LAYER) conv_item(F, 1, (int)it, scr); }
    }
    __syncthreads();
}
#ifndef P0MASK
#define P0MASK 7
#endif
#ifndef REPMASK
#define REPMASK 0
#endif
__device__ __forceinline__ void p0_prologue(Fr F) {
    RELAUNDER(F);
    LAS float* scr = (LAS float*)(F.lds + F.wave * 16640);
    const int gw = F.bid * NWAVES + F.wave, NGW = F.G * NWAVES, lane = F.lane;
    bf16* WinT = (bf16*)(F.ws + WS_WIN);
    if (P0MASK & 1)
    for (int rep = 0; rep < 1 + ((REPMASK >> 11) & 1); ++rep)
    for (int it = gw; it < CONV_PER_LAYER; it += NGW) conv_item(F, 0, it, scr);
    for (int i = F.bid * NTHR + F.tid; i < NLAYER * (INCP - INC) * (DM * 2 / 16); i += F.G * NTHR) {
        const int L = i / ((INCP - INC) * 256), q = i % ((INCP - INC) * 256);
        ((v4u*)(WinT + (size_t)L * INCP * DM + (size_t)INC * DM))[q] = (v4u){0u, 0u, 0u, 0u}; }
    { bf16* WRH = (bf16*)(F.ws + WS_WRT); bf16* WRL = (bf16*)(F.ws + WS_WRT + 512 * 1024);
      for (int i = F.bid * NTHR + F.tid; i < NLAYER * 48 * DM; i += F.G * NTHR) { const int L = i / (48 * DM), q = i % (48 * DM), o = q / DM, k = q % DM;
          const float w = (o < 4) ? INP(IN_WRG)[(size_t)L * DM * 4 + k * 4 + o] : (o < 36) ? INP(IN_WRE)[(size_t)L * DM * 32 + k * 32 + (o - 4)] : 0.f;
          const unsigned hi = f2bf(w); WRH[i] = (bf16)hi; WRL[i] = (bf16)f2bf(w - __builtin_bit_cast(float, hi << 16)); } }
    __syncthreads();
    if (P0MASK & 2)
    { float* MOD = (float*)(F.ctl + CW_MOD); LAS float* sc = (LAS float*)F.lds;
      LAS f32x4* part = (LAS f32x4*)(F.lds + 65536);
      for (int i = F.tid; i < 5 * DM; i += NTHR) { const int r = i / DM, k = i % DM; sc[k * 8 + r] = silu_f((r < 4) ? INP(IN_C)[r * DM + k] : INP(IN_CCTX)[k]); }
      __syncthreads();
      for (int rep = 0; rep < 1 + ((REPMASK >> 12) & 1); ++rep)
      for (int it = F.bid; it < NLAYER * 128; it += F.G) {
          const int L = it >> 7, col = (it & 127) * 96 + (lane < 24 ? lane : 0) * 4;
          const float* wp = INP(IN_WADA) + (size_t)L * DM * 12288 + (size_t)(F.wave * 256) * 12288 + col;
          f32x4 acc[5];
#pragma unroll
          for (int r = 0; r < 5; ++r) acc[r] = (f32x4){0.f, 0.f, 0.f, 0.f};
          if (lane < 24) {
#pragma unroll 16
              for (int k = 0; k < 256; ++k) { const f32x4 w = *(const f32x4*)(wp + (size_t)k * 12288); const LAS float* sk = sc + (F.wave * 256 + k) * 8;
                  const f32x4 s03 = *(const LAS f32x4*)sk; const float s4 = sk[4];
                  acc[0] += w * s03[0]; acc[1] += w * s03[1]; acc[2] += w * s03[2]; acc[3] += w * s03[3]; acc[4] += w * s4; }
#pragma unroll
              for (int r = 0; r < 5; ++r) part[(F.wave * 5 + r) * 24 + lane] = acc[r]; }
          __syncthreads();
          for (int idx = F.tid; idx < 5 * 24; idx += NTHR) { const int r = idx / 24, ln = idx % 24; f32x4 sum = *(const f32x4*)(INP(IN_BADA) + L * 12288 + (it & 127) * 96 + ln * 4);
#pragma unroll
              for (int w = 0; w < 8; ++w) sum += part[(w * 5 + r) * 24 + ln];
              *(f32x4*)(MOD + (size_t)(L * 5 + r) * 12288 + (it & 127) * 96 + ln * 4) = sum; }
          __syncthreads();
      } }
    __syncthreads();
    if (P0MASK & 4)
    for (int rep = 0; rep < 1 + ((REPMASK >> 13) & 1); ++rep)
    for (int it = F.bid; it < 136; it += F.G) {
        if (it < 128) { const int L = it >> 6; hy_filter_item(F, L, SEQ, it & 63, (float*)(F.ws + WS_KF) + (size_t)L * HYC * 4096); }
        else hy_filter_item(F, 0, CTXL, it - 128, (float*)(F.ws + WS_KFC));
    }
}

__device__ __forceinline__ const float* mod_ptr(const Fr& F, int L, int row) {
    const int r = row < TLAT ? (row >> 11) : 4; return (const float*)(F.ctl + CW_MOD) + (size_t)(L * 5 + r) * 12288;
}
__device__ __forceinline__ f32x4 load_x4(const Fr& F, int L, int row, int idx4) {
    if (L == 0) return *((const f32x4*)(row < TLAT ? INP(IN_X) + (size_t)row * DM : INP(IN_CTX) + (size_t)(row - TLAT) * DM) + idx4);
    const v2u w = *((const v2u*)((const bf16*)(F.ws + WS_X2) + (size_t)row * DM) + idx4); return (f32x4){bflo(w.x), bfhi(w.x), bflo(w.y), bfhi(w.y)};
}
__device__ __forceinline__ void p1_ln_mod(Fr F, int L) {
    RELAUNDER(F);
    const int gw = F.bid * NWAVES + F.wave, NGW = F.G * NWAVES, lane = F.lane;
    bf16* H = (bf16*)(F.ws + WS_H);
    for (int row = gw; row < TTOT; row += NGW) {
        const float* mod = mod_ptr(F, L, row);
        f32x4 v[8]; float s = 0.f;
#pragma unroll
        for (int j = 0; j < 8; ++j) { v[j] = load_x4(F, L, row, lane + 64 * j); s += (v[j][0] + v[j][1]) + (v[j][2] + v[j][3]); }
        const float mean = wave_sum(s) * (1.f / DM); float s2 = 0.f;
#pragma unroll
        for (int j = 0; j < 8; ++j) { v[j] = v[j] - mean; s2 += (v[j][0] * v[j][0] + v[j][1] * v[j][1]) + (v[j][2] * v[j][2] + v[j][3] * v[j][3]); }
        const float rstd = 1.f / sqrtf(wave_sum(s2) * (1.f / DM) + LN_EPS);
        v2u* o8 = (v2u*)(H + (size_t)row * DM) + lane;
#pragma unroll
        for (int j = 0; j < 8; ++j) { const f32x4 sh = *((const f32x4*)(mod) + lane + 64 * j), sc = *((const f32x4*)(mod + DM) + lane + 64 * j);
            const f32x4 h = v[j] * rstd * (sc + 1.0f) + sh; v2u w; w.x = pk2(h[0], h[1]); w.y = pk2(h[2], h[3]); o8[64 * j] = w; }
    }
}

__device__ __forceinline__ void hy_pre_item(const Fr& F, int L, int item, LAS bf16* zt, LAS bf16* xt) {
    const int lane = F.lane; const bf16* PROJ = (const bf16*)(F.ws + WS_PROJ);
    int cb, n0, bt, lseq, tokbase; bf16 *ZT, *X0T;
    if (item < 1024) { cb = item & 7; const int tb = item >> 3; bt = tb >> 5; n0 = (tb & 31) * 64; lseq = SEQ; tokbase = bt * SEQ; ZT = (bf16*)(F.ws + WS_ZT); X0T = (bf16*)(F.ws + WS_X0T); }
    else { const int it = item - 1024; cb = it & 7; const int tb = it >> 3; bt = tb >> 2; n0 = (tb & 3) * 64; lseq = CTXL; tokbase = TLAT + bt * CTXL; ZT = (bf16*)(F.ws + WS_ZTC); X0T = (bf16*)(F.ws + WS_X0TC); }
    const int q = lane & 7, c0 = cb * 64 + 8 * q;
    float wgt[3][3][8], bias[3][8];
#pragma unroll
    for (int j = 0; j < 3; ++j) {
#pragma unroll
        for (int e = 0; e < 8; ++e) bias[j][e] = INP(IN_HYSB)[L * 1536 + j * 512 + c0 + e];
#pragma unroll
        for (int t = 0; t < 3; ++t)
#pragma unroll
            for (int e = 0; e < 8; ++e) wgt[j][t][e] = INP(IN_HYSW)[(L * 3 + t) * 1536 + j * 512 + c0 + e]; }
#pragma unroll 1
    for (int it = 0; it < 8; ++it) { const int tl = (lane >> 3) + 8 * it, n = n0 + tl; const bf16* rowp = PROJ + (size_t)(tokbase + n) * INCP + c0;
        float sj[3][8];
#pragma unroll
        for (int j = 0; j < 3; ++j) { const v4u z4 = (v4u){0u, 0u, 0u, 0u};
            const v4u rm = (n > 0) ? *(const v4u*)(rowp - INCP + j * 512) : z4, r0 = *(const v4u*)(rowp + j * 512), rp = (n < lseq - 1) ? *(const v4u*)(rowp + INCP + j * 512) : z4;
            const unsigned am[4] = {rm.x, rm.y, rm.z, rm.w}, a0[4] = {r0.x, r0.y, r0.z, r0.w}, ap[4] = {rp.x, rp.y, rp.z, rp.w};
#pragma unroll
            for (int e2 = 0; e2 < 4; ++e2) {
                sj[j][2 * e2] = wgt[j][0][2 * e2] * bflo(am[e2]) + wgt[j][1][2 * e2] * bflo(a0[e2]) + wgt[j][2][2 * e2] * bflo(ap[e2]) + bias[j][2 * e2];
                sj[j][2 * e2 + 1] = wgt[j][0][2 * e2 + 1] * bfhi(am[e2]) + wgt[j][1][2 * e2 + 1] * bfhi(a0[e2]) + wgt[j][2][2 * e2 + 1] * bfhi(ap[e2]) + bias[j][2 * e2 + 1]; } }
#pragma unroll
        for (int e = 0; e < 8; ++e) { zt[(8 * q + e) * 66 + tl] = (bf16)f2bf(sj[1][e] * sj[2][e]); xt[(8 * q + e) * 66 + tl] = (bf16)f2bf(sj[0][e]); } }
    LDS_WAIT(); asm volatile("" ::: "memory");
#pragma unroll 4
    for (int ch = 0; ch < 64; ++ch) { const size_t o = ((size_t)(cb * 64 + ch) * 4 + bt) * lseq + n0 + lane; ZT[o] = zt[ch * 66 + lane]; X0T[o] = xt[ch * 66 + lane]; }
    LDS_WAIT(); asm volatile("" ::: "memory");
}

template <int LSEQ>
__device__ __forceinline__ void hy_conv_item(const Fr& F, int c, const float* kfg, const bf16* ZT, const bf16* X0T, bf16* YT) {
    constexpr int CPLEN = 2 * LSEQ + 16, YOFF = LSEQ, ZOFF = 192, ZLEN = LSEQ + 416, NW = LSEQ / 256, NKS = (LSEQ + 192) / 32;
    LAS bf16* CP = (LAS bf16*)F.lds;
    LAS bf16* Z = CP + 8 * CPLEN;
    const int tid = F.tid;
#pragma unroll 8
    for (int idx = tid; idx < 8 * CPLEN; idx += NTHR) { const int sft = idx / CPLEN, y = idx - sft * CPLEN, k = 2 * LSEQ + sft - y;
        CP[idx] = (bf16)((k >= 1 && k <= 2 * LSEQ - 1) ? f2bf(kfg[k]) : 0u); }
#pragma unroll 3
    for (int idx = tid; idx < 4 * ZLEN / 8; idx += NTHR) { const int bt = idx / (ZLEN / 8), p8 = (idx - bt * (ZLEN / 8)) * 8, n = p8 - ZOFF;
        v4u v = (v4u){0u, 0u, 0u, 0u}; if (n >= 0 && n < LSEQ) v = *(const v4u*)(ZT + ((size_t)c * 4 + bt) * LSEQ + n);
        *(LAS v4u*)(Z + bt * ZLEN + p8) = v; }
    __syncthreads();
    if (F.wave < NW) {
        const int lane = F.lane, r16 = lane & 15, g = lane >> 4, a0 = 4 * F.wave, a = a0 + (r16 >> 2), bt = r16 & 3, jlo = -64 * (a0 + 3);
        const LAS bf16* ap = CP + (r16 & 7) * CPLEN + YOFF + jlo + 8 * g - 8 * (r16 >> 3);
        const LAS bf16* bp = Z + bt * ZLEN + ZOFF + 64 * a + jlo + 8 * g;
        f32x4 acc[4];
#pragma unroll
        for (int mb = 0; mb < 4; ++mb) acc[mb] = (f32x4){0.f, 0.f, 0.f, 0.f};
        bf16x8 T0 = *(const LAS bf16x8*)(ap), T1 = *(const LAS bf16x8*)(ap - 16), T2 = *(const LAS bf16x8*)(ap - 32), T3 = *(const LAS bf16x8*)(ap - 48);
#pragma unroll 2
        for (int ks = 0; ks < NKS; ++ks) {
            const bf16x8 B = *(const LAS bf16x8*)(bp + 32 * ks);
            acc[0] = __builtin_amdgcn_mfma_f32_16x16x32_bf16(T0, B, acc[0], 0, 0, 0); acc[1] = __builtin_amdgcn_mfma_f32_16x16x32_bf16(T1, B, acc[1], 0, 0, 0);
            acc[2] = __builtin_amdgcn_mfma_f32_16x16x32_bf16(T2, B, acc[2], 0, 0, 0); acc[3] = __builtin_amdgcn_mfma_f32_16x16x32_bf16(T3, B, acc[3], 0, 0, 0);
            T2 = T0; T3 = T1; T0 = *(const LAS bf16x8*)(ap + 32 * (ks + 1)); T1 = *(const LAS bf16x8*)(ap + 32 * (ks + 1) - 16);
        }
        const size_t rowo = ((size_t)c * 4 + bt) * LSEQ + 64 * a + 4 * g;
#pragma unroll
        for (int mb = 0; mb < 4; ++mb) { const v2u xw = *(const v2u*)(X0T + rowo + 16 * mb);
            v2u o; o.x = pk2(acc[mb][0] * bflo(xw.x), acc[mb][1] * bfhi(xw.x)); o.y = pk2(acc[mb][2] * bflo(xw.y), acc[mb][3] * bfhi(xw.y));
            *(v2u*)(YT + rowo + 16 * mb) = o; }
    }
    __syncthreads();
}

__device__ __forceinline__ void hy_post_item(const Fr& F, int L, int item) {
    const int lane = F.lane, w = F.wave;
    int bt, n0, lseq, tokbase; const bf16* YT;
    if (item < 128) { bt = item >> 5; n0 = (item & 31) * 64; lseq = SEQ; tokbase = bt * SEQ; YT = (const bf16*)(F.ws + WS_YT); }
    else { const int it = item - 128; bt = it >> 2; n0 = (it & 3) * 64; lseq = CTXL; tokbase = TLAT + bt * CTXL; YT = (const bf16*)(F.ws + WS_YTC); }
    LAS bf16* ys = (LAS bf16*)F.lds + w * (64 * 72);
    LAS float* part = (LAS float*)(F.lds + 8 * 64 * 72 * 2);
    float ss = 0.f;
#pragma unroll 4
    for (int ch = 0; ch < 64; ++ch) { const bf16 v = YT[((size_t)(64 * w + ch) * 4 + bt) * lseq + n0 + lane]; const float f = bf2f(v); ss += f * f; ys[lane * 72 + ch] = v; }
    part[w * 64 + lane] = ss;
    __syncthreads();
    bf16* MIX = (bf16*)(F.ws + WS_MIX); const float* nw = INP(IN_HYNW) + L * HYC + 64 * w + 8 * (lane & 7);
#pragma unroll 1
    for (int it = 0; it < 8; ++it) { const int tl = (lane >> 3) + 8 * it; float tot = 0.f;
#pragma unroll
        for (int ww = 0; ww < 8; ++ww) tot += part[ww * 64 + tl];
        const float rn = 1.0f / sqrtf(tot * (1.0f / 512.0f) + LN_EPS);
        const v4u v = *(const LAS v4u*)(ys + tl * 72 + 8 * (lane & 7));
        v4u o; o.x = pk2(bflo(v.x) * rn * nw[0], bfhi(v.x) * rn * nw[1]); o.y = pk2(bflo(v.y) * rn * nw[2], bfhi(v.y) * rn * nw[3]); o.z = pk2(bflo(v.z) * rn * nw[4], bfhi(v.z) * rn * nw[5]); o.w = pk2(bflo(v.w) * rn * nw[6], bfhi(v.w) * rn * nw[7]);
        *(v4u*)(MIX + (size_t)(tokbase + n0 + tl) * DM + 64 * w + 8 * (lane & 7)) = o; }
    __syncthreads();
}

__device__ __forceinline__ int gla_chunk_base(int b, int dir, int s, bool& is_ctx) {
    if (s < 4) { is_ctx = true; const int cc = dir ? 3 - s : s; return TLAT + b * CTXL + cc * 64; }
    is_ctx = false; const int lc = dir ? 35 - s : s - 4; return b * SEQ + lc * 64;
}
constexpr int GLP = 72;
template <bool WITH_Q>
__device__ __forceinline__ void gla_stage_raw(const Fr& F, int h, int base, LAS bf16* RK, LAS bf16* RQ, LAS bf16* RG, LAS bf16* VTs) {
    const bf16* PROJ = (const bf16*)(F.ws + WS_PROJ); const int tl = 8 * F.wave + (F.lane >> 3), c = F.lane & 7;
    const bf16* rp = PROJ + (size_t)(base + tl) * INCP;
    *(LAS v4u*)(RK + tl * GLP + 8 * c) = *(const v4u*)(rp + C_GK + h * 64 + 8 * c);
    if (WITH_Q) *(LAS v4u*)(RQ + tl * GLP + 8 * c) = *(const v4u*)(rp + C_GQ + h * 64 + 8 * c);
    if (c < 4) *(LAS v4u*)(RG + tl * 32 + 8 * c) = *(const v4u*)(rp + C_GA + 8 * c);
    const v4u a = *(const v4u*)(rp + C_GV + h * 128 + 8 * c), b = *(const v4u*)(rp + C_GV + h * 128 + 64 + 8 * c);
    const unsigned wa[4] = {a.x, a.y, a.z, a.w}, wb[4] = {b.x, b.y, b.z, b.w};
#pragma unroll
    for (int e = 0; e < 4; ++e) { VTs[(8 * c + 2 * e) * GLP + tl] = (bf16)(wa[e] & 0xffffu); VTs[(8 * c + 2 * e + 1) * GLP + tl] = (bf16)(wa[e] >> 16);
        VTs[(64 + 8 * c + 2 * e) * GLP + tl] = (bf16)(wb[e] & 0xffffu); VTs[(64 + 8 * c + 2 * e + 1) * GLP + tl] = (bf16)(wb[e] >> 16); }
}
__device__ __forceinline__ void gla_gate_scan(const Fr& F, int L, int h, int dir, const LAS bf16* RG, float (&cf)[8], float (&la)[8]) {
    const int lane = F.lane;
    const v4u g0 = *(const LAS v4u*)(RG + lane * 32 + dir * 16), g1 = *(const LAS v4u*)(RG + lane * 32 + dir * 16 + 8);
    const float ga[16] = {bflo(g0.x), bfhi(g0.x), bflo(g0.y), bfhi(g0.y), bflo(g0.z), bfhi(g0.z), bflo(g0.w), bfhi(g0.w), bflo(g1.x), bfhi(g1.x), bflo(g1.y), bfhi(g1.y), bflo(g1.z), bfhi(g1.z), bflo(g1.w), bfhi(g1.w)};
    const float* w2 = INP(IN_GAW2) + (size_t)(L * 2 + dir) * 16 * 384 + h * 64 + F.wave * 8; const float* gb = INP(IN_GAB) + (L * 2 + dir) * 384 + h * 64 + F.wave * 8;
#pragma unroll
    for (int e = 0; e < 8; ++e) { float z = gb[e];
#pragma unroll
        for (int r = 0; r < 16; ++r) z += ga[r] * w2[r * 384 + e];
        la[e] = logsigmoid_f(z) * (1.0f / 16.0f);
        float v = la[e];
#pragma unroll
        for (int off = 1; off < 64; off <<= 1) { const float u = __shfl_up(v, off); if (lane >= off) v += u; }
        cf[e] = v; }
}
__device__ __forceinline__ void gla_load_rope(const Fr& F, const LAS bf16* R, int tok, bool is_ctx, float (&x)[8]) {
    const int w = F.wave; const LAS bf16* p = R + F.lane * GLP + 8 * w; const v4u a = *(const LAS v4u*)p;
    const float own[8] = {bflo(a.x), bfhi(a.x), bflo(a.y), bfhi(a.y), bflo(a.z), bfhi(a.z), bflo(a.w), bfhi(a.w)};
    if (is_ctx) {
#pragma unroll
        for (int e = 0; e < 8; ++e) x[e] = own[e];
        return; }
    const bool first = (w & 3) < 2;
    const v4u bq = *(const LAS v4u*)(first ? p + 16 : p - 16);
    const float oth[8] = {bflo(bq.x), bfhi(bq.x), bflo(bq.y), bfhi(bq.y), bflo(bq.z), bfhi(bq.z), bflo(bq.w), bfhi(bq.w)};
    const int t = tok & (SEQ - 1); const float pos = (w >= 4) ? (float)(t & 63) : (float)(t >> 6);
#pragma unroll
    for (int e = 0; e < 8; ++e) { const int ai = (8 * w + e) & 15; const float ang = pos * __expf(-(float)ai * (9.210340371976184f / 16.0f)); const float sn = __sinf(ang), cs = __cosf(ang);
        x[e] = first ? own[e] * cs - oth[e] * sn : oth[e] * sn + own[e] * cs; }
}
__device__ __forceinline__ void gla_g1_item(const Fr& F, int L, int item) {
    const int ci = item % GSTEPS, bh = item / GSTEPS, h = bh % GH, b = bh / GH;
    const bool is_ctx = ci < 4; const int base = is_ctx ? TLAT + b * CTXL + ci * 64 : b * SEQ + (ci - 4) * 64;
    LAS bf16* VTs = (LAS bf16*)F.lds; LAS bf16* KT0 = VTs + 128 * GLP; LAS bf16* KT1 = KT0 + 64 * GLP; LAS float* Cs = (LAS float*)(KT1 + 64 * GLP); LAS bf16* RK = (LAS bf16*)(Cs + 128); LAS bf16* RG = RK + 64 * GLP;
    const int lane = F.lane, w = F.wave;
    gla_stage_raw<false>(F, h, base, RK, nullptr, RG, VTs);
    __syncthreads();
    float kx[8];
    gla_load_rope(F, RK, base + lane, is_ctx, kx);
#pragma unroll
    for (int dir = 0; dir < 2; ++dir) { float cf[8], la[8];
        gla_gate_scan(F, L, h, dir, RG, cf, la);
        { float* cfp = (float*)(F.ws + WS_CF) + ((size_t)(base + lane) * 2 + dir) * 384 + h * 64 + 8 * w;
          *(f32x4*)cfp = (f32x4){cf[0], cf[1], cf[2], cf[3]}; *(f32x4*)(cfp + 4) = (f32x4){cf[4], cf[5], cf[6], cf[7]}; }
        LAS bf16* KTs = dir ? KT1 : KT0;
#pragma unroll
        for (int e = 0; e < 8; ++e) { const float kt = kx[e] * __expf(dir ? (cf[e] - la[e]) : -cf[e]); KTs[(8 * w + e) * GLP + lane] = (bf16)f2bf(kt); if (lane == 63) Cs[dir * 64 + 8 * w + e] = cf[e]; } }
    __syncthreads();
    const int r16 = lane & 15, g = lane >> 4;
    bf16x8 va[2];
#pragma unroll
    for (int ks = 0; ks < 2; ++ks) va[ks] = *(const LAS bf16x8*)(VTs + (16 * w + r16) * GLP + 8 * g + 32 * ks);
#pragma unroll
    for (int dir = 0; dir < 2; ++dir) {
        const int step = is_ctx ? (dir ? 3 - ci : ci) : (dir ? 39 - ci : ci); const size_t slot = (size_t)((b * GH + h) * 2 + dir) * GSTEPS + step;
        if (F.tid < 64) ((float*)(F.ws + WS_DEC))[slot * 64 + F.tid] = __expf(Cs[dir * 64 + F.tid]);
        const LAS bf16* KTs = dir ? KT1 : KT0; bf16* U = (bf16*)(F.ws + WS_ST) + slot * 8192;
#pragma unroll
        for (int ib = 0; ib < 4; ++ib) { f32x4 acc = (f32x4){0.f, 0.f, 0.f, 0.f};
#pragma unroll
            for (int ks = 0; ks < 2; ++ks) acc = __builtin_amdgcn_mfma_f32_16x16x32_bf16(va[ks], *(const LAS bf16x8*)(KTs + (16 * ib + r16) * GLP + 8 * g + 32 * ks), acc, 0, 0, 0);
            const int i = 16 * ib + r16; const float sc = dir ? 1.0f : __expf(Cs[i]);
#pragma unroll
            for (int e = 0; e < 4; ++e) U[(16 * w + 4 * g + e) * 64 + i] = (bf16)f2bf(acc[e] * sc); } }
    __syncthreads();
}

__device__ __forceinline__ void vt_item(const Fr& F, int item, LAS unsigned* st) {
    const int lane = F.lane; const bf16* PROJ = (const bf16*)(F.ws + WS_PROJ);
    int b, h, tok0, t0; bf16 *VT, *KT;
    if (item < NB * NAH * 32) { const int tb = item & 31, bh = item >> 5; b = bh / NAH; h = bh % NAH; t0 = tb * 64; tok0 = b * SEQ + t0; VT = (bf16*)(F.ws + WS_VTL) + (size_t)bh * 128 * SEQ; KT = (bf16*)(F.ws + WS_KTL) + (size_t)bh * 128 * SEQ; }
    else { const int it = item - NB * NAH * 32, tb = it & 3, bh = it >> 2; b = bh / NAH; h = bh % NAH; t0 = tb * 64; tok0 = TLAT + b * CTXL + t0; VT = (bf16*)(F.ws + WS_VTC) + (size_t)bh * 128 * CTXL; KT = (bf16*)(F.ws + WS_KTC) + (size_t)bh * 128 * CTXL; }
#pragma unroll 4
    for (int idx = lane; idx < 64 * 16; idx += 64) { const int tok = idx >> 4, ch = idx & 15; const bf16* rp = PROJ + (size_t)(tok0 + tok) * INCP + h * 128 + ch * 8;
        const v4u w = *(const v4u*)(rp + C_NV), kq = *(const v4u*)(rp + C_NK);
        LAS unsigned* p = st + tok * 65 + ch * 4; p[0] = w.x; p[1] = w.y; p[2] = w.z; p[3] = w.w;
        *(v4u*)(KT + (size_t)((t0 + tok) >> 3) * 1024 + (ch >> 2) * 256 + (tok & 7) * 32 + ((ch & 3) ^ (2 * (((t0 + tok) >> 3) & 1))) * 8) = kq; }
    LDS_WAIT(); asm volatile("" ::: "memory");
    bf16* vo = VT + (size_t)((t0 + lane) >> 3) * 1024 + (lane & 7);
#pragma unroll 4
    for (int d2 = 0; d2 < 64; ++d2) { const unsigned w = st[lane * 65 + d2]; vo[(2 * d2) * 8] = (bf16)(w & 0xffffu); vo[(2 * d2 + 1) * 8] = (bf16)(w >> 16); }
    LDS_WAIT(); asm volatile("" ::: "memory");
}
template <bool LAT>
__device__ __forceinline__ void na_mfma_item(const Fr& F, int L, int tile, int h, const LAS float* rpb) {
    const int lane = F.lane, qi = lane & 15, g = lane >> 4;
    const bf16* PROJ = (const bf16*)(F.ws + WS_PROJ);
    int b, r = 0, j = 0, qbase;
    if (LAT) { b = tile >> 7; const int rem = tile & 127; r = rem >> 2; j = rem & 3; qbase = b * SEQ + r * 64 + j * 16; }
    else { b = tile >> 4; qbase = TLAT + b * CTXL + (tile & 15) * 16; }
    const int r0 = min(max(r - 4, 0), 24), cs = min(max(16 * j - 8, 0), 32), c = 16 * j + qi, c0 = min(max(c - 8, 0), 48);
    const int ctx0 = TLAT + b * CTXL;
    bf16x8 bq[4];
    { const bf16* qp = PROJ + (size_t)(qbase + qi) * INCP + C_NQ + h * 128 + g * 8;
#pragma unroll
      for (int ks = 0; ks < 4; ++ks) bq[ks] = *(const bf16x8*)(qp + ks * 32); }
    constexpr int NKB = LAT ? 32 : 16, NLOC = LAT ? 16 : 0;
    f32x4 S[NKB];
    const bf16* ktl = (const bf16*)(F.ws + WS_KTL) + (size_t)(b * NAH + h) * 128 * SEQ + (qi >> 2) * 1024 + (qi & 3) * 32 + (g ^ (2 * (((cs >> 3) + (qi >> 2)) & 1))) * 8;
    const bf16* ktc = (const bf16*)(F.ws + WS_KTC) + (size_t)(b * NAH + h) * 128 * CTXL + (qi >> 2) * 1024 + (qi & 3) * 32 + (g ^ (2 * ((qi >> 2) & 1))) * 8;
#define NA_KP(kb) (((kb) < NLOC) ? ktl + (((r0 + ((kb) >> 1)) * 64 + cs) >> 3) * 1024 + ((kb) & 1) * 128 : ktc + (((kb) - NLOC) >> 1) * 4096 + ((kb) & 1) * 128)
#define NA_LOADK(dst, kb) do { const bf16* kp_ = NA_KP(kb); _Pragma("unroll") for (int ks = 0; ks < 4; ++ks) dst[ks] = *(const bf16x8*)(kp_ + ks * 256); } while (0)
    bf16x8 k0[4], k1[4], k2[4], k3[4], k4[4];
#define NA_QK(ka, kb_) do { f32x4 acc0 = (f32x4){0.f, 0.f, 0.f, 0.f}; \
        _Pragma("unroll") for (int ks = 0; ks < 4; ++ks) acc0 = __builtin_amdgcn_mfma_f32_16x16x32_bf16(ka[ks], bq[ks], acc0, 0, 0, 0); \
        S[kb_] = acc0; } while (0)
    NA_LOADK(k0, 0); NA_LOADK(k1, 1); NA_LOADK(k2, 2); NA_LOADK(k3, 3);
    if (0 < NKB) { if (0 + 4 < NKB) NA_LOADK(k4, 0 + 4); __builtin_amdgcn_sched_barrier(0); NA_QK(k0, 0); __builtin_amdgcn_sched_barrier(0); }
    if (1 < NKB) { if (1 + 4 < NKB) NA_LOADK(k0, 1 + 4); __builtin_amdgcn_sched_barrier(0); NA_QK(k1, 1); __builtin_amdgcn_sched_barrier(0); }
    if (2 < NKB) { if (2 + 4 < NKB) NA_LOADK(k1, 2 + 4); __builtin_amdgcn_sched_barrier(0); NA_QK(k2, 2); __builtin_amdgcn_sched_barrier(0); }
    if (3 < NKB) { if (3 + 4 < NKB) NA_LOADK(k2, 3 + 4); __builtin_amdgcn_sched_barrier(0); NA_QK(k3, 3); __builtin_amdgcn_sched_barrier(0); }
    if (4 < NKB) { if (4 + 4 < NKB) NA_LOADK(k3, 4 + 4); __builtin_amdgcn_sched_barrier(0); NA_QK(k4, 4); __builtin_amdgcn_sched_barrier(0); }
    if (5 < NKB) { if (5 + 4 < NKB) NA_LOADK(k4, 5 + 4); __builtin_amdgcn_sched_barrier(0); NA_QK(k0, 5); __builtin_amdgcn_sched_barrier(0); }
    if (6 < NKB) { if (6 + 4 < NKB) NA_LOADK(k0, 6 + 4); __builtin_amdgcn_sched_barrier(0); NA_QK(k1, 6); __builtin_amdgcn_sched_barrier(0); }
    if (7 < NKB) { if (7 + 4 < NKB) NA_LOADK(k1, 7 + 4); __builtin_amdgcn_sched_barrier(0); NA_QK(k2, 7); __builtin_amdgcn_sched_barrier(0); }
    if (8 < NKB) { if (8 + 4 < NKB) NA_LOADK(k2, 8 + 4); __builtin_amdgcn_sched_barrier(0); NA_QK(k3, 8); __builtin_amdgcn_sched_barrier(0); }
    if (9 < NKB) { if (9 + 4 < NKB) NA_LOADK(k3, 9 + 4); __builtin_amdgcn_sched_barrier(0); NA_QK(k4, 9); __builtin_amdgcn_sched_barrier(0); }
    if (10 < NKB) { if (10 + 4 < NKB) NA_LOADK(k4, 10 + 4); __builtin_amdgcn_sched_barrier(0); NA_QK(k0, 10); __builtin_amdgcn_sched_barrier(0); }
    if (11 < NKB) { if (11 + 4 < NKB) NA_LOADK(k0, 11 + 4); __builtin_amdgcn_sched_barrier(0); NA_QK(k1, 11); __builtin_amdgcn_sched_barrier(0); }
    if (12 < NKB) { if (12 + 4 < NKB) NA_LOADK(k1, 12 + 4); __builtin_amdgcn_sched_barrier(0); NA_QK(k2, 12); __builtin_amdgcn_sched_barrier(0); }
    if (13 < NKB) { if (13 + 4 < NKB) NA_LOADK(k2, 13 + 4); __builtin_amdgcn_sched_barrier(0); NA_QK(k3, 13); __builtin_amdgcn_sched_barrier(0); }
    if (14 < NKB) { if (14 + 4 < NKB) NA_LOADK(k3, 14 + 4); __builtin_amdgcn_sched_barrier(0); NA_QK(k4, 14); __builtin_amdgcn_sched_barrier(0); }
    if (15 < NKB) { if (15 + 4 < NKB) NA_LOADK(k4, 15 + 4); __builtin_amdgcn_sched_barrier(0); NA_QK(k0, 15); __builtin_amdgcn_sched_barrier(0); }
    if (16 < NKB) { if (16 + 4 < NKB) NA_LOADK(k0, 16 + 4); __builtin_amdgcn_sched_barrier(0); NA_QK(k1, 16); __builtin_amdgcn_sched_barrier(0); }
    if (17 < NKB) { if (17 + 4 < NKB) NA_LOADK(k1, 17 + 4); __builtin_amdgcn_sched_barrier(0); NA_QK(k2, 17); __builtin_amdgcn_sched_barrier(0); }
    if (18 < NKB) { if (18 + 4 < NKB) NA_LOADK(k2, 18 + 4); __builtin_amdgcn_sched_barrier(0); NA_QK(k3, 18); __builtin_amdgcn_sched_barrier(0); }
    if (19 < NKB) { if (19 + 4 < NKB) NA_LOADK(k3, 19 + 4); __builtin_amdgcn_sched_barrier(0); NA_QK(k4, 19); __builtin_amdgcn_sched_barrier(0); }
    if (20 < NKB) { if (20 + 4 < NKB) NA_LOADK(k4, 20 + 4); __builtin_amdgcn_sched_barrier(0); NA_QK(k0, 20); __builtin_amdgcn_sched_barrier(0); }
    if (21 < NKB) { if (21 + 4 < NKB) NA_LOADK(k0, 21 + 4); __builtin_amdgcn_sched_barrier(0); NA_QK(k1, 21); __builtin_amdgcn_sched_barrier(0); }
    if (22 < NKB) { if (22 + 4 < NKB) NA_LOADK(k1, 22 + 4); __builtin_amdgcn_sched_barrier(0); NA_QK(k2, 22); __builtin_amdgcn_sched_barrier(0); }
    if (23 < NKB) { if (23 + 4 < NKB) NA_LOADK(k2, 23 + 4); __builtin_amdgcn_sched_barrier(0); NA_QK(k3, 23); __builtin_amdgcn_sched_barrier(0); }
    if (24 < NKB) { if (24 + 4 < NKB) NA_LOADK(k3, 24 + 4); __builtin_amdgcn_sched_barrier(0); NA_QK(k4, 24); __builtin_amdgcn_sched_barrier(0); }
    if (25 < NKB) { if (25 + 4 < NKB) NA_LOADK(k4, 25 + 4); __builtin_amdgcn_sched_barrier(0); NA_QK(k0, 25); __builtin_amdgcn_sched_barrier(0); }
    if (26 < NKB) { if (26 + 4 < NKB) NA_LOADK(k0, 26 + 4); __builtin_amdgcn_sched_barrier(0); NA_QK(k1, 26); __builtin_amdgcn_sched_barrier(0); }
    if (27 < NKB) { if (27 + 4 < NKB) NA_LOADK(k1, 27 + 4); __builtin_amdgcn_sched_barrier(0); NA_QK(k2, 27); __builtin_amdgcn_sched_barrier(0); }
    if (28 < NKB) { if (28 + 4 < NKB) NA_LOADK(k2, 28 + 4); __builtin_amdgcn_sched_barrier(0); NA_QK(k3, 28); __builtin_amdgcn_sched_barrier(0); }
    if (29 < NKB) { if (29 + 4 < NKB) NA_LOADK(k3, 29 + 4); __builtin_amdgcn_sched_barrier(0); NA_QK(k4, 29); __builtin_amdgcn_sched_barrier(0); }
    if (30 < NKB) { if (30 + 4 < NKB) NA_LOADK(k4, 30 + 4); __builtin_amdgcn_sched_barrier(0); NA_QK(k0, 30); __builtin_amdgcn_sched_barrier(0); }
    if (31 < NKB) { if (31 + 4 < NKB) NA_LOADK(k0, 31 + 4); __builtin_amdgcn_sched_barrier(0); NA_QK(k1, 31); __builtin_amdgcn_sched_barrier(0); }
#undef NA_QK
#undef NA_LOADK
#undef NA_KP
    float mx = -3.0e38f;
#pragma unroll
    for (int kb = 0; kb < NKB; ++kb)
#pragma unroll
        for (int i = 0; i < 4; ++i) { float sv = S[kb][i] * 0.08838834764831845f;
            if (kb < NLOC) { const int kc = cs + (kb & 1) * 4 + 8 * g + i; const bool ok = (kc >= c0) && (kc < c0 + 16); const int rel = min(max(kc - c + 15, 0), 30);
                const float bias = rpb[h * 465 + (r0 + (kb >> 1) - r + 7) * 31 + rel]; sv = ok ? sv + bias * 0.6931471805599453f : -3.0e38f;     }
            S[kb][i] = sv; mx = fmaxf(mx, sv); }
    mx = fmaxf(mx, __shfl_xor(mx, 16)); mx = fmaxf(mx, __shfl_xor(mx, 32));
    float sum = 0.f;
#pragma unroll
    for (int kb = 0; kb < NKB; ++kb)
#pragma unroll
        for (int i = 0; i < 4; ++i) { const float p = __expf(S[kb][i] - mx); S[kb][i] = p; sum += p; }
    sum += __shfl_xor(sum, 16); sum += __shfl_xor(sum, 32);
    const float inv = 1.0f / sum;
    f32x4 O[8];
#pragma unroll
    for (int db = 0; db < 8; ++db) O[db] = (f32x4){0.f, 0.f, 0.f, 0.f};
    const bf16* VTL = (const bf16*)(F.ws + WS_VTL) + (size_t)(b * NAH + h) * 128 * SEQ + g * 1024 + qi * 8;
    const bf16* VTC = (const bf16*)(F.ws + WS_VTC) + (size_t)(b * NAH + h) * 128 * CTXL + g * 1024 + qi * 8;
#define NA_VB(s2) (((s2) < NLOC / 2) ? VTL + (((r0 + (s2)) * 64 + cs) >> 3) * 1024 : VTC + ((s2) - NLOC / 2) * 4096)
#define NA_LOADV(dst, s2) do { const bf16* vb_ = NA_VB(s2); _Pragma("unroll") for (int db = 0; db < 8; ++db) dst[db] = *(const v4u*)(vb_ + db * 128); } while (0)
#define NA_PV(src, s2) do { const bf16x8 pf = __builtin_bit_cast(bf16x8, P[s2]); _Pragma("unroll") for (int db = 0; db < 8; ++db) O[db] = __builtin_amdgcn_mfma_f32_16x16x32_bf16(__builtin_bit_cast(bf16x8, src[db]), pf, O[db], 0, 0, 0); } while (0)
    v4u P[NKB / 2];
#pragma unroll
    for (int s2 = 0; s2 < NKB / 2; ++s2) { P[s2].x = pk2(S[2 * s2][0], S[2 * s2][1]); P[s2].y = pk2(S[2 * s2][2], S[2 * s2][3]); P[s2].z = pk2(S[2 * s2 + 1][0], S[2 * s2 + 1][1]); P[s2].w = pk2(S[2 * s2 + 1][2], S[2 * s2 + 1][3]); }
#pragma unroll
    for (int s2 = 0; s2 < NKB / 2; ++s2) asm volatile("" : "+v"(P[s2]));
    v4u va[8], vb[8];
    NA_LOADV(va, 0);
#pragma unroll
    for (int s2 = 0; s2 < NKB / 2; s2 += 2) {
        NA_LOADV(vb, s2 + 1);
        __builtin_amdgcn_sched_barrier(0);
        NA_PV(va, s2);
        __builtin_amdgcn_sched_barrier(0);
        if (s2 + 2 < NKB / 2) NA_LOADV(va, s2 + 2);
        __builtin_amdgcn_sched_barrier(0);
        NA_PV(vb, s2 + 1);
        __builtin_amdgcn_sched_barrier(0);
    }
#undef NA_VB
#undef NA_LOADV
#undef NA_PV
    bf16* op = (bf16*)(F.ws + WS_MIX) + (size_t)(qbase + qi) * DM + M_NA + h * 128 + 4 * g;
#pragma unroll
    for (int db = 0; db < 8; ++db) { v2u w; w.x = pk2(O[db][0] * inv, O[db][1] * inv); w.y = pk2(O[db][2] * inv, O[db][3] * inv); *(v2u*)(op + db * 16) = w; }
}

__device__ __forceinline__ void p3_mixers1(Fr F, int L) {
    RELAUNDER(F);
#ifndef REPMASK
#define REPMASK 0
#endif
    for (int rep = 0; rep < 1 + ((REPMASK >> 1) & 1); ++rep)
    for (int it = F.bid; it < NB * GH * GSTEPS; it += F.G) gla_g1_item(F, L, it);
    __syncthreads();
    const int gw = F.bid * NWAVES + F.wave, NGW = F.G * NWAVES;
    { LAS unsigned* st = (LAS unsigned*)(F.lds + F.wave * 16640);
      for (int rep = 0; rep < 1 + ((REPMASK >> 4) & 1); ++rep)
      for (int it = gw; it < NB * NAH * 36; it += NGW) vt_item(F, it, st); }
    __syncthreads();
    { LAS bf16* zt = (LAS bf16*)(F.lds + F.wave * 16896); LAS bf16* xt = zt + 64 * 66;
      const int n_pre = 1024 + ((L == 0) ? 128 : 0);
      for (int rep = 0; rep < 1 + ((REPMASK >> 4) & 1); ++rep)
      for (int it = NGW - 1 - gw; it < n_pre; it += NGW) hy_pre_item(F, L, it, zt, xt); }
}

constexpr int NBU_STATS = 11264, NBU_BUF0 = 12288, NBU_BUFSZ = 49152, NBU_XCH = 110592, NBU_UNITS = NB * NAH * 32;
__device__ __forceinline__ void na_block_units(const Fr& F, int L, const LAS float* rpb, const XcdBarrier& bar) {
    const int lane = F.lane, qi = lane & 15, g = lane >> 4, tid = F.tid, j = F.wave & 3, part = F.wave >> 2;
    LAS unsigned char* lb = F.lds;
    LAS float* stats = (LAS float*)(lb + NBU_STATS);
    const bf16* PROJ = (const bf16*)(F.ws + WS_PROJ);
    const int cs = min(max(16 * j - 8, 0), 32), c = 16 * j + qi, c0 = min(max(c - 8, 0), 48);
    int rel8[8]; bool ok8[8];
#pragma unroll
    for (int e = 0; e < 8; ++e) { const int kc = cs + (e >> 2) * 4 + 8 * g + (e & 3); ok8[e] = (kc >= c0) && (kc < c0 + 16); rel8[e] = min(max(kc - c + 15, 0), 30); }
#define NB_DMA(unit_, s_, buf_) do { const int bh_ = (unit_) >> 5, r_ = (unit_) & 31, r0_ = min(max(r_ - 4, 0), 24), sk_ = (s_) & 3; \
        const bf16* sl_ = (const bf16*)(F.ws + (((s_) < 4) ? WS_KTL : WS_VTL)) + (size_t)bh_ * 128 * SEQ + (size_t)(r0_ + 2 * sk_) * 8192; \
        const bf16* sc_ = (const bf16*)(F.ws + (((s_) < 4) ? WS_KTC : WS_VTC)) + (size_t)bh_ * 128 * CTXL + sk_ * 8192; \
        LAS unsigned char* d_ = lb + NBU_BUF0 + (buf_) * NBU_BUFSZ + F.wave * 1024; \
        _Pragma("unroll") for (int k = 0; k < 4; ++k) __builtin_amdgcn_global_load_lds((const unsigned*)(sl_ + (tid + 512 * k) * 8), (LAS unsigned*)(d_ + k * 8192), 16, 0, 0); \
        _Pragma("unroll") for (int k = 0; k < 2; ++k) __builtin_amdgcn_global_load_lds((const unsigned*)(sc_ + (tid + 512 * k) * 8), (LAS unsigned*)(d_ + (4 + k) * 8192), 16, 0, 0); } while (0)
#define NB_LANDED() do { asm volatile("s_waitcnt vmcnt(0)" ::: "memory"); __syncthreads(); } while (0)
    volatile LAS unsigned* cen = (volatile LAS unsigned*)(F.lds + LDSCTL_OFF + 32);
    const unsigned xn = cen[0], xx = cen[1], xr = cen[2];
    const bool xmap = (xn == 32u) && (xx == 8u) && (bar.x < 8u) && (xr < 32u) && (F.G == 256);
    const int ustep = xmap ? 32 : F.G;
    int unit = xmap ? (int)((3u * bar.x) << 5) + (int)xr : F.bid;
    const int uend = xmap ? unit + 96 : NBU_UNITS;
    if (unit < uend) NB_DMA(unit, 0, 0);
    NB_LANDED();
    const int koff = (part ? 16384 : (cs >> 3) * 1024) + (qi >> 2) * 1024 + (qi & 3) * 32 + (g ^ (2 * (((part ? 0 : (cs >> 3)) + (qi >> 2)) & 1))) * 8;
    const int kstep1 = 128, kstep2 = part ? 4096 : 8192;
    const int voff = (part ? 16384 : (cs >> 3) * 1024) + g * 1024 + qi * 8;
    const int vstep = part ? 4096 : 8192;
    for (; unit < uend; unit += ustep) {
        const int bh = unit >> 5, r = unit & 31, b = bh / NAH, h = bh - b * NAH, r0 = min(max(r - 4, 0), 24);
        const int qbase = b * SEQ + r * 64 + j * 16;
        bf16x8 bq[4];
        { const bf16* qp = PROJ + (size_t)(qbase + qi) * INCP + C_NQ + h * 128 + g * 8;
#pragma unroll
          for (int ks = 0; ks < 4; ++ks) bq[ks] = *(const bf16x8*)(qp + ks * 32); }
        f32x4 S[16];
        const int nxt = unit + ustep;
#pragma unroll
        for (int s = 0; s < 4; ++s) {
            NB_DMA(unit, s + 1, (s + 1) & 1);
            if ((REPMASK >> 24) & 1) NB_DMA(unit, s + 1, (s + 1) & 1);
            __builtin_amdgcn_sched_barrier(0);
            const LAS bf16* kb_ = (const LAS bf16*)(lb + NBU_BUF0 + (s & 1) * NBU_BUFSZ) + koff;
            for (int rq = 0; rq < 1 + ((REPMASK >> 22) & 1); ++rq) { asm volatile("" ::: "memory");
#pragma unroll
            for (int t4 = 0; t4 < 4; ++t4) { const LAS bf16* kp = kb_ + (t4 & 1) * kstep1 + (t4 >> 1) * kstep2;
                f32x4 acc0 = (f32x4){0.f, 0.f, 0.f, 0.f};
#pragma unroll
                for (int ks = 0; ks < 4; ++ks) acc0 = __builtin_amdgcn_mfma_f32_16x16x32_bf16(*(const LAS bf16x8*)(kp + ks * 256), bq[ks], acc0, 0, 0, 0);
                S[4 * s + t4] = acc0; }
            }
            __builtin_amdgcn_sched_barrier(0);
            if (s == 3) {
                float mx = -3.0e38f;
                if (!part) {
                    const LAS float* rb = rpb + h * 465 + (r0 - r + 7) * 31;
#pragma unroll
                    for (int kb = 0; kb < 16; ++kb)
#pragma unroll
                        for (int i = 0; i < 4; ++i) { const int e = (kb & 1) * 4 + i;
                            const float t = fmaf(S[kb][i], 0.08838834764831845f * 1.4426950408889634f, rb[(kb >> 1) * 31 + rel8[e]]);
                            const float sv = ok8[e] ? t : -3.0e38f; S[kb][i] = sv; mx = fmaxf(mx, sv); }
                } else {
#pragma unroll
                    for (int kb = 0; kb < 16; ++kb)
#pragma unroll
                        for (int i = 0; i < 4; ++i) { const float sv = S[kb][i] * (0.08838834764831845f * 1.4426950408889634f); S[kb][i] = sv; mx = fmaxf(mx, sv); }
                }
                mx = fmaxf(mx, __shfl_xor(mx, 16)); mx = fmaxf(mx, __shfl_xor(mx, 32));
                if (g == 0) stats[F.wave * 16 + qi] = mx;
            }
            NB_LANDED();
        }
        const float mxa = fmaxf(stats[j * 16 + qi], stats[(4 + j) * 16 + qi]);
        float sum = 0.f;
#pragma unroll
        for (int kb = 0; kb < 16; ++kb)
#pragma unroll
            for (int i = 0; i < 4; ++i) { const float p = __builtin_amdgcn_exp2f(S[kb][i] - mxa); S[kb][i] = p; sum += p; }
        sum += __shfl_xor(sum, 16); sum += __shfl_xor(sum, 32);
        v4u P[8];
#pragma unroll
        for (int s2 = 0; s2 < 8; ++s2) { P[s2].x = pk2(S[2 * s2][0], S[2 * s2][1]); P[s2].y = pk2(S[2 * s2][2], S[2 * s2][3]); P[s2].z = pk2(S[2 * s2 + 1][0], S[2 * s2 + 1][1]); P[s2].w = pk2(S[2 * s2 + 1][2], S[2 * s2 + 1][3]); }
        f32x4 O[8];
#pragma unroll
        for (int db = 0; db < 8; ++db) O[db] = (f32x4){0.f, 0.f, 0.f, 0.f};
#pragma unroll
        for (int s = 4; s < 8; ++s) {
            if (s < 7) NB_DMA(unit, s + 1, (s + 1) & 1); else if (nxt < uend) NB_DMA(nxt, 0, 0);
            if ((REPMASK >> 24) & 1) { if (s < 7) NB_DMA(unit, s + 1, (s + 1) & 1); else if (nxt < uend) NB_DMA(nxt, 0, 0); }
            __builtin_amdgcn_sched_barrier(0);
            const LAS bf16* vb_ = (const LAS bf16*)(lb + NBU_BUF0 + (s & 1) * NBU_BUFSZ) + voff;
            bf16x8 vf[2][8];
#pragma unroll
            for (int t2 = 0; t2 < 2; ++t2)
#pragma unroll
                for (int db = 0; db < 8; ++db) vf[t2][db] = *(const LAS bf16x8*)(vb_ + t2 * vstep + db * 128);
            __builtin_amdgcn_sched_barrier(0);
#pragma unroll
            for (int t2 = 0; t2 < 2; ++t2) { const bf16x8 pf = __builtin_bit_cast(bf16x8, P[2 * (s - 4) + t2]);
#pragma unroll
                for (int db = 0; db < 8; ++db) O[db] = __builtin_amdgcn_mfma_f32_16x16x32_bf16(vf[t2][db], pf, O[db], 0, 0, 0); }
            __builtin_amdgcn_sched_barrier(0);
            if (s == 7 && part) {
                LAS f32x4* xo = (LAS f32x4*)(lb + NBU_XCH) + j * 512 + lane;
#pragma unroll
                for (int db = 0; db < 8; ++db) xo[db * 64] = O[db];
                if (g == 0) stats[128 + j * 16 + qi] = sum;
            }
            NB_LANDED();
        }
        if (!part) {
            const LAS f32x4* xo = (const LAS f32x4*)(lb + NBU_XCH) + j * 512 + lane;
            const float inv = 1.0f / (sum + stats[128 + j * 16 + qi]);
            bf16* op = (bf16*)(F.ws + WS_MIX) + (size_t)(qbase + qi) * DM + M_NA + h * 128 + 4 * g;
#pragma unroll
            for (int db = 0; db < 8; ++db) { const f32x4 o = O[db] + xo[db * 64]; v2u w; w.x = pk2(o[0] * inv, o[1] * inv); w.y = pk2(o[2] * inv, o[3] * inv); *(v2u*)(op + db * 16) = w; }
        }
    }
#undef NB_DMA
#undef NB_LANDED
}

__device__ __forceinline__ void p4_gla_scan(Fr F, int L, const XcdBarrier& bar) {
    RELAUNDER(F);
    for (int rep = 0; rep < 1 + ((REPMASK >> 10) & 1); ++rep)
    for (int it = F.bid; it < HYC + ((L == 0) ? HYC : 0); it += F.G) {
        if (it < HYC) hy_conv_item<SEQ>(F, it, (const float*)(F.ws + WS_KF) + ((size_t)L * HYC + it) * 4096, (const bf16*)(F.ws + WS_ZT), (const bf16*)(F.ws + WS_X0T), (bf16*)(F.ws + WS_YT));
        else hy_conv_item<CTXL>(F, it - HYC, (const float*)(F.ws + WS_KFC) + (size_t)(it - HYC) * 512, (const bf16*)(F.ws + WS_ZTC), (const bf16*)(F.ws + WS_X0TC), (bf16*)(F.ws + WS_YTC));
    }
    unsigned* ST = (unsigned*)(F.ws + WS_ST); const float* DEC = (const float*)(F.ws + WS_DEC);
    for (int rep = 0; rep < 1 + ((REPMASK >> 7) & 1); ++rep) {
    if (rep > 0) { __syncthreads(); for (int it = F.bid; it < NB * GH * GSTEPS; it += F.G) gla_g1_item(F, L, it); xcd_barrier(bar); }
    for (int e = F.bid * NTHR + F.tid; e < NB * GH * 2 * 4096; e += F.G * NTHR) {
        const int chain = e >> 12, el2 = e & 4095, i = (el2 & 31) * 2; float S0 = 0.f, S1 = 0.f;
        unsigned* p = ST + (size_t)chain * GSTEPS * 4096 + el2; const float* d = DEC + (size_t)chain * GSTEPS * 64 + i;
#pragma unroll 6
        for (int s = 0; s < GSTEPS; ++s) { const unsigned u = p[(size_t)s * 4096]; p[(size_t)s * 4096] = pk2(S0, S1); S0 = d[s * 64] * S0 + bflo(u); S1 = d[s * 64 + 1] * S1 + bfhi(u); }
    }
    if (((REPMASK >> 7) & 1) && rep == 0) xcd_barrier(bar);
    }
    LAS float* rpb = (LAS float*)F.lds;
    for (int i = F.tid; i < NAH * 465; i += NTHR) rpb[i] = INP(IN_RPB)[L * NAH * 465 + i] * 1.4426950408889634f;
    __syncthreads();
    const int gw = F.bid * NWAVES + F.wave, NGW = F.G * NWAVES;
    for (int rep = 0; rep < 1 + (REPMASK & 1); ++rep) {
    if (rep > 0) __syncthreads();
    for (int rep2 = 0; rep2 < 1 + ((REPMASK >> 20) & 1); ++rep2) { if (rep2 > 0) __syncthreads(); na_block_units(F, L, rpb, bar); }
    for (int rep2 = 0; rep2 < 1 + ((REPMASK >> 21) & 1); ++rep2)
    if (L == 0) for (int q = gw; q < 64 * NAH; q += NGW) { const int h = q / 64, tile = q % 64; na_mfma_item<false>(F, L, tile, h, rpb); }
    }
}

__device__ __forceinline__ void gla_g3_item(const Fr& F, int L, int b, int h, int ci) {
    LAS bf16* VTs = (LAS bf16*)F.lds; LAS bf16* Qs = VTs + 128 * GLP; LAS bf16* Ks = Qs + 64 * GLP; LAS float* Cs = (LAS float*)(Ks + 64 * GLP); LAS float* red = Cs + 64;
    LAS bf16* RK = (LAS bf16*)(red + 128); LAS bf16* RQ = RK + 64 * GLP; LAS bf16* RG = RQ + 64 * GLP;
    LAS bf16* Qs1 = RG + 64 * 32; LAS bf16* Ks1 = Qs1 + 64 * GLP; LAS float* Cs1 = (LAS float*)(Ks1 + 64 * GLP);
    LAS bf16* const Qs0 = Qs; LAS bf16* const Ks0 = Ks; LAS float* const Cs0 = Cs;
    const int lane = F.lane, w = F.wave, r16 = lane & 15, g = lane >> 4, tb = w & 3, jh = w >> 2;
    const bool is_ctx = ci < 4; const int base = is_ctx ? TLAT + b * CTXL + ci * 64 : b * SEQ + (ci - 4) * 64;
    gla_stage_raw<true>(F, h, base, RK, RQ, RG, VTs);
    __syncthreads();
    float qx[8], kx[8];
    gla_load_rope(F, RQ, base + lane, is_ctx, qx); gla_load_rope(F, RK, base + lane, is_ctx, kx);
    f32x4 O[4];
#pragma unroll
    for (int jb = 0; jb < 4; ++jb) O[jb] = (f32x4){0.f, 0.f, 0.f, 0.f};
#pragma unroll 1
    for (int dir = 0; dir < 2; ++dir) {
        LAS bf16* Qs = dir ? Qs1 : Qs0; LAS bf16* Ks = dir ? Ks1 : Ks0; LAS float* Cs = dir ? Cs1 : Cs0;
        const int step = is_ctx ? (dir ? 3 - ci : ci) : (dir ? 39 - ci : ci);
        float cf[8], la[8];
        { const float* cfp = (const float*)(F.ws + WS_CF) + ((size_t)(base + lane) * 2 + dir) * 384 + h * 64 + 8 * w; const f32x4 c0 = *(const f32x4*)cfp, c1 = *(const f32x4*)(cfp + 4);
          const float cv[8] = {c0[0], c0[1], c0[2], c0[3], c1[0], c1[1], c1[2], c1[3]};
#pragma unroll
          for (int e = 0; e < 8; ++e) { cf[e] = cv[e]; const float pv = __shfl_up(cv[e], 1); la[e] = cv[e] - (lane ? pv : 0.f); } }
        { v4u qw, kw; float qt[8], kt[8];
#pragma unroll
          for (int e = 0; e < 8; ++e) { const float c = dir ? -(cf[e] - la[e]) : cf[e]; qt[e] = qx[e] * 0.125f * __expf(c); kt[e] = kx[e] * __expf(-c); if (lane == 63) Cs[8 * w + e] = cf[e]; }
          qw.x = pk2(qt[0], qt[1]); qw.y = pk2(qt[2], qt[3]); qw.z = pk2(qt[4], qt[5]); qw.w = pk2(qt[6], qt[7]); kw.x = pk2(kt[0], kt[1]); kw.y = pk2(kt[2], kt[3]); kw.z = pk2(kt[4], kt[5]); kw.w = pk2(kt[6], kt[7]);
          *(LAS v4u*)(Qs + lane * GLP + 8 * w) = qw; *(LAS v4u*)(Ks + lane * GLP + 8 * w) = kw; }
        const bf16* ST = (const bf16*)(F.ws + WS_ST) + ((size_t)((b * GH + h) * 2 + dir) * GSTEPS + step) * 8192;
        v4u sraw[4][2];
#pragma unroll
        for (int jb = 0; jb < 4; ++jb)
#pragma unroll
            for (int ks = 0; ks < 2; ++ks) sraw[jb][ks] = *(const v4u*)(ST + (16 * (4 * jh + jb) + r16) * 64 + 8 * g + 32 * ks);
        __syncthreads();
        bf16x8 qf[2];
#pragma unroll
        for (int ks = 0; ks < 2; ++ks) qf[ks] = *(const LAS bf16x8*)(Qs + (16 * tb + r16) * GLP + 8 * g + 32 * ks);
        f32x4 at[4];
#pragma unroll
        for (int sb = 0; sb < 4; ++sb) { at[sb] = (f32x4){0.f, 0.f, 0.f, 0.f};
            const bool live = dir ? (sb >= tb) : (sb <= tb);
            if (live) {
#pragma unroll
                for (int ks = 0; ks < 2; ++ks) at[sb] = __builtin_amdgcn_mfma_f32_16x16x32_bf16(*(const LAS bf16x8*)(Ks + (16 * sb + r16) * GLP + 8 * g + 32 * ks), qf[ks], at[sb], 0, 0, 0);
                if (sb == tb) {
#pragma unroll
                    for (int e = 0; e < 4; ++e) { const int sl = 4 * g + e; const bool keep = dir ? (sl >= r16) : (sl <= r16); if (!keep) at[sb][e] = 0.f; } } } }
#pragma unroll
        for (int jb = 0; jb < 4; ++jb) {
#pragma unroll
            for (int ks = 0; ks < 2; ++ks) { v4u sw = sraw[jb][ks];
                if (dir) { const unsigned wsrc[4] = {sw.x, sw.y, sw.z, sw.w}; unsigned wd[4];
#pragma unroll
                    for (int e2 = 0; e2 < 4; ++e2) wd[e2] = pk2(bflo(wsrc[e2]) * __expf(Cs[8 * g + 32 * ks + 2 * e2]), bfhi(wsrc[e2]) * __expf(Cs[8 * g + 32 * ks + 2 * e2 + 1]));
                    sw.x = wd[0]; sw.y = wd[1]; sw.z = wd[2]; sw.w = wd[3]; }
                O[jb] = __builtin_amdgcn_mfma_f32_16x16x32_bf16(__builtin_bit_cast(bf16x8, sw), qf[ks], O[jb], 0, 0, 0); }
#pragma unroll
            for (int ss = 0; ss < 2; ++ss) { const bool live = dir ? (2 * ss + 1 >= tb) : (2 * ss <= tb);
                if (live) { v4u pw; pw.x = pk2(at[2 * ss][0], at[2 * ss][1]); pw.y = pk2(at[2 * ss][2], at[2 * ss][3]); pw.z = pk2(at[2 * ss + 1][0], at[2 * ss + 1][1]); pw.w = pk2(at[2 * ss + 1][2], at[2 * ss + 1][3]);
                    const LAS bf16* vp = VTs + (16 * (4 * jh + jb) + r16) * GLP + 32 * ss + 4 * g; const v2u lo = *(const LAS v2u*)vp, hi = *(const LAS v2u*)(vp + 16);
                    v4u aw; aw.x = lo.x; aw.y = lo.y; aw.z = hi.x; aw.w = hi.y;
                    O[jb] = __builtin_amdgcn_mfma_f32_16x16x32_bf16(__builtin_bit_cast(bf16x8, aw), __builtin_bit_cast(bf16x8, pw), O[jb], 0, 0, 0); } } }
    }
    float ss2 = 0.f;
#pragma unroll
    for (int jb = 0; jb < 4; ++jb) ss2 += (O[jb][0] * O[jb][0] + O[jb][1] * O[jb][1]) + (O[jb][2] * O[jb][2] + O[jb][3] * O[jb][3]);
    ss2 += __shfl_xor(ss2, 16); ss2 += __shfl_xor(ss2, 32);
    if (g == 0) red[(16 * tb + r16) * 2 + jh] = ss2;
    __syncthreads();
    const int tl = 16 * tb + r16; const float rn = 1.0f / sqrtf((red[tl * 2] + red[tl * 2 + 1]) * (1.0f / 128.0f) + LN_EPS);
    const bf16* PROJ = (const bf16*)(F.ws + WS_PROJ); bf16* MIX = (bf16*)(F.ws + WS_MIX); const size_t otok = (size_t)base + tl;
#pragma unroll
    for (int jb = 0; jb < 4; ++jb) { const int j0 = 16 * (4 * jh + jb) + 4 * g; const v2u gw = *(const v2u*)(PROJ + otok * INCP + C_GG + h * 128 + j0); const f32x4 nw = *(const f32x4*)(INP(IN_GNW) + L * 128 + j0);
        v2u o; o.x = pk2(O[jb][0] * rn * nw[0] * silu_f(bflo(gw.x)), O[jb][1] * rn * nw[1] * silu_f(bfhi(gw.x))); o.y = pk2(O[jb][2] * rn * nw[2] * silu_f(bflo(gw.y)), O[jb][3] * rn * nw[3] * silu_f(bfhi(gw.y)));
        *(v2u*)(MIX + otok * DM + M_GLA + h * 128 + j0) = o; }
    __syncthreads();
}
__device__ __forceinline__ void p5_mixers2(Fr F, int L) {
    RELAUNDER(F);
    const int nci = (L == 0) ? 36 : 32, n_items = NB * GH * nci;
    for (int rep = 0; rep < 1 + ((REPMASK >> 2) & 1); ++rep)
    for (int it = F.bid; it < n_items; it += F.G) { const int ci = it % nci + ((L == 0) ? 0 : 4), bh = it / nci; gla_g3_item(F, L, bh / GH, bh % GH, ci); }
    for (int rep = 0; rep < 1 + ((REPMASK >> 4) & 1); ++rep)
    for (int it = F.bid; it < 128 + ((L == 0) ? 16 : 0); it += F.G) hy_post_item(F, L, it);
    const int gw = F.bid * NWAVES + F.wave, NGW = F.G * NWAVES; const int nrows = (L == 0) ? TTOT : TLAT; bf16* MIX = (bf16*)(F.ws + WS_MIX);
    for (int row = gw; row < nrows; row += NGW) {
        { v2u* p = (v2u*)(MIX + (size_t)row * DM + M_NA + F.lane * 12); const v2u w0 = p[0], w1 = p[1], w2 = p[2];
          float x[12] = {bflo(w0.x), bfhi(w0.x), bflo(w0.y), bfhi(w0.y), bflo(w1.x), bfhi(w1.x), bflo(w1.y), bfhi(w1.y), bflo(w2.x), bfhi(w2.x), bflo(w2.y), bfhi(w2.y)}; float s = 0.f;
#pragma unroll
          for (int i = 0; i < 12; ++i) s += x[i] * x[i];
          const float rn = 1.0f / sqrtf(wave_sum(s) * (1.0f / 768.0f) + LN_EPS); const float* nw = INP(IN_NANW) + L * 768 + F.lane * 12;
#pragma unroll
          for (int i = 0; i < 12; ++i) x[i] *= rn * nw[i];
          v2u o0, o1, o2; o0.x = pk2(x[0], x[1]); o0.y = pk2(x[2], x[3]); o1.x = pk2(x[4], x[5]); o1.y = pk2(x[6], x[7]); o2.x = pk2(x[8], x[9]); o2.y = pk2(x[10], x[11]);
          p[0] = o0; p[1] = o1; p[2] = o2; }
    }
}

__device__ __forceinline__ void p7_row(const Fr& F, int L, int row, f32x4 (&hv)[8]) {
    const int lane = F.lane;
    const bf16* Y = (const bf16*)(F.ws + WS_Y); bf16* X1 = (bf16*)(F.ws + WS_X1); bf16* H = (bf16*)(F.ws + WS_H);
    const float* lg = INP(IN_LN1G) + L * DM; const float* lb = INP(IN_LN1B) + L * DM;
    const float* mod = mod_ptr(F, L, row);
    const v2u* yr = (const v2u*)(Y + (size_t)row * DM) + lane;
    f32x4 v[8]; float s = 0.f;
#pragma unroll
    for (int j = 0; j < 8; ++j) { const f32x4 g1 = *((const f32x4*)(mod + 2 * DM) + lane + 64 * j); const v2u yw = yr[64 * j]; v[j] = load_x4(F, L, row, lane + 64 * j) * ALPHA + g1 * (f32x4){bflo(yw.x), bfhi(yw.x), bflo(yw.y), bfhi(yw.y)}; s += (v[j][0] + v[j][1]) + (v[j][2] + v[j][3]); }
    float mean = wave_sum(s) * (1.f / DM), s2 = 0.f;
#pragma unroll
    for (int j = 0; j < 8; ++j) { v[j] = v[j] - mean; s2 += (v[j][0] * v[j][0] + v[j][1] * v[j][1]) + (v[j][2] * v[j][2] + v[j][3] * v[j][3]); }
    float rstd = 1.f / sqrtf(wave_sum(s2) * (1.f / DM) + LN_EPS); s = 0.f;
#pragma unroll
    for (int j = 0; j < 8; ++j) { const f32x4 g = *((const f32x4*)lg + lane + 64 * j), bb = *((const f32x4*)lb + lane + 64 * j); v[j] = v[j] * rstd * g + bb;
        { v2u xw; xw.x = pk2(v[j][0], v[j][1]); xw.y = pk2(v[j][2], v[j][3]); *((v2u*)(X1 + (size_t)row * DM) + lane + 64 * j) = xw; } s += (v[j][0] + v[j][1]) + (v[j][2] + v[j][3]); }
    mean = wave_sum(s) * (1.f / DM); s2 = 0.f;
#pragma unroll
    for (int j = 0; j < 8; ++j) { v[j] = v[j] - mean; s2 += (v[j][0] * v[j][0] + v[j][1] * v[j][1]) + (v[j][2] * v[j][2] + v[j][3] * v[j][3]); }
    rstd = 1.f / sqrtf(wave_sum(s2) * (1.f / DM) + LN_EPS);
    v2u* o8 = (v2u*)(H + (size_t)row * DM) + lane;
#pragma unroll
    for (int j = 0; j < 8; ++j) { const f32x4 sh = *((const f32x4*)(mod + 3 * DM) + lane + 64 * j), sc = *((const f32x4*)(mod + 4 * DM) + lane + 64 * j);
        hv[j] = v[j] * rstd * (sc + 1.0f) + sh; v2u w; w.x = pk2(hv[j][0], hv[j][1]); w.y = pk2(hv[j][2], hv[j][3]); o8[64 * j] = w; }
}
__device__ __forceinline__ void p7_route(const Fr& F, int L, int row, const float (&a)[36], bool commit) {
    const float gl0 = a[0] + INP(IN_BRG)[L * 4 + 0], gl1 = a[1] + INP(IN_BRG)[L * 4 + 1], gl2 = a[2] + INP(IN_BRG)[L * 4 + 2], gl3 = a[3] + INP(IN_BRG)[L * 4 + 3];
    float gm = gl0; int g = 0;
    if (gl1 > gm) { gm = gl1; g = 1; }
    if (gl2 > gm) { gm = gl2; g = 2; }
    if (gl3 > gm) { gm = gl3; g = 3; }
    const float gs = __expf(gl0 - gm) + __expf(gl1 - gm) + __expf(gl2 - gm) + __expf(gl3 - gm);
    const float top_pg = 1.0f / gs;
    float le[8];
#pragma unroll
    for (int e = 0; e < 8; ++e) { const float c0 = a[4 + e], c1 = a[12 + e], c2 = a[20 + e], c3 = a[28 + e];
        const float x = (g == 0) ? c0 : (g == 1) ? c1 : (g == 2) ? c2 : c3; le[e] = x + INP(IN_BRE)[L * 32 + g * 8 + e]; }
    float v1 = -3.0e38f; int e1 = 0;
#pragma unroll
    for (int e = 0; e < 8; ++e) if (le[e] > v1) { v1 = le[e]; e1 = e; }
    float v2 = -3.0e38f; int e2 = 0;
#pragma unroll
    for (int e = 0; e < 8; ++e) if (e != e1 && le[e] > v2) { v2 = le[e]; e2 = e; }
    const float ex = __expf(v2 - v1), w1 = top_pg / (1.0f + ex), w2 = top_pg * ex / (1.0f + ex);
    if (commit) {
        unsigned* cnt = (unsigned*)(F.ctl + CW_CNT + L * 64); int* asg = (int*)(F.ws + WS_ASG) + (size_t)row * 8;
        const int ea = g * 8 + e1, eb = g * 8 + e2;
        const unsigned ra = atomicAdd(cnt + ea, 1u), rb = atomicAdd(cnt + eb, 1u);
        int* RLIST = (int*)(F.ws + WS_XG); float* GLIST = (float*)(F.ws + WS_XG + 2 * MiB);
        RLIST[ea * TTOT + (int)ra] = row; GLIST[ea * TTOT + (int)ra] = w1; RLIST[eb * TTOT + (int)rb] = row; GLIST[eb * TTOT + (int)rb] = w2;
        asg[0] = ea; asg[1] = (int)ra; asg[2] = __builtin_bit_cast(int, w1); asg[3] = 0;
        asg[4] = eb; asg[5] = (int)rb; asg[6] = __builtin_bit_cast(int, w2); asg[7] = 0;
    }
}
constexpr int RP = DM + 8;
__device__ __forceinline__ void p7_item(const Fr& F, int L, int item, bool commit) {
    const int lane = F.lane, tid = F.tid, w = F.wave, r16 = lane & 15, g = lane >> 4;
    LAS bf16* Ah = (LAS bf16*)F.lds; LAS bf16* Al = Ah + 16 * RP;
#pragma unroll 1
    for (int rr = 0; rr < 2; ++rr) { f32x4 hv[8]; p7_row(F, L, item * 16 + w * 2 + rr, hv);
#pragma unroll
        for (int j = 0; j < 8; ++j) { v2u hi, lo; float r[4];
#pragma unroll
            for (int i = 0; i < 4; ++i) r[i] = hv[j][i] - __builtin_bit_cast(float, f2bf(hv[j][i]) << 16);
            hi.x = pk2(hv[j][0], hv[j][1]); hi.y = pk2(hv[j][2], hv[j][3]); lo.x = pk2(r[0], r[1]); lo.y = pk2(r[2], r[3]);
            *(LAS v2u*)(Ah + (w * 2 + rr) * RP + lane * 4 + 256 * j) = hi; *(LAS v2u*)(Al + (w * 2 + rr) * RP + lane * 4 + 256 * j) = lo; } }
    __syncthreads();
    f32x4 acc[3];
#pragma unroll
    for (int nt = 0; nt < 3; ++nt) acc[nt] = (f32x4){0.f, 0.f, 0.f, 0.f};
    { const bf16* WRH = (const bf16*)(F.ws + WS_WRT) + ((size_t)L * 48 + r16) * DM + 256 * w + 8 * g; const bf16* WRL = (const bf16*)(F.ws + WS_WRT + 512 * 1024) + ((size_t)L * 48 + r16) * DM + 256 * w + 8 * g;
      const LAS bf16* ahp = Ah + r16 * RP + 256 * w + 8 * g; const LAS bf16* alp = Al + r16 * RP + 256 * w + 8 * g;
#pragma unroll
      for (int ks = 0; ks < 8; ++ks) { const bf16x8 ah = *(const LAS bf16x8*)(ahp + 32 * ks), al = *(const LAS bf16x8*)(alp + 32 * ks);
#pragma unroll
          for (int nt = 0; nt < 3; ++nt) { const bf16x8 bh = *(const bf16x8*)(WRH + (size_t)nt * 16 * DM + 32 * ks), bl = *(const bf16x8*)(WRL + (size_t)nt * 16 * DM + 32 * ks);
              acc[nt] = __builtin_amdgcn_mfma_f32_16x16x32_bf16(ah, bh, acc[nt], 0, 0, 0); acc[nt] = __builtin_amdgcn_mfma_f32_16x16x32_bf16(ah, bl, acc[nt], 0, 0, 0); acc[nt] = __builtin_amdgcn_mfma_f32_16x16x32_bf16(al, bh, acc[nt], 0, 0, 0); } } }
    __syncthreads();
    LAS float* Pp = (LAS float*)F.lds;
    LAS float* LG = Pp + 8 * 16 * 48;
#pragma unroll
    for (int nt = 0; nt < 3; ++nt)
#pragma unroll
        for (int e = 0; e < 4; ++e) Pp[(w * 16 + 4 * g + e) * 48 + nt * 16 + r16] = acc[nt][e];
    __syncthreads();
    for (int idx = tid; idx < 16 * 36; idx += NTHR) { const int row = idx / 36, o = idx - row * 36; float sum = 0.f;
#pragma unroll
        for (int ww = 0; ww < 8; ++ww) sum += Pp[(ww * 16 + row) * 48 + o];
        LG[idx] = sum; }
    __syncthreads();
    if (tid < 16) { float a[36];
#pragma unroll
        for (int o = 0; o < 36; ++o) a[o] = LG[tid * 36 + o];
        p7_route(F, L, item * 16 + tid, a, commit); }
    __syncthreads();
}

constexpr int MT_OFF = 0, MT_CNT = 33, MT_NT = 65, MT_TILE = 66;
__device__ __forceinline__ void moe_tables(const Fr& F, int L, LAS int* tab) {
    __syncthreads();
    if (F.tid < 64) { const int e = F.tid & 31; const unsigned* cnt = (unsigned*)(F.ctl + CW_CNT + L * 64);
        const int cn = (int)__hip_atomic_load(cnt + e, __ATOMIC_RELAXED, __HIP_MEMORY_SCOPE_AGENT), nt = (cn + 255) >> 8;
        int incl = nt;
#pragma unroll
        for (int o = 1; o < 32; o <<= 1) { const int u = __shfl_up(incl, o); if ((F.tid & 31) >= o) incl += u; }
        const int t0 = incl - nt;
        if (F.tid < 32) { tab[MT_OFF + e] = t0 * 256; tab[MT_CNT + e] = cn; for (int t = 0; t < nt; ++t) tab[MT_TILE + t0 + t] = e;
            if (e == 31) { tab[MT_OFF + 32] = incl * 256; tab[MT_NT] = incl; } } }
    __syncthreads();
}

__device__ __forceinline__ void p11_ln2(Fr F, int L, int nrows, float* outp) {
    RELAUNDER(F);
    const int gw = F.bid * NWAVES + F.wave, NGW = F.G * NWAVES, lane = F.lane;
    const bf16* X1 = (const bf16*)(F.ws + WS_X1); const bf16* DN = (const bf16*)(F.ws + WS_DN); const int* ASG = (const int*)(F.ws + WS_ASG);
    LAS int* tab = (LAS int*)(F.lds + LDSCTL_OFF + 128); moe_tables(F, L, tab);
    const float* lg = INP(IN_LN2G) + L * DM; const float* lb = INP(IN_LN2B) + L * DM;
    for (int row = gw; row < nrows; row += NGW) {
        const float* mod = mod_ptr(F, L, row); const int s0 = tab[MT_OFF + ASG[row * 8]] + ASG[row * 8 + 1], s1 = tab[MT_OFF + ASG[row * 8 + 4]] + ASG[row * 8 + 5];
        const v2u* xr = (const v2u*)(X1 + (size_t)row * DM) + lane; const v2u* d0 = (const v2u*)(DN + (size_t)s0 * DM) + lane; const v2u* d1 = (const v2u*)(DN + (size_t)s1 * DM) + lane;
        f32x4 v[8]; float s = 0.f;
#pragma unroll
        for (int j = 0; j < 8; ++j) { const f32x4 g2 = *((const f32x4*)(mod + 5 * DM) + lane + 64 * j); const v2u a = d0[64 * j], bq = d1[64 * j];
            const f32x4 f = (f32x4){bflo(a.x) + bflo(bq.x), bfhi(a.x) + bfhi(bq.x), bflo(a.y) + bflo(bq.y), bfhi(a.y) + bfhi(bq.y)};
            const v2u xw = xr[64 * j]; v[j] = (f32x4){bflo(xw.x), bfhi(xw.x), bflo(xw.y), bfhi(xw.y)} * ALPHA + g2 * f; s += (v[j][0] + v[j][1]) + (v[j][2] + v[j][3]); }
        const float mean = wave_sum(s) * (1.f / DM); float s2 = 0.f;
#pragma unroll
        for (int j = 0; j < 8; ++j) { v[j] = v[j] - mean; s2 += (v[j][0] * v[j][0] + v[j][1] * v[j][1]) + (v[j][2] * v[j][2] + v[j][3] * v[j][3]); }
        const float rstd = 1.f / sqrtf(wave_sum(s2) * (1.f / DM) + LN_EPS);
        float sn = 0.f;
#pragma unroll
        for (int j = 0; j < 8; ++j) { const f32x4 g = *((const f32x4*)lg + lane + 64 * j), bb = *((const f32x4*)lb + lane + 64 * j);
            v[j] = v[j] * rstd * g + bb; sn += (v[j][0] + v[j][1]) + (v[j][2] + v[j][3]);
            if (L == NLAYER - 1) *((f32x4*)(outp + (size_t)row * DM) + lane + 64 * j) = v[j];
            else { v2u xw; xw.x = pk2(v[j][0], v[j][1]); xw.y = pk2(v[j][2], v[j][3]); *((v2u*)((bf16*)(F.ws + WS_X2) + (size_t)row * DM) + lane + 64 * j) = xw; } }
        if (L + 1 < NLAYER) {
            const float* modn = mod_ptr(F, L + 1, row); const float mn = wave_sum(sn) * (1.f / DM); float s3 = 0.f;
#pragma unroll
            for (int j = 0; j < 8; ++j) { v[j] = v[j] - mn; s3 += (v[j][0] * v[j][0] + v[j][1] * v[j][1]) + (v[j][2] * v[j][2] + v[j][3] * v[j][3]); }
            const float rs = 1.f / sqrtf(wave_sum(s3) * (1.f / DM) + LN_EPS);
            v2u* o8 = (v2u*)((bf16*)(F.ws + WS_H) + (size_t)row * DM) + lane;
#pragma unroll
            for (int j = 0; j < 8; ++j) { const f32x4 sh = *((const f32x4*)(modn) + lane + 64 * j), sc = *((const f32x4*)(modn + DM) + lane + 64 * j);
                const f32x4 hh = v[j] * rs * (sc + 1.0f) + sh; v2u w; w.x = pk2(hh[0], hh[1]); w.y = pk2(hh[2], hh[3]); o8[64 * j] = w; }
        }
    }
}

constexpr int PH_PER_LAYER = 11, N_PHASES = 1 + NLAYER * PH_PER_LAYER;
struct Args { const float* in[33]; float* out; unsigned char* ws; int ph_lo, ph_hi, use_bar, pad; };
#ifndef PHMASK
#define PHMASK 0xFFFF
#endif
#define IN(k) (lo <= (k) && (k) < hi)
#define EN(j) ((PHMASK >> (j)) & 1)
#define SEAM(k) do { if (IN(k) && IN((k) + 1)) { xcd_barrier(bar); if ((REPMASK >> 14) & 1) xcd_barrier(bar); } } while (0)

#ifndef QUOTA_P2
#define QUOTA_P2 2
#define QUOTA_P6 1
#define QUOTA_P9 1
#define QUOTA_P10 0
#endif
template <int L> __device__ __forceinline__ void layer_phases(const Fr& F, const XcdBarrier& bar, const int lo, const int hi) {
        const int pb = 1 + L * PH_PER_LAYER;
        const int nrows = (L == 0) ? TTOT : TLAT;
        if (L == 0) { if (EN(1) && IN(pb + 0)) { p1_ln_mod(F, L); if ((REPMASK >> 6) & 1) p1_ln_mod(F, L); } SEAM(pb + 0); }
        if (EN(2) && IN(pb + 1)) {
            Fr Fp = F; RELAUNDER(Fp);
            pg8::Gemm g{(const pg8::bf16_t*)(Fp.ws + WS_H), (const pg8::bf16_t*)(Fp.ws + WS_WIN) + (size_t)L * INCP * DM, TTOT, INCP, DM};
            pg8::StaticOrder S; S.init(TTOT, INCP, Fp.G, Fp.bid);
            pg8::EpiBf16P E{(pg8::bf16_t*)(Fp.ws + WS_PROJ), INCP};
            for (int rep = 0; rep < 1 + (((REPMASK >> 5) | (REPMASK >> 16)) & 1); ++rep) pg8::gemm_phase<pg8::EpiBf16P, pg8::StaticOrder, true, true>(Fp.lds, g, S, E);
                    if (L == 0) { const int n_ = (TTOT / 256) * (INCP / 256), mx_ = (n_ + Fp.G - 1) / Fp.G, my_ = (Fp.bid < n_) ? (n_ - Fp.bid + Fp.G - 1) / Fp.G : 0; if (my_ < mx_) conv_bubble(Fp, QUOTA_P2); }
        } SEAM(pb + 1);
        if (EN(3) && IN(pb + 2)) { p3_mixers1(F, L); } SEAM(pb + 2);
        if (EN(4) && IN(pb + 3)) { p4_gla_scan(F, L, bar); } SEAM(pb + 3);
        if (EN(5) && IN(pb + 4)) { p5_mixers2(F, L); } SEAM(pb + 4);
        if (EN(6) && IN(pb + 5)) {
            Fr Fp = F; RELAUNDER(Fp);
            pg8::Gemm g{(const pg8::bf16_t*)(Fp.ws + WS_MIX), (const pg8::bf16_t*)(Fp.ws + WS_WOUT) + (size_t)L * DM * DM, nrows, DM, DM};
            pg8::StaticOrder S; S.init(nrows, DM, Fp.G, Fp.bid);
            pg8::EpiBf16P E{(pg8::bf16_t*)(Fp.ws + WS_Y), DM};
            for (int rep = 0; rep < 1 + (((REPMASK >> 5) | (REPMASK >> 17)) & 1); ++rep) pg8::gemm_phase<pg8::EpiBf16P, pg8::StaticOrder, true, true>(Fp.lds, g, S, E);
                    if (L == 0) { const int n_ = (nrows / 256) * (DM / 256), mx_ = (n_ + Fp.G - 1) / Fp.G, my_ = (Fp.bid < n_) ? (n_ - Fp.bid + Fp.G - 1) / Fp.G : 0; if (my_ < mx_) conv_bubble(Fp, QUOTA_P6); }
        } SEAM(pb + 5);
        if (EN(7) && IN(pb + 6)) { Fr Fp = F; RELAUNDER(Fp); for (int rep = ((REPMASK >> 9) & 1) ? 0 : 1; rep < 2; ++rep) { _Pragma("unroll 1") for (int it = Fp.bid; it < nrows / 16; it += Fp.G) p7_item(Fp, L, it, rep == 1); } } SEAM(pb + 6);
        if (EN(9) && IN(pb + 8)) {
            Fr Fp = F; RELAUNDER(Fp);
            LAS int* tab = (LAS int*)(Fp.lds + LDSCTL_OFF + 128); moe_tables(Fp, L, tab); const int ntiles = __builtin_amdgcn_readfirstlane(tab[MT_NT]);
            pg8::EpiAct E{(pg8::bf16_t*)(Fp.ws + WS_ACT), (const float*)(Fp.ws + WS_XG + 2 * MiB)};
            for (int rep = 0; rep < 1 + (((REPMASK >> 5) | (REPMASK >> 18)) & 1); ++rep) pg8::moe_gemm_phase<true, pg8::EpiAct>(Fp.lds, (const pg8::bf16_t*)(Fp.ws + WS_H), (const int*)(Fp.ws + WS_XG), INP(IN_WUP) + (size_t)L * NEXP * DM * 1024, tab, ntiles, Fp.G, Fp.bid, E);
                    if (L == 0) { const int n_ = ntiles * 4, mx_ = (n_ + Fp.G - 1) / Fp.G, my_ = (Fp.bid < n_) ? (n_ - Fp.bid + Fp.G - 1) / Fp.G : 0; if (my_ < mx_) conv_bubble(Fp, QUOTA_P9); }
        } SEAM(pb + 8);
        if (EN(10) && IN(pb + 9)) {
            Fr Fp = F; RELAUNDER(Fp);
            LAS int* tab = (LAS int*)(Fp.lds + LDSCTL_OFF + 128); moe_tables(Fp, L, tab); const int ntiles = __builtin_amdgcn_readfirstlane(tab[MT_NT]);
            pg8::EpiDn E{(pg8::bf16_t*)(Fp.ws + WS_DN)};
            for (int rep = 0; rep < 1 + (((REPMASK >> 5) | (REPMASK >> 19)) & 1); ++rep) pg8::moe_gemm_phase<false, pg8::EpiDn>(Fp.lds, (const pg8::bf16_t*)(Fp.ws + WS_ACT), nullptr, INP(IN_WDN) + (size_t)L * NEXP * DEXP * DM, tab, ntiles, Fp.G, Fp.bid, E);
                    if (L == 0) { const int n_ = ntiles * 8, mx_ = (n_ + Fp.G - 1) / Fp.G, my_ = (Fp.bid < n_) ? (n_ - Fp.bid + Fp.G - 1) / Fp.G : 0; if (my_ < mx_) conv_bubble(Fp, QUOTA_P10); }
        } SEAM(pb + 9);
        if (EN(11) && IN(pb + 10)) { p11_ln2(F, L, nrows, (L == NLAYER - 1) ? (float*)F.out : (float*)(F.ws + WS_X2)); if ((REPMASK >> 6) & 1) p11_ln2(F, L, nrows, (L == NLAYER - 1) ? (float*)F.out : (float*)(F.ws + WS_X2)); }
        if (L + 1 < NLAYER) { if (IN(pb + 10)) { __syncthreads(); conv_bubble(F, -1); } SEAM(pb + 10); }
    }
__global__ void __launch_bounds__(NTHR, 2) fwd_kernel(Args args) {
    extern __shared__ __attribute__((aligned(16))) unsigned char lds_raw[];
    Fr F;
    F.lds = (LAS unsigned char*)lds_raw;
    F.tid = threadIdx.x; F.lane = F.tid & 63; F.wave = __builtin_amdgcn_readfirstlane(F.tid >> 6);
    F.G = gridDim.x; F.bid = blockIdx.x;
    F.in = (const GAS float* const KAS*)__builtin_amdgcn_kernarg_segment_ptr();
    F.out = (GAS float*)args.out; F.ws = (GAS unsigned char*)args.ws; F.ctl = (GAS unsigned*)(args.ws + WS_CTL);
    for (int u = F.tid; u < (LDS_BYTES - LDSCTL_OFF) / 4; u += NTHR) ((LAS unsigned*)(F.lds + LDSCTL_OFF))[u] = 0u;
    __syncthreads();
    XcdBarrier bar; bar.bar = (unsigned*)(F.ctl + CW_BAR); bar.x = 0; bar.st = nullptr;
    if (args.use_bar) bar = xcd_barrier_post((unsigned*)(F.ctl + CW_BAR), (volatile LAS unsigned*)(F.lds + LDSCTL_OFF + 32));
    const int lo = args.ph_lo, hi = args.ph_hi;
    if (EN(0) && IN(0)) { p0_prologue(F); if ((REPMASK >> 3) & 1) { __syncthreads(); p0_prologue(F); } } SEAM(0);
    layer_phases<0>(F, bar, lo, hi);
    layer_phases<1>(F, bar, lo, hi);
#undef IN
#undef SEAM
}

#ifndef MK_ONE_LAUNCH
#define MK_ONE_LAUNCH 0
#endif
extern "C" void kernel_launch(void* const* d_in, const int* in_sizes, int n_in, void* d_out, int out_size, void* d_ws, size_t ws_size, hipStream_t stream) {
    static int grid = 0;
    if (grid == 0) {
        if (n_in != 33 || out_size != TLAT * DM || ws_size < WS_END) { fprintf(stderr, "kernel_launch: unexpected shapes: n_in %d out %d ws %zu (need %zu)\n", n_in, out_size, ws_size, (size_t)WS_END); grid = -1; return; }
        int dev = 0, cus = 0, per_cu = 0;
        if (hipGetDevice(&dev) != hipSuccess || hipDeviceGetAttribute(&cus, hipDeviceAttributeMultiprocessorCount, dev) != hipSuccess) { grid = -1; return; }
        if (hipFuncSetAttribute((const void*)fwd_kernel, hipFuncAttributeMaxDynamicSharedMemorySize, LDS_BYTES) != hipSuccess) { fprintf(stderr, "kernel_launch: hipFuncSetAttribute failed\n"); grid = -1; return; }
        if (hipOccupancyMaxActiveBlocksPerMultiprocessor(&per_cu, (const void*)fwd_kernel, NTHR, LDS_BYTES) != hipSuccess || per_cu < 1) fprintf(stderr, "kernel_launch: occupancy query says %d\n", per_cu);
        (void)hipGetLastError();
        grid = cus;
    }
    if (grid < 0) return;
    if (hipMemsetAsync((char*)d_ws + WS_CTL, 0, CTL_ZERO_BYTES, stream) != hipSuccess) return;
    Args a{};
    for (int i = 0; i < 33; ++i) a.in[i] = (const float*)d_in[i];
    a.out = (float*)d_out; a.ws = (unsigned char*)d_ws; a.pad = 0;
#if MK_ONE_LAUNCH
    a.ph_lo = 0; a.ph_hi = N_PHASES; a.use_bar = 1;
    hipLaunchKernelGGL(fwd_kernel, dim3(grid), dim3(NTHR), LDS_BYTES, stream, a);
    if ((REPMASK >> 15) & 1) {
        (void)hipMemsetAsync((char*)d_ws + WS_CTL, 0, CTL_ZERO_BYTES, stream);
        hipLaunchKernelGGL(fwd_kernel, dim3(grid), dim3(NTHR), LDS_BYTES, stream, a); }
#else
    for (int p = 0; p < N_PHASES; ++p) { a.ph_lo = p; a.ph_hi = p + 1; a.use_bar = 0;
        hipLaunchKernelGGL(fwd_kernel, dim3(grid), dim3(NTHR), LDS_BYTES, stream, a); }
#endif
}
```

```cpp
#include <hip/hip_runtime.h>
#include <cstdio>
#include <cstdint>
#define MK_ONE_LAUNCH 1
namespace pg8 {
#define PG8_LAS __attribute__((address_space(3)))
typedef unsigned short bf16_t;
typedef short bf16x8 __attribute__((ext_vector_type(8)));
typedef float f32x4 __attribute__((ext_vector_type(4)));
typedef unsigned u32x4 __attribute__((ext_vector_type(4)));
constexpr int BM = 256, BK = 64, HALF = 128, HTB = HALF * BK * 2  , STAGE_BYTES = 8 * HTB, NXCD = 8, WGM = 8;

__host__ __device__ __forceinline__ int lds_byte(int r, int c) { const int st = (r >> 4) * 2 + (c >> 5), rr = r & 15, cc = c & 31, ob = rr * 64 + cc * 2; return st * 1024 + (ob ^ (((ob >> 9) & 1) << 5)); }
__host__ __device__ __forceinline__ void stage_rc(int b, int& R, int& C) { const int st = b / 1024, sb = b % 1024, swz = sb ^ (((sb >> 9) & 1) << 5); R = (st >> 1) * 16 + swz / 64; C = (st & 1) * 32 + (swz % 64) / 2; }
__host__ __device__ __forceinline__ int perm32(int rho) { const int n = rho >> 4, i = rho & 15; return 8 * (i >> 2) + 4 * n + (i & 3); }

struct Unit { int pm, pn; };
struct Gemm { const bf16_t* A; const bf16_t* Bt; int M, N, K; };

struct StaticOrder {
    int nM, nN, nwg, G, c;
    __host__ __device__ void init(int M, int N, int G_, int c_) { nM = M / BM; nN = N / BM; nwg = nM * nN; G = G_; c = c_; }
    __host__ __device__ bool next(int i, Unit& u) const {
        const long L = (long)i * G + c; if (L >= nwg) return false;
        int wgid = (int)L; { const int q = nwg / NXCD, r = nwg % NXCD, xcd = wgid % NXCD, off = wgid / NXCD; wgid = (xcd < r ? xcd * (q + 1) : r * (q + 1) + (xcd - r) * q) + off; }
        const int nig = WGM * nN, gid = wgid / nig, fm = gid * WGM, gsz = (nM - fm) < WGM ? (nM - fm) : WGM;
        u.pm = fm + ((wgid % nig) % gsz); u.pn = (wgid % nig) / gsz; return true;
    }
    __device__ __forceinline__ void a_ready(const Unit&) const {}
    __device__ __forceinline__ void done(const Unit&) const {}
};
__device__ __forceinline__ unsigned cvt_pk_bf16(float lo, float hi) { unsigned r; asm volatile("v_cvt_pk_bf16_f32 %0, %1, %2" : "=v"(r) : "v"(lo), "v"(hi)); return r; }
typedef float f32x2 __attribute__((ext_vector_type(2)));
struct EpiBf16P {
    static constexpr bool PERM = true, AFTER_DRAIN = false;
    bf16_t* O; int ldc;
    __device__ __forceinline__ void operator()(const f32x4 (&acc)[2][2][4][2], const Unit& u, int wr, int wc, int fr, int fq) const {
        const int row0 = u.pm * BM + wr * 64 + fr, col0 = u.pn * BM + wc * 32 + 8 * fq;
        bf16_t* Ob = O; asm volatile("" : "+s"(Ob));
#pragma unroll
        for (int ai = 0; ai < 2; ++ai)
#pragma unroll
            for (int m = 0; m < 4; ++m) { bf16_t* rowp = Ob + (size_t)(row0 + ai * HALF + m * 16) * ldc + col0;
#pragma unroll
                for (int bj = 0; bj < 2; ++bj) { const f32x4 v0 = acc[ai][bj][m][0], v1 = acc[ai][bj][m][1];
                    u32x4 w; w.x = cvt_pk_bf16(v0[0], v0[1]); w.y = cvt_pk_bf16(v0[2], v0[3]); w.z = cvt_pk_bf16(v1[0], v1[1]); w.w = cvt_pk_bf16(v1[2], v1[3]);
                    *(u32x4*)(rowp + bj * HALF) = w; } }
    }
};
struct EpiF32P {
    static constexpr bool PERM = false, AFTER_DRAIN = false;
    float* C; int ldc;
    __device__ __forceinline__ void operator()(const f32x4 (&acc)[2][2][4][2], const Unit& u, int wr, int wc, int fr, int fq) const {
        const int row0 = u.pm * BM + wr * 64 + fr, col0 = u.pn * BM + wc * 32 + 4 * fq;
        float* Cb = C; asm volatile("" : "+s"(Cb));
#pragma unroll
        for (int ai = 0; ai < 2; ++ai)
#pragma unroll
            for (int m = 0; m < 4; ++m) { float* rowp = Cb + (size_t)(row0 + ai * HALF + m * 16) * ldc + col0;
#pragma unroll
                for (int bj = 0; bj < 2; ++bj)
#pragma unroll
                    for (int n = 0; n < 2; ++n) *(f32x4*)(rowp + bj * HALF + n * 16) = acc[ai][bj][m][n]; }
    }
};
struct EpiAct {
    static constexpr bool PERM = true, AFTER_DRAIN = false;
    bf16_t* O; const float* gate;
    __device__ __forceinline__ void operator()(const f32x4 (&acc)[2][2][4][2], const Unit& u, int wr, int wc, int fr, int fq) const {
        const int row0 = u.pm * BM + wr * 64 + fr, col0 = (u.pn & 3) * 128 + wc * 32 + 8 * fq;
        bf16_t* Ob = O; const float* gb = gate; asm volatile("" : "+s"(Ob), "+s"(gb));
#pragma unroll
        for (int ai = 0; ai < 2; ++ai)
#pragma unroll
            for (int m = 0; m < 4; ++m) { const int row = row0 + ai * HALF + m * 16; const float gt = gb[row];
                float o[8];
#pragma unroll
                for (int n = 0; n < 2; ++n)
#pragma unroll
                    for (int i = 0; i < 4; ++i) { const float g = acc[ai][0][m][n][i], up = acc[ai][1][m][n][i]; o[n * 4 + i] = g / (1.0f + __expf(-g)) * up * gt; }
                u32x4 w; w.x = cvt_pk_bf16(o[0], o[1]); w.y = cvt_pk_bf16(o[2], o[3]); w.z = cvt_pk_bf16(o[4], o[5]); w.w = cvt_pk_bf16(o[6], o[7]);
                bf16_t* dst = Ob + (size_t)row * 512 + col0;
                *(u32x4*)dst = w; }
    }
};
struct EpiDn {
    static constexpr bool PERM = true, AFTER_DRAIN = false;
    bf16_t* O;
    __device__ __forceinline__ void operator()(const f32x4 (&acc)[2][2][4][2], const Unit& u, int wr, int wc, int fr, int fq) const {
        const int row0 = u.pm * BM + wr * 64 + fr, col0 = (u.pn & 7) * BM + wc * 32 + 8 * fq;
        bf16_t* Ob = O; asm volatile("" : "+s"(Ob));
#pragma unroll
        for (int ai = 0; ai < 2; ++ai)
#pragma unroll
            for (int m = 0; m < 4; ++m) { bf16_t* rowp = Ob + (size_t)(row0 + ai * HALF + m * 16) * 2048 + col0;
#pragma unroll
                for (int bj = 0; bj < 2; ++bj) { const f32x4 v0 = acc[ai][bj][m][0], v1 = acc[ai][bj][m][1];
                    u32x4 w; w.x = cvt_pk_bf16(v0[0], v0[1]); w.y = cvt_pk_bf16(v0[2], v0[3]); w.z = cvt_pk_bf16(v1[0], v1[1]); w.w = cvt_pk_bf16(v1[2], v1[3]);
                    *(u32x4*)(rowp + bj * HALF) = w; } }
    }
};
struct MoeOrder {
    const int* tile_e; int ntiles, nsub, G, c;
    __device__ __forceinline__ bool next(int i, Unit& u) const {
        const int L = i * G + c; if (L >= ntiles * nsub) return false;
        const int t = L / nsub, j = L - t * nsub; u.pm = t; u.pn = tile_e[t] * nsub + j; return true;
    }
    __device__ __forceinline__ void a_ready(const Unit&) const {}
    __device__ __forceinline__ void done(const Unit&) const {}
};
template <class Epi, class Sched, bool ALIGN_EPI = false, bool SP2 = false>
__device__ __forceinline__ void gemm_phase(PG8_LAS unsigned char* lds, const Gemm g, const Sched& S, const Epi& E) {
    int tid_ = threadIdx.x; asm volatile("" : "+v"(tid_));
    const int tid = tid_, wid = __builtin_amdgcn_readfirstlane(tid >> 6), lane = tid & 63, wr = wid >> 2, wc = wid & 3, fr = lane & 15, fq = lane >> 4;
    const int K = g.K, nt = K / BK;
    unsigned voffA[2], voffB[2];
#pragma unroll
    for (int i = 0; i < 2; ++i) { int R, C; stage_rc(tid * 16 + i * 8192, R, C); const int Rb = Epi::PERM ? ((R & ~31) + perm32(R & 31)) : R;
        voffA[i] = (unsigned)(R * K + C) * 2u; voffB[i] = (unsigned)(Rb * K + C) * 2u; }
    const size_t kstep = (size_t)(BK * 2);
    const size_t hstep = (size_t)HALF * K * 2;
    const size_t tstep = 2 * hstep;
    const unsigned ldsw = (unsigned)wid * 1024u;
    const int aoff = lds_byte(wr * 64 + fr, fq * 8), boff = lds_byte(wc * 32 + fr, fq * 8);
#define PG8_SA(b, h) (((b) * 2 + (h)) * HTB)
#define PG8_SB(b, h) ((4 + (b) * 2 + (h)) * HTB)
#define PG8_STAGE(bufoff, gbase, voff) do { _Pragma("unroll") for (int _i = 0; _i < 2; ++_i) \
        __builtin_amdgcn_global_load_lds((const unsigned*)((const char*)(gbase) + (voff)[_i]), (PG8_LAS unsigned*)(lds + (bufoff) + ldsw + _i * 8192), 16, 0, 0); } while (0)
#define PG8_LDA(dst, b, h) do { _Pragma("unroll") for (int m = 0; m < 4; ++m) _Pragma("unroll") for (int k = 0; k < 2; ++k) dst[m][k] = *(const PG8_LAS bf16x8*)(lds + PG8_SA(b, h) + aoff + m * 2048 + k * 1024); } while (0)
#define PG8_LDB(dst, b, h) do { _Pragma("unroll") for (int n = 0; n < 2; ++n) _Pragma("unroll") for (int k = 0; k < 2; ++k) dst[n][k] = *(const PG8_LAS bf16x8*)(lds + PG8_SB(b, h) + boff + n * 2048 + k * 1024); } while (0)
#define PG8_MMA(ai, bj, At, Bt) do { __builtin_amdgcn_s_setprio(1); _Pragma("unroll") for (int m = 0; m < 4; ++m) _Pragma("unroll") for (int n = 0; n < 2; ++n) _Pragma("unroll") for (int k = 0; k < 2; ++k) \
        acc[ai][bj][m][n] = __builtin_amdgcn_mfma_f32_16x16x32_bf16(Bt[n][k], At[m][k], acc[ai][bj][m][n], 0, 0, 0); __builtin_amdgcn_s_setprio(0); } while (0)
#define PG8_WAIT_V(n) asm volatile("s_waitcnt vmcnt(" #n ")" ::: "memory")
#define PG8_WAIT_L(n) asm volatile("s_waitcnt lgkmcnt(" #n ")" ::: "memory")
#define PG8_BAR __builtin_amdgcn_s_barrier()
#define PG8_SCHED __builtin_amdgcn_sched_barrier(0)
    Unit cur, nxt; int ui = 0;
    if (!S.next(0, cur)) return;
    f32x4 acc[2][2][4][2];
#pragma unroll
    for (int a = 0; a < 2; ++a)
#pragma unroll
        for (int b = 0; b < 2; ++b)
#pragma unroll
            for (int m = 0; m < 4; ++m)
#pragma unroll
                for (int n = 0; n < 2; ++n) acc[a][b][m][n] = (f32x4){0.f, 0.f, 0.f, 0.f};
    bf16x8 At[4][2], B0[2][2], B1[2][2];
    const char* cA = (const char*)g.A + (size_t)cur.pm * tstep; const char* cB = (const char*)g.Bt + (size_t)cur.pn * tstep;
    S.a_ready(cur);
    if constexpr (SP2) {
        PG8_STAGE(PG8_SB(0, 0), cB, voffB); PG8_STAGE(PG8_SB(0, 1), cB + hstep, voffB); PG8_STAGE(PG8_SA(0, 0), cA, voffA); PG8_STAGE(PG8_SA(0, 1), cA + hstep, voffA);
        if (wr == 1) PG8_BAR;
        PG8_WAIT_V(2); PG8_BAR;
        PG8_STAGE(PG8_SB(1, 0), cB + kstep, voffB); PG8_STAGE(PG8_SA(1, 0), cA + kstep, voffA); PG8_STAGE(PG8_SB(1, 1), cB + hstep + kstep, voffB);
        PG8_WAIT_V(6); PG8_BAR;
    } else {
        PG8_STAGE(PG8_SB(0, 0), cB, voffB); PG8_STAGE(PG8_SA(0, 0), cA, voffA); PG8_STAGE(PG8_SB(0, 1), cB + hstep, voffB); PG8_STAGE(PG8_SA(0, 1), cA + hstep, voffA);
        if (wr == 1) PG8_BAR;
        PG8_WAIT_V(4); PG8_BAR;
        PG8_STAGE(PG8_SB(1, 0), cB + kstep, voffB); PG8_STAGE(PG8_SA(1, 0), cA + kstep, voffA); PG8_STAGE(PG8_SB(1, 1), cB + hstep + kstep, voffB);
        PG8_WAIT_V(6); PG8_BAR;
    }
    for (;;) {
        const bool has_next = S.next(ui + 1, nxt);
        const char* nA = has_next ? (const char*)g.A + (size_t)nxt.pm * tstep : cA; const char* nB = has_next ? (const char*)g.Bt + (size_t)nxt.pn * tstep : cB;
        for (int t = 0; t < nt; t += 2) {
            const bool last = (t == nt - 2);
            const char* a1 = cA + (size_t)(t + 1) * kstep;
            const char* a2 = last ? nA : cA + (size_t)(t + 2) * kstep; const char* b2 = last ? nB : cB + (size_t)(t + 2) * kstep;
            const char* a3 = a2 + kstep; const char* b3 = b2 + kstep;
            if (last && has_next) S.a_ready(nxt);
            if constexpr (SP2) {
            PG8_LDB(B0, 0, 0); PG8_LDB(B1, 0, 1); PG8_SCHED; PG8_LDA(At, 0, 0); PG8_STAGE(PG8_SA(1, 1), a1 + hstep, voffA);
            PG8_WAIT_V(8); PG8_WAIT_L(0); PG8_BAR; PG8_MMA(0, 0, At, B0); PG8_MMA(0, 1, At, B1); PG8_BAR; PG8_SCHED;
            PG8_LDA(At, 0, 1); PG8_STAGE(PG8_SB(0, 0), b2, voffB); PG8_STAGE(PG8_SB(0, 1), b2 + hstep, voffB); PG8_STAGE(PG8_SA(0, 0), a2, voffA);
            PG8_WAIT_V(8); PG8_WAIT_L(0); PG8_BAR; PG8_MMA(1, 0, At, B0); PG8_MMA(1, 1, At, B1); PG8_BAR; PG8_SCHED;
            PG8_LDB(B0, 1, 0); PG8_LDB(B1, 1, 1); PG8_SCHED; PG8_LDA(At, 1, 0); PG8_STAGE(PG8_SA(0, 1), a2 + hstep, voffA);
            PG8_WAIT_V(8); PG8_WAIT_L(0); PG8_BAR; PG8_MMA(0, 0, At, B0); PG8_MMA(0, 1, At, B1); PG8_BAR; PG8_SCHED;
            PG8_LDA(At, 1, 1); PG8_STAGE(PG8_SB(1, 0), b3, voffB); PG8_STAGE(PG8_SB(1, 1), b3 + hstep, voffB); PG8_STAGE(PG8_SA(1, 0), a3, voffA);
            PG8_WAIT_V(8); PG8_WAIT_L(0); PG8_BAR; PG8_MMA(1, 0, At, B0); PG8_MMA(1, 1, At, B1); PG8_BAR; PG8_SCHED;
            } else {
            PG8_LDB(B0, 0, 0); PG8_SCHED; PG8_LDA(At, 0, 0); PG8_STAGE(PG8_SA(1, 1), a1 + hstep, voffA);
            PG8_WAIT_L(8); PG8_BAR; PG8_WAIT_L(0); PG8_MMA(0, 0, At, B0); PG8_BAR; PG8_SCHED;
            PG8_LDB(B1, 0, 1); PG8_STAGE(PG8_SB(0, 0), b2, voffB);
            PG8_BAR; PG8_WAIT_L(0); PG8_MMA(0, 1, At, B1); PG8_BAR;
            PG8_LDA(At, 0, 1); PG8_STAGE(PG8_SA(0, 0), a2, voffA);
            PG8_BAR; PG8_WAIT_L(0); PG8_MMA(1, 0, At, B0); PG8_BAR; PG8_SCHED;
            PG8_STAGE(PG8_SB(0, 1), b2 + hstep, voffB);
            PG8_WAIT_V(6); PG8_BAR; PG8_MMA(1, 1, At, B1); PG8_BAR;
            PG8_LDB(B0, 1, 0); PG8_SCHED; PG8_LDA(At, 1, 0); PG8_STAGE(PG8_SA(0, 1), a2 + hstep, voffA);
            PG8_WAIT_L(8); PG8_BAR; PG8_WAIT_L(0); PG8_MMA(0, 0, At, B0); PG8_BAR; PG8_SCHED;
            PG8_LDB(B1, 1, 1); PG8_STAGE(PG8_SB(1, 0), b3, voffB);
            PG8_BAR; PG8_WAIT_L(0); PG8_MMA(0, 1, At, B1); PG8_BAR;
            PG8_LDA(At, 1, 1); PG8_STAGE(PG8_SA(1, 0), a3, voffA);
            PG8_BAR; PG8_WAIT_L(0); PG8_MMA(1, 0, At, B0); PG8_BAR; PG8_SCHED;
            PG8_STAGE(PG8_SB(1, 1), b3 + hstep, voffB);
            PG8_WAIT_V(6); PG8_BAR; PG8_MMA(1, 1, At, B1); PG8_BAR;
            }
        }
        if constexpr (ALIGN_EPI) { if (wr == 0) PG8_BAR; }
        if constexpr (!Epi::AFTER_DRAIN) { E(acc, cur, wr, wc, fr, fq); S.done(cur); }
        if (!has_next) break;
#pragma unroll
        for (int a = 0; a < 2; ++a)
#pragma unroll
            for (int b = 0; b < 2; ++b)
#pragma unroll
                for (int m = 0; m < 4; ++m)
#pragma unroll
                    for (int n = 0; n < 2; ++n) acc[a][b][m][n] = (f32x4){0.f, 0.f, 0.f, 0.f};
        cur = nxt; cA = nA; cB = nB; ++ui;
        if constexpr (ALIGN_EPI) { if (wr == 1) PG8_BAR; }
    }
    PG8_WAIT_V(0);
    if constexpr (!ALIGN_EPI) { if (wr == 0) PG8_BAR; }
    PG8_BAR;
    if constexpr (Epi::AFTER_DRAIN) { E.fused(acc, cur, wr, wc, fr, fq, lds, wid, lane); S.done(cur); }
#undef PG8_SA
#undef PG8_SB
#undef PG8_STAGE
#undef PG8_LDA
#undef PG8_LDB
#undef PG8_MMA
#undef PG8_WAIT_V
#undef PG8_WAIT_L
#undef PG8_BAR
#undef PG8_SCHED
}
template <bool IS_UP, class Epi>
__device__ __forceinline__ void moe_unit(PG8_LAS unsigned char* lds, const bf16_t* A, const int* rlist, const float* W, const PG8_LAS int* tab, const int t, const int j, const Epi& E) {
    constexpr int MT_OFF = 0, MT_CNT = 33, MT_TILE = 66, CAP = 9216;
    constexpr int K = IS_UP ? 2048 : 512, NSUB = IS_UP ? 4 : 8, NT = K / 64, WN = IS_UP ? 1024 : 2048;
    int tid_ = threadIdx.x; asm volatile("" : "+v"(tid_));
    const int tid = tid_, wid = __builtin_amdgcn_readfirstlane(tid >> 6), lane = tid & 63, wr = wid >> 2, wc = wid & 3, fr = lane & 15, fq = lane >> 4;
    const int key = (fr >> 1) & 7;
    const int arow = 64 * wr + fr, brow = 32 * wc + fr;
    const int ch0 = ((fq) ^ key) << 4, ch1 = ((fq + 4) ^ key) << 4;
    int awo[4], bwo[4];
#pragma unroll
    for (int p = 0; p < 4; ++p) { const int row = (tid >> 3) + 64 * p; awo[p] = row * 128 + (((tid & 7) ^ ((row >> 1) & 7)) << 4); }
#pragma unroll
    for (int cc = 0; cc < 4; ++cc) { const int rho = 32 * (lane >> 3) + 16 * (lane & 1) + 4 * ((lane >> 1) & 3) + cc; bwo[cc] = rho * 128 + ((wid ^ ((rho >> 1) & 7) ^ ((rho >> 4) & 1)) << 4); }
    int e = 0, eoff = 0, ecnt = 0; const char* agp[4] = {nullptr, nullptr, nullptr, nullptr}; const float* wg = nullptr;
    u32x4 ar[4]; f32x4 wv[8];
#define MG_UNIT() do { { \
        e = __builtin_amdgcn_readfirstlane(tab[MT_TILE + t]); eoff = __builtin_amdgcn_readfirstlane(tab[MT_OFF + e]); ecnt = __builtin_amdgcn_readfirstlane(tab[MT_CNT + e]); \
        _Pragma("unroll") for (int p = 0; p < 4; ++p) { const int sr = t * 256 + (tid >> 3) + 64 * p, li = sr - eoff;     \
            const size_t ar_ = IS_UP ? (size_t)((li < ecnt) ? rlist[e * CAP + li] : 0) : (size_t)sr; agp[p] = (const char*)(A + ar_ * K) + (tid & 7) * 16; } \
        wg = W + (size_t)e * K * WN + (size_t)(8 * wid) * WN + (IS_UP ? ((lane < 32) ? j * 128 + 4 * lane : 512 + j * 128 + 4 * (lane - 32)) : j * 256 + 4 * lane); } } while (0)
#define MG_LOAD(kt) do { _Pragma("unroll") for (int p = 0; p < 4; ++p) ar[p] = *(const u32x4*)(agp[p] + (kt) * 128); \
        _Pragma("unroll") for (int i = 0; i < 8; ++i) wv[i] = *(const f32x4*)(wg + (size_t)((kt) * 64 + i) * WN); } while (0)
#define MG_WRITE(buf) do { PG8_LAS unsigned char* ab_ = lds + (buf) * 32768; PG8_LAS unsigned char* bb_ = lds + 65536 + (buf) * 32768; \
        _Pragma("unroll") for (int p = 0; p < 4; ++p) *(PG8_LAS u32x4*)(ab_ + awo[p]) = ar[p]; \
        _Pragma("unroll") for (int cc = 0; cc < 4; ++cc) { u32x4 o; o.x = cvt_pk_bf16(wv[0][cc], wv[1][cc]); o.y = cvt_pk_bf16(wv[2][cc], wv[3][cc]); o.z = cvt_pk_bf16(wv[4][cc], wv[5][cc]); o.w = cvt_pk_bf16(wv[6][cc], wv[7][cc]); \
            *(PG8_LAS u32x4*)(bb_ + bwo[cc]) = o; } } while (0)
    MG_UNIT();
    MG_LOAD(0);
    {
        f32x4 acc[2][2][4][2];
#pragma unroll
        for (int a = 0; a < 2; ++a)
#pragma unroll
            for (int b = 0; b < 2; ++b)
#pragma unroll
                for (int m = 0; m < 4; ++m)
#pragma unroll
                    for (int n = 0; n < 2; ++n) acc[a][b][m][n] = (f32x4){0.f, 0.f, 0.f, 0.f};
        MG_WRITE(0);
        __syncthreads();
#pragma unroll 1
        for (int kt = 0; kt < NT; ++kt) {
            const int cur = kt & 1;
            if (kt + 1 < NT) MG_LOAD(kt + 1);
            __builtin_amdgcn_sched_barrier(0);
            { const PG8_LAS unsigned char* ab = lds + cur * 32768; const PG8_LAS unsigned char* bb = lds + 65536 + cur * 32768;
#pragma unroll
              for (int k = 0; k < 2; ++k) { const int chk = k ? ch1 : ch0;
                  bf16x8 Bf[2][2];
#pragma unroll
                  for (int bj = 0; bj < 2; ++bj)
#pragma unroll
                      for (int n = 0; n < 2; ++n) Bf[bj][n] = *(const PG8_LAS bf16x8*)(bb + (128 * bj + 16 * n + brow) * 128 + (n ? chk ^ 16 : chk));
                  bf16x8 Ac = *(const PG8_LAS bf16x8*)(ab + arow * 128 + chk), An = *(const PG8_LAS bf16x8*)(ab + (16 + arow) * 128 + chk);
#pragma unroll
                  for (int im = 0; im < 8; ++im) { const int ai = im >> 2, m = im & 3; bf16x8 Af = An;
                      if (im + 2 < 8) Af = *(const PG8_LAS bf16x8*)(ab + (128 * ((im + 2) >> 2) + 16 * ((im + 2) & 3) + arow) * 128 + chk);
                      __builtin_amdgcn_sched_barrier(0);
#pragma unroll
                      for (int bj = 0; bj < 2; ++bj)
#pragma unroll
                          for (int n = 0; n < 2; ++n) acc[ai][bj][m][n] = __builtin_amdgcn_mfma_f32_16x16x32_bf16(Bf[bj][n], Ac, acc[ai][bj][m][n], 0, 0, 0);
                      __builtin_amdgcn_sched_barrier(0);
                      Ac = An; An = Af; } } }
            __builtin_amdgcn_sched_barrier(0);
            if (kt + 1 < NT) MG_WRITE(cur ^ 1);
            __syncthreads();
        }
        const Unit u{t, j}; const float* gbase = nullptr; if constexpr (IS_UP) gbase = E.gate + (size_t)e * CAP - eoff;
        if constexpr (IS_UP) { Epi E2 = E; E2.gate = gbase; E2(acc, u, wr, wc, fr, fq); }
        else E(acc, u, wr, wc, fr, fq);
    }
#undef MG_UNIT
#undef MG_LOAD
#undef MG_WRITE
}
}
#define LAS __attribute__((address_space(3)))
#define XB_TMO      128
#define XB_XCNT(j)  (256  + 64 * (j))
#define XB_XSUB(j)  (1280 + 64 * (j))
#define XB_XGEN(j)  (2304 + 64 * (j))
#define XB_TOP      3328
#define XB_TOPGEN   3392
#define XCD_BAR_WORDS 3456
#define XB_SPIN_CAP (1u << 18)

__device__ __forceinline__ unsigned xb_ld(unsigned* p)              { return __hip_atomic_load(p, __ATOMIC_RELAXED, __HIP_MEMORY_SCOPE_AGENT); }
__device__ __forceinline__ unsigned xb_add(unsigned* p, unsigned v) { return __hip_atomic_fetch_add(p, v, __ATOMIC_RELAXED, __HIP_MEMORY_SCOPE_AGENT); }
__device__ __forceinline__ unsigned xb_xcc_id() { return (unsigned)__builtin_amdgcn_s_getreg((3 << 11) | 20) & 0xFu; }
#define XB_SPIN(cond, bar) do { unsigned _sp = 0; while (cond) { __builtin_amdgcn_s_sleep(1); \
    if ((++_sp & 255u) == 0u) { if (xb_ld(&(bar)[XB_TMO])) break; if (_sp > XB_SPIN_CAP) { atomicAdd(&(bar)[XB_TMO], 1u); break; } } } } while (0)

struct XcdBarrier {
    unsigned* bar; unsigned x;
    volatile LAS unsigned* st;
};

__device__ __forceinline__ XcdBarrier xcd_barrier_post(unsigned* bar, volatile LAS unsigned* st) {
    XcdBarrier b; b.bar = bar; b.x = xb_xcc_id(); b.st = st;
    if (threadIdx.x == 0) (void)xb_add(&bar[XB_XCNT(b.x)], 1u);
    return b;
}
__device__ __forceinline__ void xcd_barrier_complete(unsigned* bar, unsigned x, unsigned& nloc, unsigned& nx) {
    const unsigned G = gridDim.x * gridDim.y * gridDim.z;
    unsigned sum, cnt, mine, sp = 0u;
    for (;;) {
        sum = 0u; cnt = 0u; mine = 0u;
#pragma unroll
        for (unsigned j = 0; j < 16; ++j) { const unsigned c = xb_ld(&bar[XB_XCNT(j)]); sum += c; cnt += (c > 0u) ? 1u : 0u; mine = (j == x) ? c : mine; }
        if (sum == G) break;
        __builtin_amdgcn_s_sleep(1);
        if ((++sp & 255u) == 0u) { if (xb_ld(&bar[XB_TMO])) break; if (sp > XB_SPIN_CAP) { atomicAdd(&bar[XB_TMO], 1u); break; } }
    }
    nloc = mine > 0u ? mine : 1u; nx = cnt > 0u ? cnt : 1u;
}

__device__ __forceinline__ void xcd_barrier(const XcdBarrier& b) {
    asm volatile("s_waitcnt vmcnt(0)" ::: "memory");
    __syncthreads();
    if (threadIdx.x == 0) {
        unsigned* bar = b.bar;
        __builtin_amdgcn_s_waitcnt(0);
        unsigned nloc = b.st[0], nx = b.st[1];
        if (nloc == 0u) { xcd_barrier_complete(bar, b.x, nloc, nx); b.st[0] = nloc; b.st[1] = nx; }
        const unsigned old = xb_add(&bar[XB_XSUB(b.x)], 1u);
        const unsigned gen = old / nloc;
        if (old + 1u == (gen + 1u) * nloc) {
            __builtin_amdgcn_fence(__ATOMIC_RELEASE, "agent");
            asm volatile("s_waitcnt vmcnt(0)" ::: "memory");
            const unsigned og = xb_add(&bar[XB_TOP], 1u);
            const unsigned tg = og / nx;
            if (og + 1u == (tg + 1u) * nx) xb_add(&bar[XB_TOPGEN], 1u);
            else XB_SPIN(xb_ld(&bar[XB_TOPGEN]) == tg, bar);
            __builtin_amdgcn_fence(__ATOMIC_ACQUIRE, "agent");
            xb_add(&bar[XB_XGEN(b.x)], 1u);
            asm volatile("s_waitcnt vmcnt(0)" ::: "memory");
        } else {
            XB_SPIN(xb_ld(&bar[XB_XGEN(b.x)]) == gen, bar);
            __builtin_amdgcn_fence(__ATOMIC_ACQUIRE, "agent");
            asm volatile("s_waitcnt vmcnt(0)" ::: "memory");
        }
    }
    __syncthreads();
}
constexpr int DM = 2048, NB = 4, SEQ = 2048, CTXL = 256, TLAT = NB * SEQ, TCTX = NB * CTXL, TTOT = TLAT + TCTX;
constexpr int INC = 6176, INCP = 6400;
constexpr int C_HY = 0, C_NQ = 1536, C_NK = 2304, C_NV = 3072, C_GQ = 3840, C_GK = 4224, C_GV = 4608, C_GG = 5376, C_GA = 6144;
constexpr int M_NA = 512, M_GLA = 1280;
constexpr int HYC = 512, NAH = 6, GH = 6;
constexpr int NEXP = 32, DEXP = 512;
constexpr int NLAYER = 2;
constexpr float LN_EPS = 1e-6f;
constexpr float ALPHA = 1.41421356237f;
constexpr int MAXSLOTS = 26624;
constexpr int GSTEPS = 36;

constexpr size_t MiB = 1u << 20;
constexpr size_t WS_CTL = 0, CTL_ZERO_BYTES = 64 * 1024;
constexpr size_t WS_WIN = 2 * MiB;
constexpr size_t WS_WOUT = 52 * MiB;
constexpr size_t WS_WUP = 68 * MiB;
constexpr size_t WS_WDN = 324 * MiB;
constexpr size_t WS_KF = 452 * MiB;
constexpr size_t WS_KFC = 468 * MiB;
constexpr size_t WS_WRT = 469 * MiB;
constexpr size_t WS_H = 470 * MiB;
constexpr size_t WS_PROJ = 506 * MiB;
constexpr size_t WS_MIX = 620 * MiB;
constexpr size_t WS_Y = 656 * MiB;
constexpr size_t WS_X1 = 728 * MiB;
constexpr size_t WS_X2 = 800 * MiB;
constexpr size_t WS_XG = 872 * MiB;
constexpr size_t WS_ACT = 976 * MiB;
constexpr size_t WS_ACT1 = 68 * MiB;
constexpr size_t WS_DN = 1002 * MiB;
constexpr size_t WS_ST = 1106 * MiB;
constexpr size_t WS_DEC = 1160 * MiB;
constexpr size_t WS_ASG = 1161 * MiB;
constexpr size_t WS_SLOT = 1162 * MiB;
constexpr size_t WS_GATE = 1162 * MiB + 512 * 1024;
constexpr size_t WS_TILE = 1163 * MiB;
constexpr size_t WS_VTL = 1164 * MiB;
constexpr size_t WS_VTC = 1177 * MiB;
constexpr size_t WS_KTL = 1206 * MiB;
constexpr size_t WS_KTC = 1219 * MiB;
constexpr size_t WS_ZT = 1179 * MiB;
constexpr size_t WS_X0T = 1187 * MiB;
constexpr size_t WS_YT = 1195 * MiB;
constexpr size_t WS_ZTC = 1203 * MiB, WS_X0TC = 1204 * MiB, WS_YTC = 1205 * MiB;
constexpr size_t WS_CF = 1221 * MiB;
constexpr size_t WS_END = 1250 * MiB;
constexpr int CW_BAR = 4096;
constexpr int CW_CNT = 8192;
constexpr int CW_MOD = 65536;

constexpr int RING_BYTES = 131072;
constexpr int LDSCTL_OFF = 143360, LDS_BYTES = 147456;
constexpr int NWAVES = 8, NTHR = 512;


typedef unsigned short bf16;
typedef unsigned v4u __attribute__((ext_vector_type(4)));
typedef unsigned v2u __attribute__((ext_vector_type(2)));
typedef float f32x4 __attribute__((ext_vector_type(4)));
typedef short bf16x8 __attribute__((ext_vector_type(8)));
#define LDS_WAIT() asm volatile("s_waitcnt lgkmcnt(0)" ::: "memory")
__device__ __forceinline__ unsigned f2bf(float f) { unsigned u = __builtin_bit_cast(unsigned, f); return (u + 0x7fffu + ((u >> 16) & 1u)) >> 16; }
__device__ __forceinline__ unsigned pk2(float lo, float hi) { return f2bf(lo) | (f2bf(hi) << 16); }
__device__ __forceinline__ float bf2f(unsigned short b) { return __builtin_bit_cast(float, (unsigned)b << 16); }
__device__ __forceinline__ float bflo(unsigned w) { return __builtin_bit_cast(float, w << 16); }
__device__ __forceinline__ float bfhi(unsigned w) { return __builtin_bit_cast(float, w & 0xffff0000u); }
__device__ __forceinline__ float wave_sum(float v) {
#pragma unroll
    for (int o = 1; o < 64; o <<= 1) v += __shfl_xor(v, o);
    return v;
}
__device__ __forceinline__ float wave_max(float v) {
#pragma unroll
    for (int o = 1; o < 64; o <<= 1) v = fmaxf(v, __shfl_xor(v, o));
    return v;
}
__device__ __forceinline__ float silu_f(float x) { return x / (1.0f + __expf(-x)); }
__device__ __forceinline__ float logsigmoid_f(float z) { return fminf(z, 0.f) - __logf(1.0f + __expf(-fabsf(z))); }

#define KAS __attribute__((address_space(4)))
#define GAS __attribute__((address_space(1)))
#define RELAUNDER(F) do { asm volatile("" : "+s"(F.ws), "+s"(F.in)); asm volatile("" : "+v"(F.tid)); F.lane = F.tid & 63; F.wave = __builtin_amdgcn_readfirstlane(F.tid >> 6); F.ctl = (GAS unsigned*)F.ws; } while (0)
#define INP(i) ((const float*)F.in[i])
struct Fr {
    LAS unsigned char* lds;
    int tid, lane, wave, G, bid;
    const GAS float* const KAS* in;
    GAS float* out; GAS unsigned char* ws;
    GAS unsigned* ctl;
};
#define IN_X 0
#define IN_C 1
#define IN_CTX 2
#define IN_CCTX 3
#define IN_WADA 4
#define IN_BADA 5
#define IN_WIN 6
#define IN_HYSW 7
#define IN_HYSB 8
#define IN_HYW1 9
#define IN_HYB1 10
#define IN_HYW2 11
#define IN_HYB2 12
#define IN_HYW3 13
#define IN_HYFR 14
#define IN_HYBIAS 15
#define IN_HYNW 16
#define IN_RPB 17
#define IN_NANW 18
#define IN_GAW2 19
#define IN_GAB 20
#define IN_GNW 21
#define IN_WOUT 22
#define IN_LN1G 23
#define IN_LN1B 24
#define IN_WRG 25
#define IN_BRG 26
#define IN_WRE 27
#define IN_BRE 28
#define IN_WUP 29
#define IN_WDN 30
#define IN_LN2G 31
#define IN_LN2B 32

__device__ __forceinline__ void transpose_item(const float* W, int ldw, bf16* WT, int ldt, int k0, int n0, int dst_row0, bool full, LAS float* scr, int lane) {
    const float* src = W + (size_t)k0 * ldw + n0 + lane; const bool ok = full || lane < 32;
    float v[64];
#pragma unroll
    for (int kk = 0; kk < 64; ++kk) v[kk] = ok ? src[(size_t)kk * ldw] : 0.f;
#pragma unroll
    for (int kk = 0; kk < 64; ++kk) scr[kk * 65 + lane] = v[kk];
    LDS_WAIT(); asm volatile("" ::: "memory");
    const int c = lane & 7;
#pragma unroll
    for (int j = 0; j < 8; ++j) { const int n = (lane >> 3) + 8 * j; const LAS float* s = scr + (8 * c) * 65 + n;
        v4u o; o.x = pk2(s[0 * 65], s[1 * 65]); o.y = pk2(s[2 * 65], s[3 * 65]); o.z = pk2(s[4 * 65], s[5 * 65]); o.w = pk2(s[6 * 65], s[7 * 65]);
        if (full || n < 32) *(v4u*)(WT + (size_t)(dst_row0 + n) * ldt + k0 + 8 * c) = o; }
    LDS_WAIT(); asm volatile("" ::: "memory");
}

__device__ __forceinline__ void hy_filter_item(const Fr& F, int L, int l, int pb, float* KFo) {
    LAS float* zf = (LAS float*)F.lds;
    LAS float* h1 = zf + 32 * 33;
    LAS float* h2 = h1 + 32 * 64;
    const int n0 = pb * 32, tid = F.tid;
    const float* w1 = INP(IN_HYW1) + L * 33 * 64; const float* b1 = INP(IN_HYB1) + L * 64;
    const float* w2 = INP(IN_HYW2) + L * 64 * 64; const float* b2 = INP(IN_HYB2) + L * 64;
    const float* w3 = INP(IN_HYW3) + L * 64 * 1024; const float* fr = INP(IN_HYFR) + L * 64;
    const float tden = 1.0f / (float)(l - 1);
    for (int idx = tid; idx < 32 * 33; idx += NTHR) {
        const int p = idx / 33, i = idx - p * 33; const float n = (float)(n0 + p); float val;
        if (i == 0) val = n * tden;
        else { const int j = (i - 1) & 15; const float band = 1e-4f + (float)j * ((15.0f - 1e-4f) / 15.0f);
            float turns = n * band * (1.0f / (float)l); turns -= floorf(turns);
            const float ang = 6.283185307179586f * turns;
            val = (i <= 16) ? __cosf(ang) : -__sinf(ang); }
        zf[idx] = val;
    }
    __syncthreads();
    for (int idx = tid; idx < 32 * 64; idx += NTHR) { const int p = idx >> 6, j = idx & 63; float s = b1[j];
        for (int i = 0; i < 33; ++i) s += zf[p * 33 + i] * w1[i * 64 + j];
        h1[idx] = __sinf(fr[j] * s); }
    __syncthreads();
    for (int idx = tid; idx < 32 * 64; idx += NTHR) { const int p = idx >> 6, j = idx & 63; float s = b2[j];
        for (int i = 0; i < 64; ++i) s += h1[p * 64 + i] * w2[i * 64 + j];
        h2[idx] = __sinf(fr[j] * s); }
    __syncthreads();
    const int c = tid;
    const float dmin = -3.0701134573253943f, dmax = -15.350567286626972f;
    const float delta = fabsf(dmin + (float)c * ((dmax - dmin) / 511.0f));
    const float hb = INP(IN_HYBIAS)[L * HYC + c];
#pragma unroll 1
    for (int dh = 0; dh < 4; ++dh) {
        const int dir = dh >> 1, p0 = (dh & 1) * 16; const int col = dir * 512 + c; float acc[16];
#pragma unroll
        for (int p = 0; p < 16; ++p) acc[p] = 0.f;
        float wv[64];
#pragma unroll
        for (int i = 0; i < 64; ++i) wv[i] = w3[i * 1024 + col];
#pragma unroll
        for (int i = 0; i < 64; ++i) { const float w = wv[i];
#pragma unroll
            for (int p = 0; p < 16; ++p) acc[p] += h2[(p0 + p) * 64 + i] * w;
            asm volatile("" : "+v"(acc[0]), "+v"(acc[1]), "+v"(acc[2]), "+v"(acc[3]), "+v"(acc[4]), "+v"(acc[5]), "+v"(acc[6]), "+v"(acc[7]));
            asm volatile("" : "+v"(acc[8]), "+v"(acc[9]), "+v"(acc[10]), "+v"(acc[11]), "+v"(acc[12]), "+v"(acc[13]), "+v"(acc[14]), "+v"(acc[15])); }
        float* kf = KFo + (size_t)c * (2 * l);
#pragma unroll
        for (int p = 0; p < 16; ++p) { const int n = n0 + p0 + p; const float t = (float)n * tden; float v = acc[p] * __expf(-t * delta);
            if (dir == 0) { if (n == 0) { v += hb; kf[0] = 0.f; } kf[l + n] = v; }
            else if (n >= 1) kf[l - n] = v; }
    }
    __syncthreads();
}

constexpr int I_IN = 32 * 97, I_OUT = 32 * 32, I_UP = 32 * 16, I_DN = 8 * 32;
constexpr int CONV_PER_LAYER = I_IN + I_OUT;
constexpr int CW_MQ = 12800, CW_DONE = 13312;
constexpr int CW_Q = 12288;
__device__ __forceinline__ void conv_item(const Fr& F, int L, int r, LAS float* scr) {
    const int lane = F.lane;
    bf16* WinT = (bf16*)(F.ws + WS_WIN); bf16* WoutT = (bf16*)(F.ws + WS_WOUT); bf16* WupT = (bf16*)(F.ws + WS_WUP); bf16* WdnT = (bf16*)(F.ws + WS_WDN);
    if (r < I_IN) { const int kb = r / 97, nb = r % 97;
        transpose_item(INP(IN_WIN) + (size_t)L * DM * INC, INC, WinT + (size_t)L * INCP * DM, DM, kb * 64, nb * 64, nb * 64, nb < 96, scr, lane); return; }
    r -= I_IN;
    if (r < I_OUT) { const int kb = r / 32, nb = r % 32;
        transpose_item(INP(IN_WOUT) + (size_t)L * DM * DM, DM, WoutT + (size_t)L * DM * DM, DM, kb * 64, nb * 64, nb * 64, true, scr, lane); return; }
    r -= I_OUT;
    if (r < NEXP * I_UP) { const int le = L * NEXP + r / I_UP, q = r % I_UP, kb = q / 16, nb = q % 16;
        const int n0 = nb * 64, bj = n0 / 512, rem = n0 % 512, j = rem / 128, cc = rem % 128;
        transpose_item(INP(IN_WUP) + (size_t)le * DM * 1024, 1024, WupT + (size_t)le * 1024 * DM, DM, kb * 64, n0, j * 256 + bj * 128 + cc, true, scr, lane); return; }
    r -= NEXP * I_UP;
    { const int le = L * NEXP + r / I_DN, q = r % I_DN, kb = q / 32, nb = q % 32;
        transpose_item(INP(IN_WDN) + (size_t)le * DEXP * DM, DM, WdnT + (size_t)le * DM * DEXP, DEXP, kb * 64, nb * 64, nb * 64, true, scr, lane); }
}
__device__ __forceinline__ void conv_bubble(Fr F, int quota) {
    RELAUNDER(F);
    LAS float* scr = (LAS float*)(F.lds + F.wave * 16640);
    LAS unsigned* slot = (LAS unsigned*)(F.lds + LDSCTL_OFF + 64);
    unsigned* q = (unsigned*)(F.ctl + CW_Q);
    for (int n = 0; quota < 0 || n < quota; ++n) {
        __syncthreads();
        if (F.tid == 0) *slot = __hip_atomic_fetch_add(q, 32u, __ATOMIC_RELAXED, __HIP_MEMORY_SCOPE_AGENT);
        __syncthreads();
        const unsigned base = *slot;
        if (base >= (unsigned)CONV_PER_LAYER) break;
#pragma unroll 1
        for (int j = 0; j < 4; ++j) { const unsigned it = base + 8 * j + F.wave; if (it < (unsigned)CONV_PER_LAYER) conv_item(F, 1, (int)it, scr); }
    }
    __syncthreads();
}
#ifndef P0MASK
#define P0MASK 7
#endif
#ifndef REPMASK
#define REPMASK 0
#endif
__device__ __forceinline__ void p0_prologue(Fr F) {
    RELAUNDER(F);
    LAS float* scr = (LAS float*)(F.lds + F.wave * 16640);
    const int gw = F.bid * NWAVES + F.wave, NGW = F.G * NWAVES, lane = F.lane;
    bf16* WinT = (bf16*)(F.ws + WS_WIN);
    if (P0MASK & 1)
    for (int rep = 0; rep < 1 + ((REPMASK >> 11) & 1); ++rep)
    for (int it = gw; it < CONV_PER_LAYER; it += NGW) conv_item(F, 0, it, scr);
    for (int i = F.bid * NTHR + F.tid; i < NLAYER * (INCP - INC) * (DM * 2 / 16); i += F.G * NTHR) {
        const int L = i / ((INCP - INC) * 256), q = i % ((INCP - INC) * 256);
        ((v4u*)(WinT + (size_t)L * INCP * DM + (size_t)INC * DM))[q] = (v4u){0u, 0u, 0u, 0u}; }
    { bf16* WRH = (bf16*)(F.ws + WS_WRT); bf16* WRL = (bf16*)(F.ws + WS_WRT + 512 * 1024);
      for (int i = F.bid * NTHR + F.tid; i < NLAYER * 48 * DM; i += F.G * NTHR) { const int L = i / (48 * DM), q = i % (48 * DM), o = q / DM, k = q % DM;
          const float w = (o < 4) ? INP(IN_WRG)[(size_t)L * DM * 4 + k * 4 + o] : (o < 36) ? INP(IN_WRE)[(size_t)L * DM * 32 + k * 32 + (o - 4)] : 0.f;
          const unsigned hi = f2bf(w); WRH[i] = (bf16)hi; WRL[i] = (bf16)f2bf(w - __builtin_bit_cast(float, hi << 16)); } }
    __syncthreads();
    if (P0MASK & 2)
    { float* MOD = (float*)(F.ctl + CW_MOD); LAS float* sc = (LAS float*)F.lds;
      LAS f32x4* part = (LAS f32x4*)(F.lds + 65536);
      for (int i = F.tid; i < 5 * DM; i += NTHR) { const int r = i / DM, k = i % DM; sc[k * 8 + r] = silu_f((r < 4) ? INP(IN_C)[r * DM + k] : INP(IN_CCTX)[k]); }
      __syncthreads();
      for (int rep = 0; rep < 1 + ((REPMASK >> 12) & 1); ++rep)
      for (int it = F.bid; it < NLAYER * 128; it += F.G) {
          const int L = it >> 7, col = (it & 127) * 96 + (lane < 24 ? lane : 0) * 4;
          const float* wp = INP(IN_WADA) + (size_t)L * DM * 12288 + (size_t)(F.wave * 256) * 12288 + col;
          f32x4 acc[5];
#pragma unroll
          for (int r = 0; r < 5; ++r) acc[r] = (f32x4){0.f, 0.f, 0.f, 0.f};
          if (lane < 24) {
#pragma unroll 16
              for (int k = 0; k < 256; ++k) { const f32x4 w = *(const f32x4*)(wp + (size_t)k * 12288); const LAS float* sk = sc + (F.wave * 256 + k) * 8;
                  const f32x4 s03 = *(const LAS f32x4*)sk; const float s4 = sk[4];
                  acc[0] += w * s03[0]; acc[1] += w * s03[1]; acc[2] += w * s03[2]; acc[3] += w * s03[3]; acc[4] += w * s4; }
#pragma unroll
              for (int r = 0; r < 5; ++r) part[(F.wave * 5 + r) * 24 + lane] = acc[r]; }
          __syncthreads();
          for (int idx = F.tid; idx < 5 * 24; idx += NTHR) { const int r = idx / 24, ln = idx % 24; f32x4 sum = *(const f32x4*)(INP(IN_BADA) + L * 12288 + (it & 127) * 96 + ln * 4);
#pragma unroll
              for (int w = 0; w < 8; ++w) sum += part[(w * 5 + r) * 24 + ln];
              *(f32x4*)(MOD + (size_t)(L * 5 + r) * 12288 + (it & 127) * 96 + ln * 4) = sum; }
          __syncthreads();
      } }
    __syncthreads();
    if (P0MASK & 4)
    for (int rep = 0; rep < 1 + ((REPMASK >> 13) & 1); ++rep)
    for (int it = F.bid; it < 136; it += F.G) {
        if (it < 128) { const int L = it >> 6; hy_filter_item(F, L, SEQ, it & 63, (float*)(F.ws + WS_KF) + (size_t)L * HYC * 4096); }
        else hy_filter_item(F, 0, CTXL, it - 128, (float*)(F.ws + WS_KFC));
    }
}

__device__ __forceinline__ const float* mod_ptr(const Fr& F, int L, int row) {
    const int r = row < TLAT ? (row >> 11) : 4; return (const float*)(F.ctl + CW_MOD) + (size_t)(L * 5 + r) * 12288;
}
__device__ __forceinline__ f32x4 load_x4(const Fr& F, int L, int row, int idx4) {
    if (L == 0) return *((const f32x4*)(row < TLAT ? INP(IN_X) + (size_t)row * DM : INP(IN_CTX) + (size_t)(row - TLAT) * DM) + idx4);
    const v2u w = *((const v2u*)((const bf16*)(F.ws + WS_X2) + (size_t)row * DM) + idx4); return (f32x4){bflo(w.x), bfhi(w.x), bflo(w.y), bfhi(w.y)};
}
__device__ __forceinline__ void p1_ln_mod(Fr F, int L) {
    RELAUNDER(F);
    const int gw = F.bid * NWAVES + F.wave, NGW = F.G * NWAVES, lane = F.lane;
    bf16* H = (bf16*)(F.ws + WS_H);
    for (int row = gw; row < TTOT; row += NGW) {
        const float* mod = mod_ptr(F, L, row);
        f32x4 v[8]; float s = 0.f;
#pragma unroll
        for (int j = 0; j < 8; ++j) { v[j] = load_x4(F, L, row, lane + 64 * j); s += (v[j][0] + v[j][1]) + (v[j][2] + v[j][3]); }
        const float mean = wave_sum(s) * (1.f / DM); float s2 = 0.f;
#pragma unroll
        for (int j = 0; j < 8; ++j) { v[j] = v[j] - mean; s2 += (v[j][0] * v[j][0] + v[j][1] * v[j][1]) + (v[j][2] * v[j][2] + v[j][3] * v[j][3]); }
        const float rstd = 1.f / sqrtf(wave_sum(s2) * (1.f / DM) + LN_EPS);
        v2u* o8 = (v2u*)(H + (size_t)row * DM) + lane;
#pragma unroll
        for (int j = 0; j < 8; ++j) { const f32x4 sh = *((const f32x4*)(mod) + lane + 64 * j), sc = *((const f32x4*)(mod + DM) + lane + 64 * j);
            const f32x4 h = v[j] * rstd * (sc + 1.0f) + sh; v2u w; w.x = pk2(h[0], h[1]); w.y = pk2(h[2], h[3]); o8[64 * j] = w; }
    }
}

__device__ __forceinline__ void hy_pre_item(const Fr& F, int L, int item, LAS bf16* zt, LAS bf16* xt) {
    const int lane = F.lane; const bf16* PROJ = (const bf16*)(F.ws + WS_PROJ);
    int cb, n0, bt, lseq, tokbase; bf16 *ZT, *X0T;
    if (item < 1024) { cb = item & 7; const int tb = item >> 3; bt = tb >> 5; n0 = (tb & 31) * 64; lseq = SEQ; tokbase = bt * SEQ; ZT = (bf16*)(F.ws + WS_ZT); X0T = (bf16*)(F.ws + WS_X0T); }
    else { const int it = item - 1024; cb = it & 7; const int tb = it >> 3; bt = tb >> 2; n0 = (tb & 3) * 64; lseq = CTXL; tokbase = TLAT + bt * CTXL; ZT = (bf16*)(F.ws + WS_ZTC); X0T = (bf16*)(F.ws + WS_X0TC); }
    const int q = lane & 7, c0 = cb * 64 + 8 * q;
    float wgt[3][3][8], bias[3][8];
#pragma unroll
    for (int j = 0; j < 3; ++j) {
#pragma unroll
        for (int e = 0; e < 8; ++e) bias[j][e] = INP(IN_HYSB)[L * 1536 + j * 512 + c0 + e];
#pragma unroll
        for (int t = 0; t < 3; ++t)
#pragma unroll
            for (int e = 0; e < 8; ++e) wgt[j][t][e] = INP(IN_HYSW)[(L * 3 + t) * 1536 + j * 512 + c0 + e]; }
#pragma unroll 1
    for (int it = 0; it < 8; ++it) { const int tl = (lane >> 3) + 8 * it, n = n0 + tl; const bf16* rowp = PROJ + (size_t)(tokbase + n) * INCP + c0;
        float sj[3][8];
#pragma unroll
        for (int j = 0; j < 3; ++j) { const v4u z4 = (v4u){0u, 0u, 0u, 0u};
            const v4u rm = (n > 0) ? *(const v4u*)(rowp - INCP + j * 512) : z4, r0 = *(const v4u*)(rowp + j * 512), rp = (n < lseq - 1) ? *(const v4u*)(rowp + INCP + j * 512) : z4;
            const unsigned am[4] = {rm.x, rm.y, rm.z, rm.w}, a0[4] = {r0.x, r0.y, r0.z, r0.w}, ap[4] = {rp.x, rp.y, rp.z, rp.w};
#pragma unroll
            for (int e2 = 0; e2 < 4; ++e2) {
                sj[j][2 * e2] = wgt[j][0][2 * e2] * bflo(am[e2]) + wgt[j][1][2 * e2] * bflo(a0[e2]) + wgt[j][2][2 * e2] * bflo(ap[e2]) + bias[j][2 * e2];
                sj[j][2 * e2 + 1] = wgt[j][0][2 * e2 + 1] * bfhi(am[e2]) + wgt[j][1][2 * e2 + 1] * bfhi(a0[e2]) + wgt[j][2][2 * e2 + 1] * bfhi(ap[e2]) + bias[j][2 * e2 + 1]; } }
#pragma unroll
        for (int e = 0; e < 8; ++e) { zt[(8 * q + e) * 66 + tl] = (bf16)f2bf(sj[1][e] * sj[2][e]); xt[(8 * q + e) * 66 + tl] = (bf16)f2bf(sj[0][e]); } }
    LDS_WAIT(); asm volatile("" ::: "memory");
#pragma unroll 4
    for (int ch = 0; ch < 64; ++ch) { const size_t o = ((size_t)(cb * 64 + ch) * 4 + bt) * lseq + n0 + lane; ZT[o] = zt[ch * 66 + lane]; X0T[o] = xt[ch * 66 + lane]; }
    LDS_WAIT(); asm volatile("" ::: "memory");
}

template <int LSEQ>
__device__ __forceinline__ void hy_conv_item(const Fr& F, int c, const float* kfg, const bf16* ZT, const bf16* X0T, bf16* YT) {
    constexpr int CPLEN = 2 * LSEQ + 16, YOFF = LSEQ, ZOFF = 192, ZLEN = LSEQ + 416, NW = LSEQ / 256, NKS = (LSEQ + 192) / 32;
    LAS bf16* CP = (LAS bf16*)F.lds;
    LAS bf16* Z = CP + 8 * CPLEN;
    const int tid = F.tid;
#pragma unroll 8
    for (int idx = tid; idx < 8 * CPLEN; idx += NTHR) { const int sft = idx / CPLEN, y = idx - sft * CPLEN, k = 2 * LSEQ + sft - y;
        CP[idx] = (bf16)((k >= 1 && k <= 2 * LSEQ - 1) ? f2bf(kfg[k]) : 0u); }
#pragma unroll 3
    for (int idx = tid; idx < 4 * ZLEN / 8; idx += NTHR) { const int bt = idx / (ZLEN / 8), p8 = (idx - bt * (ZLEN / 8)) * 8, n = p8 - ZOFF;
        v4u v = (v4u){0u, 0u, 0u, 0u}; if (n >= 0 && n < LSEQ) v = *(const v4u*)(ZT + ((size_t)c * 4 + bt) * LSEQ + n);
        *(LAS v4u*)(Z + bt * ZLEN + p8) = v; }
    __syncthreads();
    if (F.wave < NW) {
        const int lane = F.lane, r16 = lane & 15, g = lane >> 4, a0 = 4 * F.wave, a = a0 + (r16 >> 2), bt = r16 & 3, jlo = -64 * (a0 + 3);
        const LAS bf16* ap = CP + (r16 & 7) * CPLEN + YOFF + jlo + 8 * g - 8 * (r16 >> 3);
        const LAS bf16* bp = Z + bt * ZLEN + ZOFF + 64 * a + jlo + 8 * g;
        f32x4 acc[4];
#pragma unroll
        for (int mb = 0; mb < 4; ++mb) acc[mb] = (f32x4){0.f, 0.f, 0.f, 0.f};
        bf16x8 T0 = *(const LAS bf16x8*)(ap), T1 = *(const LAS bf16x8*)(ap - 16), T2 = *(const LAS bf16x8*)(ap - 32), T3 = *(const LAS bf16x8*)(ap - 48);
#pragma unroll 2
        for (int ks = 0; ks < NKS; ++ks) {
            const bf16x8 B = *(const LAS bf16x8*)(bp + 32 * ks);
            acc[0] = __builtin_amdgcn_mfma_f32_16x16x32_bf16(T0, B, acc[0], 0, 0, 0); acc[1] = __builtin_amdgcn_mfma_f32_16x16x32_bf16(T1, B, acc[1], 0, 0, 0);
            acc[2] = __builtin_amdgcn_mfma_f32_16x16x32_bf16(T2, B, acc[2], 0, 0, 0); acc[3] = __builtin_amdgcn_mfma_f32_16x16x32_bf16(T3, B, acc[3], 0, 0, 0);
            T2 = T0; T3 = T1; T0 = *(const LAS bf16x8*)(ap + 32 * (ks + 1)); T1 = *(const LAS bf16x8*)(ap + 32 * (ks + 1) - 16);
        }
        const size_t rowo = ((size_t)c * 4 + bt) * LSEQ + 64 * a + 4 * g;
#pragma unroll
        for (int mb = 0; mb < 4; ++mb) { const v2u xw = *(const v2u*)(X0T + rowo + 16 * mb);
            v2u o; o.x = pk2(acc[mb][0] * bflo(xw.x), acc[mb][1] * bfhi(xw.x)); o.y = pk2(acc[mb][2] * bflo(xw.y), acc[mb][3] * bfhi(xw.y));
            *(v2u*)(YT + rowo + 16 * mb) = o; }
    }
    __syncthreads();
}

__device__ __forceinline__ void hy_post_item(const Fr& F, int L, int item) {
    const int lane = F.lane, w = F.wave;
    int bt, n0, lseq, tokbase; const bf16* YT;
    if (item < 128) { bt = item >> 5; n0 = (item & 31) * 64; lseq = SEQ; tokbase = bt * SEQ; YT = (const bf16*)(F.ws + WS_YT); }
    else { const int it = item - 128; bt = it >> 2; n0 = (it & 3) * 64; lseq = CTXL; tokbase = TLAT + bt * CTXL; YT = (const bf16*)(F.ws + WS_YTC); }
    LAS bf16* ys = (LAS bf16*)F.lds + w * (64 * 72);
    LAS float* part = (LAS float*)(F.lds + 8 * 64 * 72 * 2);
    float ss = 0.f;
#pragma unroll 4
    for (int ch = 0; ch < 64; ++ch) { const bf16 v = YT[((size_t)(64 * w + ch) * 4 + bt) * lseq + n0 + lane]; const float f = bf2f(v); ss += f * f; ys[lane * 72 + ch] = v; }
    part[w * 64 + lane] = ss;
    __syncthreads();
    bf16* MIX = (bf16*)(F.ws + WS_MIX); const float* nw = INP(IN_HYNW) + L * HYC + 64 * w + 8 * (lane & 7);
#pragma unroll 1
    for (int it = 0; it < 8; ++it) { const int tl = (lane >> 3) + 8 * it; float tot = 0.f;
#pragma unroll
        for (int ww = 0; ww < 8; ++ww) tot += part[ww * 64 + tl];
        const float rn = 1.0f / sqrtf(tot * (1.0f / 512.0f) + LN_EPS);
        const v4u v = *(const LAS v4u*)(ys + tl * 72 + 8 * (lane & 7));
        v4u o; o.x = pk2(bflo(v.x) * rn * nw[0], bfhi(v.x) * rn * nw[1]); o.y = pk2(bflo(v.y) * rn * nw[2], bfhi(v.y) * rn * nw[3]); o.z = pk2(bflo(v.z) * rn * nw[4], bfhi(v.z) * rn * nw[5]); o.w = pk2(bflo(v.w) * rn * nw[6], bfhi(v.w) * rn * nw[7]);
        *(v4u*)(MIX + (size_t)(tokbase + n0 + tl) * DM + 64 * w + 8 * (lane & 7)) = o; }
    __syncthreads();
}

__device__ __forceinline__ int gla_chunk_base(int b, int dir, int s, bool& is_ctx) {
    if (s < 4) { is_ctx = true; const int cc = dir ? 3 - s : s; return TLAT + b * CTXL + cc * 64; }
    is_ctx = false; const int lc = dir ? 35 - s : s - 4; return b * SEQ + lc * 64;
}
constexpr int GLP = 72;
template <bool WITH_Q>
__device__ __forceinline__ void gla_stage_raw(const Fr& F, int h, int base, LAS bf16* RK, LAS bf16* RQ, LAS bf16* RG, LAS bf16* VTs) {
    const bf16* PROJ = (const bf16*)(F.ws + WS_PROJ); const int tl = 8 * F.wave + (F.lane >> 3), c = F.lane & 7;
    const bf16* rp = PROJ + (size_t)(base + tl) * INCP;
    *(LAS v4u*)(RK + tl * GLP + 8 * c) = *(const v4u*)(rp + C_GK + h * 64 + 8 * c);
    if (WITH_Q) *(LAS v4u*)(RQ + tl * GLP + 8 * c) = *(const v4u*)(rp + C_GQ + h * 64 + 8 * c);
    if (c < 4) *(LAS v4u*)(RG + tl * 32 + 8 * c) = *(const v4u*)(rp + C_GA + 8 * c);
    const v4u a = *(const v4u*)(rp + C_GV + h * 128 + 8 * c), b = *(const v4u*)(rp + C_GV + h * 128 + 64 + 8 * c);
    const unsigned wa[4] = {a.x, a.y, a.z, a.w}, wb[4] = {b.x, b.y, b.z, b.w};
#pragma unroll
    for (int e = 0; e < 4; ++e) { VTs[(8 * c + 2 * e) * GLP + tl] = (bf16)(wa[e] & 0xffffu); VTs[(8 * c + 2 * e + 1) * GLP + tl] = (bf16)(wa[e] >> 16);
        VTs[(64 + 8 * c + 2 * e) * GLP + tl] = (bf16)(wb[e] & 0xffffu); VTs[(64 + 8 * c + 2 * e + 1) * GLP + tl] = (bf16)(wb[e] >> 16); }
}
__device__ __forceinline__ void gla_gate_scan(const Fr& F, int L, int h, int dir, const LAS bf16* RG, float (&cf)[8], float (&la)[8]) {
    const int lane = F.lane;
    const v4u g0 = *(const LAS v4u*)(RG + lane * 32 + dir * 16), g1 = *(const LAS v4u*)(RG + lane * 32 + dir * 16 + 8);
    const float ga[16] = {bflo(g0.x), bfhi(g0.x), bflo(g0.y), bfhi(g0.y), bflo(g0.z), bfhi(g0.z), bflo(g0.w), bfhi(g0.w), bflo(g1.x), bfhi(g1.x), bflo(g1.y), bfhi(g1.y), bflo(g1.z), bfhi(g1.z), bflo(g1.w), bfhi(g1.w)};
    const float* w2 = INP(IN_GAW2) + (size_t)(L * 2 + dir) * 16 * 384 + h * 64 + F.wave * 8; const float* gb = INP(IN_GAB) + (L * 2 + dir) * 384 + h * 64 + F.wave * 8;
#pragma unroll
    for (int e = 0; e < 8; ++e) { float z = gb[e];
#pragma unroll
        for (int r = 0; r < 16; ++r) z += ga[r] * w2[r * 384 + e];
        la[e] = logsigmoid_f(z) * (1.0f / 16.0f);
        float v = la[e];
#pragma unroll
        for (int off = 1; off < 64; off <<= 1) { const float u = __shfl_up(v, off); if (lane >= off) v += u; }
        cf[e] = v; }
}
__device__ __forceinline__ void gla_load_rope(const Fr& F, const LAS bf16* R, int tok, bool is_ctx, float (&x)[8]) {
    const int w = F.wave; const LAS bf16* p = R + F.lane * GLP + 8 * w; const v4u a = *(const LAS v4u*)p;
    const float own[8] = {bflo(a.x), bfhi(a.x), bflo(a.y), bfhi(a.y), bflo(a.z), bfhi(a.z), bflo(a.w), bfhi(a.w)};
    if (is_ctx) {
#pragma unroll
        for (int e = 0; e < 8; ++e) x[e] = own[e];
        return; }
    const bool first = (w & 3) < 2;
    const v4u bq = *(const LAS v4u*)(first ? p + 16 : p - 16);
    const float oth[8] = {bflo(bq.x), bfhi(bq.x), bflo(bq.y), bfhi(bq.y), bflo(bq.z), bfhi(bq.z), bflo(bq.w), bfhi(bq.w)};
    const int t = tok & (SEQ - 1); const float pos = (w >= 4) ? (float)(t & 63) : (float)(t >> 6);
#pragma unroll
    for (int e = 0; e < 8; ++e) { const int ai = (8 * w + e) & 15; const float ang = pos * __expf(-(float)ai * (9.210340371976184f / 16.0f)); const float sn = __sinf(ang), cs = __cosf(ang);
        x[e] = first ? own[e] * cs - oth[e] * sn : oth[e] * sn + own[e] * cs; }
}
__device__ __forceinline__ void gla_g1_item(const Fr& F, int L, int item) {
    const int ci = item % GSTEPS, bh = item / GSTEPS, h = bh % GH, b = bh / GH;
    const bool is_ctx = ci < 4; const int base = is_ctx ? TLAT + b * CTXL + ci * 64 : b * SEQ + (ci - 4) * 64;
    LAS bf16* VTs = (LAS bf16*)F.lds; LAS bf16* KT0 = VTs + 128 * GLP; LAS bf16* KT1 = KT0 + 64 * GLP; LAS float* Cs = (LAS float*)(KT1 + 64 * GLP); LAS bf16* RK = (LAS bf16*)(Cs + 128); LAS bf16* RG = RK + 64 * GLP;
    const int lane = F.lane, w = F.wave;
    gla_stage_raw<false>(F, h, base, RK, nullptr, RG, VTs);
    __syncthreads();
    float kx[8];
    gla_load_rope(F, RK, base + lane, is_ctx, kx);
#pragma unroll
    for (int dir = 0; dir < 2; ++dir) { float cf[8], la[8];
        gla_gate_scan(F, L, h, dir, RG, cf, la);
        { float* cfp = (float*)(F.ws + WS_CF) + ((size_t)(base + lane) * 2 + dir) * 384 + h * 64 + 8 * w;
          *(f32x4*)cfp = (f32x4){cf[0], cf[1], cf[2], cf[3]}; *(f32x4*)(cfp + 4) = (f32x4){cf[4], cf[5], cf[6], cf[7]}; }
        LAS bf16* KTs = dir ? KT1 : KT0;
#pragma unroll
        for (int e = 0; e < 8; ++e) { const float kt = kx[e] * __expf(dir ? (cf[e] - la[e]) : -cf[e]); KTs[(8 * w + e) * GLP + lane] = (bf16)f2bf(kt); if (lane == 63) Cs[dir * 64 + 8 * w + e] = cf[e]; } }
    __syncthreads();
    const int r16 = lane & 15, g = lane >> 4;
    bf16x8 va[2];
#pragma unroll
    for (int ks = 0; ks < 2; ++ks) va[ks] = *(const LAS bf16x8*)(VTs + (16 * w + r16) * GLP + 8 * g + 32 * ks);
#pragma unroll
    for (int dir = 0; dir < 2; ++dir) {
        const int step = is_ctx ? (dir ? 3 - ci : ci) : (dir ? 39 - ci : ci); const size_t slot = (size_t)((b * GH + h) * 2 + dir) * GSTEPS + step;
        if (F.tid < 64) ((float*)(F.ws + WS_DEC))[slot * 64 + F.tid] = __expf(Cs[dir * 64 + F.tid]);
        const LAS bf16* KTs = dir ? KT1 : KT0; bf16* U = (bf16*)(F.ws + WS_ST) + slot * 8192;
#pragma unroll
        for (int ib = 0; ib < 4; ++ib) { f32x4 acc = (f32x4){0.f, 0.f, 0.f, 0.f};
#pragma unroll
            for (int ks = 0; ks < 2; ++ks) acc = __builtin_amdgcn_mfma_f32_16x16x32_bf16(va[ks], *(const LAS bf16x8*)(KTs + (16 * ib + r16) * GLP + 8 * g + 32 * ks), acc, 0, 0, 0);
            const int i = 16 * ib + r16; const float sc = dir ? 1.0f : __expf(Cs[i]);
#pragma unroll
            for (int e = 0; e < 4; ++e) U[(16 * w + 4 * g + e) * 64 + i] = (bf16)f2bf(acc[e] * sc); } }
    __syncthreads();
}

__device__ __forceinline__ void vt_item(const Fr& F, int item, LAS unsigned* st) {
    const int lane = F.lane; const bf16* PROJ = (const bf16*)(F.ws + WS_PROJ);
    int b, h, tok0, t0; bf16 *VT, *KT;
    if (item < NB * NAH * 32) { const int tb = item & 31, bh = item >> 5; b = bh / NAH; h = bh % NAH; t0 = tb * 64; tok0 = b * SEQ + t0; VT = (bf16*)(F.ws + WS_VTL) + (size_t)bh * 128 * SEQ; KT = (bf16*)(F.ws + WS_KTL) + (size_t)bh * 128 * SEQ; }
    else { const int it = item - NB * NAH * 32, tb = it & 3, bh = it >> 2; b = bh / NAH; h = bh % NAH; t0 = tb * 64; tok0 = TLAT + b * CTXL + t0; VT = (bf16*)(F.ws + WS_VTC) + (size_t)bh * 128 * CTXL; KT = (bf16*)(F.ws + WS_KTC) + (size_t)bh * 128 * CTXL; }
#pragma unroll 4
    for (int idx = lane; idx < 64 * 16; idx += 64) { const int tok = idx >> 4, ch = idx & 15; const bf16* rp = PROJ + (size_t)(tok0 + tok) * INCP + h * 128 + ch * 8;
        const v4u w = *(const v4u*)(rp + C_NV), kq = *(const v4u*)(rp + C_NK);
        LAS unsigned* p = st + tok * 65 + ch * 4; p[0] = w.x; p[1] = w.y; p[2] = w.z; p[3] = w.w;
        *(v4u*)(KT + (size_t)((t0 + tok) >> 3) * 1024 + (ch >> 2) * 256 + (tok & 7) * 32 + ((ch & 3) ^ (2 * (((t0 + tok) >> 3) & 1))) * 8) = kq; }
    LDS_WAIT(); asm volatile("" ::: "memory");
    bf16* vo = VT + (size_t)((t0 + lane) >> 3) * 1024 + (lane & 7);
#pragma unroll 4
    for (int d2 = 0; d2 < 64; ++d2) { const unsigned w = st[lane * 65 + d2]; vo[(2 * d2) * 8] = (bf16)(w & 0xffffu); vo[(2 * d2 + 1) * 8] = (bf16)(w >> 16); }
    LDS_WAIT(); asm volatile("" ::: "memory");
}
template <bool LAT>
__device__ __forceinline__ void na_mfma_item(const Fr& F, int L, int tile, int h, const LAS float* rpb) {
    const int lane = F.lane, qi = lane & 15, g = lane >> 4;
    const bf16* PROJ = (const bf16*)(F.ws + WS_PROJ);
    int b, r = 0, j = 0, qbase;
    if (LAT) { b = tile >> 7; const int rem = tile & 127; r = rem >> 2; j = rem & 3; qbase = b * SEQ + r * 64 + j * 16; }
    else { b = tile >> 4; qbase = TLAT + b * CTXL + (tile & 15) * 16; }
    const int r0 = min(max(r - 4, 0), 24), cs = min(max(16 * j - 8, 0), 32), c = 16 * j + qi, c0 = min(max(c - 8, 0), 48);
    const int ctx0 = TLAT + b * CTXL;
    bf16x8 bq[4];
    { const bf16* qp = PROJ + (size_t)(qbase + qi) * INCP + C_NQ + h * 128 + g * 8;
#pragma unroll
      for (int ks = 0; ks < 4; ++ks) bq[ks] = *(const bf16x8*)(qp + ks * 32); }
    constexpr int NKB = LAT ? 32 : 16, NLOC = LAT ? 16 : 0;
    f32x4 S[NKB];
    const bf16* ktl = (const bf16*)(F.ws + WS_KTL) + (size_t)(b * NAH + h) * 128 * SEQ + (qi >> 2) * 1024 + (qi & 3) * 32 + (g ^ (2 * (((cs >> 3) + (qi >> 2)) & 1))) * 8;
    const bf16* ktc = (const bf16*)(F.ws + WS_KTC) + (size_t)(b * NAH + h) * 128 * CTXL + (qi >> 2) * 1024 + (qi & 3) * 32 + (g ^ (2 * ((qi >> 2) & 1))) * 8;
#define NA_KP(kb) (((kb) < NLOC) ? ktl + (((r0 + ((kb) >> 1)) * 64 + cs) >> 3) * 1024 + ((kb) & 1) * 128 : ktc + (((kb) - NLOC) >> 1) * 4096 + ((kb) & 1) * 128)
#define NA_LOADK(dst, kb) do { const bf16* kp_ = NA_KP(kb); _Pragma("unroll") for (int ks = 0; ks < 4; ++ks) dst[ks] = *(const bf16x8*)(kp_ + ks * 256); } while (0)
    bf16x8 k0[4], k1[4], k2[4], k3[4], k4[4];
#define NA_QK(ka, kb_) do { f32x4 acc0 = (f32x4){0.f, 0.f, 0.f, 0.f}; \
        _Pragma("unroll") for (int ks = 0; ks < 4; ++ks) acc0 = __builtin_amdgcn_mfma_f32_16x16x32_bf16(ka[ks], bq[ks], acc0, 0, 0, 0); \
        S[kb_] = acc0; } while (0)
    NA_LOADK(k0, 0); NA_LOADK(k1, 1); NA_LOADK(k2, 2); NA_LOADK(k3, 3);
    if (0 < NKB) { if (0 + 4 < NKB) NA_LOADK(k4, 0 + 4); __builtin_amdgcn_sched_barrier(0); NA_QK(k0, 0); __builtin_amdgcn_sched_barrier(0); }
    if (1 < NKB) { if (1 + 4 < NKB) NA_LOADK(k0, 1 + 4); __builtin_amdgcn_sched_barrier(0); NA_QK(k1, 1); __builtin_amdgcn_sched_barrier(0); }
    if (2 < NKB) { if (2 + 4 < NKB) NA_LOADK(k1, 2 + 4); __builtin_amdgcn_sched_barrier(0); NA_QK(k2, 2); __builtin_amdgcn_sched_barrier(0); }
    if (3 < NKB) { if (3 + 4 < NKB) NA_LOADK(k2, 3 + 4); __builtin_amdgcn_sched_barrier(0); NA_QK(k3, 3); __builtin_amdgcn_sched_barrier(0); }
    if (4 < NKB) { if (4 + 4 < NKB) NA_LOADK(k3, 4 + 4); __builtin_amdgcn_sched_barrier(0); NA_QK(k4, 4); __builtin_amdgcn_sched_barrier(0); }
    if (5 < NKB) { if (5 + 4 < NKB) NA_LOADK(k4, 5 + 4); __builtin_amdgcn_sched_barrier(0); NA_QK(k0, 5); __builtin_amdgcn_sched_barrier(0); }
    if (6 < NKB) { if (6 + 4 < NKB) NA_LOADK(k0, 6 + 4); __builtin_amdgcn_sched_barrier(0); NA_QK(k1, 6); __builtin_amdgcn_sched_barrier(0); }
    if (7 < NKB) { if (7 + 4 < NKB) NA_LOADK(k1, 7 + 4); __builtin_amdgcn_sched_barrier(0); NA_QK(k2, 7); __builtin_amdgcn_sched_barrier(0); }
    if (8 < NKB) { if (8 + 4 < NKB) NA_LOADK(k2, 8 + 4); __builtin_amdgcn_sched_barrier(0); NA_QK(k3, 8); __builtin_amdgcn_sched_barrier(0); }
    if (9 < NKB) { if (9 + 4 < NKB) NA_LOADK(k3, 9 + 4); __builtin_amdgcn_sched_barrier(0); NA_QK(k4, 9); __builtin_amdgcn_sched_barrier(0); }
    if (10 < NKB) { if (10 + 4 < NKB) NA_LOADK(k4, 10 + 4); __builtin_amdgcn_sched_barrier(0); NA_QK(k0, 10); __builtin_amdgcn_sched_barrier(0); }
    if (11 < NKB) { if (11 + 4 < NKB) NA_LOADK(k0, 11 + 4); __builtin_amdgcn_sched_barrier(0); NA_QK(k1, 11); __builtin_amdgcn_sched_barrier(0); }
    if (12 < NKB) { if (12 + 4 < NKB) NA_LOADK(k1, 12 + 4); __builtin_amdgcn_sched_barrier(0); NA_QK(k2, 12); __builtin_amdgcn_sched_barrier(0); }
    if (13 < NKB) { if (13 + 4 < NKB) NA_LOADK(k2, 13 + 4); __builtin_amdgcn_sched_barrier(0); NA_QK(k3, 13); __builtin_amdgcn_sched_barrier(0); }
    if (14 < NKB) { if (14 + 4 < NKB) NA_LOADK(k3, 14 + 4); __builtin_amdgcn_sched_barrier(0); NA_QK(k4, 14); __builtin_amdgcn_sched_barrier(0); }
    if (15 < NKB) { if (15 + 4 < NKB) NA_LOADK(k4, 15 + 4); __builtin_amdgcn_sched_barrier(0); NA_QK(k0, 15); __builtin_amdgcn_sched_barrier(0); }
    if (16 < NKB) { if (16 + 4 < NKB) NA_LOADK(k0, 16 + 4); __builtin_amdgcn_sched_barrier(0); NA_QK(k1, 16); __builtin_amdgcn_sched_barrier(0); }
    if (17 < NKB) { if (17 + 4 < NKB) NA_LOADK(k1, 17 + 4); __builtin_amdgcn_sched_barrier(0); NA_QK(k2, 17); __builtin_amdgcn_sched_barrier(0); }
    if (18 < NKB) { if (18 + 4 < NKB) NA_LOADK(k2, 18 + 4); __builtin_amdgcn_sched_barrier(0); NA_QK(k3, 18); __builtin_amdgcn_sched_barrier(0); }
    if (19 < NKB) { if (19 + 4 < NKB) NA_LOADK(k3, 19 + 4); __builtin_amdgcn_sched_barrier(0); NA_QK(k4, 19); __builtin_amdgcn_sched_barrier(0); }
    if (20 < NKB) { if (20 + 4 < NKB) NA_LOADK(k4, 20 + 4); __builtin_amdgcn_sched_barrier(0); NA_QK(k0, 20); __builtin_amdgcn_sched_barrier(0); }
    if (21 < NKB) { if (21 + 4 < NKB) NA_LOADK(k0, 21 + 4); __builtin_amdgcn_sched_barrier(0); NA_QK(k1, 21); __builtin_amdgcn_sched_barrier(0); }
    if (22 < NKB) { if (22 + 4 < NKB) NA_LOADK(k1, 22 + 4); __builtin_amdgcn_sched_barrier(0); NA_QK(k2, 22); __builtin_amdgcn_sched_barrier(0); }
    if (23 < NKB) { if (23 + 4 < NKB) NA_LOADK(k2, 23 + 4); __builtin_amdgcn_sched_barrier(0); NA_QK(k3, 23); __builtin_amdgcn_sched_barrier(0); }
    if (24 < NKB) { if (24 + 4 < NKB) NA_LOADK(k3, 24 + 4); __builtin_amdgcn_sched_barrier(0); NA_QK(k4, 24); __builtin_amdgcn_sched_barrier(0); }
    if (25 < NKB) { if (25 + 4 < NKB) NA_LOADK(k4, 25 + 4); __builtin_amdgcn_sched_barrier(0); NA_QK(k0, 25); __builtin_amdgcn_sched_barrier(0); }
    if (26 < NKB) { if (26 + 4 < NKB) NA_LOADK(k0, 26 + 4); __builtin_amdgcn_sched_barrier(0); NA_QK(k1, 26); __builtin_amdgcn_sched_barrier(0); }
    if (27 < NKB) { if (27 + 4 < NKB) NA_LOADK(k1, 27 + 4); __builtin_amdgcn_sched_barrier(0); NA_QK(k2, 27); __builtin_amdgcn_sched_barrier(0); }
    if (28 < NKB) { if (28 + 4 < NKB) NA_LOADK(k2, 28 + 4); __builtin_amdgcn_sched_barrier(0); NA_QK(k3, 28); __builtin_amdgcn_sched_barrier(0); }
    if (29 < NKB) { if (29 + 4 < NKB) NA_LOADK(k3, 29 + 4); __builtin_amdgcn_sched_barrier(0); NA_QK(k4, 29); __builtin_amdgcn_sched_barrier(0); }
    if (30 < NKB) { if (30 + 4 < NKB) NA_LOADK(k4, 30 + 4); __builtin_amdgcn_sched_barrier(0); NA_QK(k0, 30); __builtin_amdgcn_sched_barrier(0); }
    if (31 < NKB) { if (31 + 4 < NKB) NA_LOADK(k0, 31 + 4); __builtin_amdgcn_sched_barrier(0); NA_QK(k1, 31); __builtin_amdgcn_sched_barrier(0); }
#undef NA_QK
#undef NA_LOADK
#undef NA_KP
    float mx = -3.0e38f;
#pragma unroll
    for (int kb = 0; kb < NKB; ++kb)
#pragma unroll
        for (int i = 0; i < 4; ++i) { float sv = S[kb][i] * 0.08838834764831845f;
            if (kb < NLOC) { const int kc = cs + (kb & 1) * 4 + 8 * g + i; const bool ok = (kc >= c0) && (kc < c0 + 16); const int rel = min(max(kc - c + 15, 0), 30);
                const float bias = rpb[h * 465 + (r0 + (kb >> 1) - r + 7) * 31 + rel]; sv = ok ? sv + bias * 0.6931471805599453f : -3.0e38f;     }
            S[kb][i] = sv; mx = fmaxf(mx, sv); }
    mx = fmaxf(mx, __shfl_xor(mx, 16)); mx = fmaxf(mx, __shfl_xor(mx, 32));
    float sum = 0.f;
#pragma unroll
    for (int kb = 0; kb < NKB; ++kb)
#pragma unroll
        for (int i = 0; i < 4; ++i) { const float p = __expf(S[kb][i] - mx); S[kb][i] = p; sum += p; }
    sum += __shfl_xor(sum, 16); sum += __shfl_xor(sum, 32);
    const float inv = 1.0f / sum;
    f32x4 O[8];
#pragma unroll
    for (int db = 0; db < 8; ++db) O[db] = (f32x4){0.f, 0.f, 0.f, 0.f};
    const bf16* VTL = (const bf16*)(F.ws + WS_VTL) + (size_t)(b * NAH + h) * 128 * SEQ + g * 1024 + qi * 8;
    const bf16* VTC = (const bf16*)(F.ws + WS_VTC) + (size_t)(b * NAH + h) * 128 * CTXL + g * 1024 + qi * 8;
#define NA_VB(s2) (((s2) < NLOC / 2) ? VTL + (((r0 + (s2)) * 64 + cs) >> 3) * 1024 : VTC + ((s2) - NLOC / 2) * 4096)
#define NA_LOADV(dst, s2) do { const bf16* vb_ = NA_VB(s2); _Pragma("unroll") for (int db = 0; db < 8; ++db) dst[db] = *(const v4u*)(vb_ + db * 128); } while (0)
#define NA_PV(src, s2) do { const bf16x8 pf = __builtin_bit_cast(bf16x8, P[s2]); _Pragma("unroll") for (int db = 0; db < 8; ++db) O[db] = __builtin_amdgcn_mfma_f32_16x16x32_bf16(__builtin_bit_cast(bf16x8, src[db]), pf, O[db], 0, 0, 0); } while (0)
    v4u P[NKB / 2];
#pragma unroll
    for (int s2 = 0; s2 < NKB / 2; ++s2) { P[s2].x = pk2(S[2 * s2][0], S[2 * s2][1]); P[s2].y = pk2(S[2 * s2][2], S[2 * s2][3]); P[s2].z = pk2(S[2 * s2 + 1][0], S[2 * s2 + 1][1]); P[s2].w = pk2(S[2 * s2 + 1][2], S[2 * s2 + 1][3]); }
#pragma unroll
    for (int s2 = 0; s2 < NKB / 2; ++s2) asm volatile("" : "+v"(P[s2]));
    v4u va[8], vb[8];
    NA_LOADV(va, 0);
#pragma unroll
    for (int s2 = 0; s2 < NKB / 2; s2 += 2) {
        NA_LOADV(vb, s2 + 1);
        __builtin_amdgcn_sched_barrier(0);
        NA_PV(va, s2);
        __builtin_amdgcn_sched_barrier(0);
        if (s2 + 2 < NKB / 2) NA_LOADV(va, s2 + 2);
        __builtin_amdgcn_sched_barrier(0);
        NA_PV(vb, s2 + 1);
        __builtin_amdgcn_sched_barrier(0);
    }
#undef NA_VB
#undef NA_LOADV
#undef NA_PV
    bf16* op = (bf16*)(F.ws + WS_MIX) + (size_t)(qbase + qi) * DM + M_NA + h * 128 + 4 * g;
#pragma unroll
    for (int db = 0; db < 8; ++db) { v2u w; w.x = pk2(O[db][0] * inv, O[db][1] * inv); w.y = pk2(O[db][2] * inv, O[db][3] * inv); *(v2u*)(op + db * 16) = w; }
}

__device__ __forceinline__ void p3_mixers1(Fr F, int L) {
    RELAUNDER(F);
#ifndef REPMASK
#define REPMASK 0
#endif
    for (int rep = 0; rep < 1 + ((REPMASK >> 1) & 1); ++rep)
    for (int it = F.bid; it < NB * GH * GSTEPS; it += F.G) gla_g1_item(F, L, it);
    __syncthreads();
    const int gw = F.bid * NWAVES + F.wave, NGW = F.G * NWAVES;
    { LAS unsigned* st = (LAS unsigned*)(F.lds + F.wave * 16640);
      for (int rep = 0; rep < 1 + ((REPMASK >> 4) & 1); ++rep)
      for (int it = gw; it < NB * NAH * 36; it += NGW) vt_item(F, it, st); }
    __syncthreads();
    { LAS bf16* zt = (LAS bf16*)(F.lds + F.wave * 16896); LAS bf16* xt = zt + 64 * 66;
      const int n_pre = 1024 + ((L == 0) ? 128 : 0);
      for (int rep = 0; rep < 1 + ((REPMASK >> 4) & 1); ++rep)
      for (int it = NGW - 1 - gw; it < n_pre; it += NGW) hy_pre_item(F, L, it, zt, xt); }
}

constexpr int NBU_STATS = 11264, NBU_BUF0 = 12288, NBU_BUFSZ = 49152, NBU_XCH = 110592, NBU_UNITS = NB * NAH * 32;
__device__ __forceinline__ void na_block_units(const Fr& F, int L, const LAS float* rpb) {
    const int lane = F.lane, qi = lane & 15, g = lane >> 4, tid = F.tid, j = F.wave & 3, part = F.wave >> 2;
    LAS unsigned char* lb = F.lds;
    LAS float* stats = (LAS float*)(lb + NBU_STATS);
    const bf16* PROJ = (const bf16*)(F.ws + WS_PROJ);
    const int cs = min(max(16 * j - 8, 0), 32), c = 16 * j + qi, c0 = min(max(c - 8, 0), 48);
    int rel8[8]; bool ok8[8];
#pragma unroll
    for (int e = 0; e < 8; ++e) { const int kc = cs + (e >> 2) * 4 + 8 * g + (e & 3); ok8[e] = (kc >= c0) && (kc < c0 + 16); rel8[e] = min(max(kc - c + 15, 0), 30); }
    v4u st0[6], st1[6];
#define NB_LOAD(st, unit_, s_) do { const int bh_ = (unit_) >> 5, r_ = (unit_) & 31, r0_ = min(max(r_ - 4, 0), 24), sk_ = (s_) & 3; \
        const bf16* sl_ = (const bf16*)(F.ws + (((s_) < 4) ? WS_KTL : WS_VTL)) + (size_t)bh_ * 128 * SEQ + (size_t)(r0_ + 2 * sk_) * 8192; \
        const bf16* sc_ = (const bf16*)(F.ws + (((s_) < 4) ? WS_KTC : WS_VTC)) + (size_t)bh_ * 128 * CTXL + sk_ * 8192; \
        _Pragma("unroll") for (int k = 0; k < 4; ++k) st[k] = *(const v4u*)(sl_ + (tid + 512 * k) * 8); \
        _Pragma("unroll") for (int k = 0; k < 2; ++k) st[4 + k] = *(const v4u*)(sc_ + (tid + 512 * k) * 8); } while (0)
#define NB_STORE(st, buf_) do { LAS v4u* d_ = (LAS v4u*)(lb + NBU_BUF0 + (buf_) * NBU_BUFSZ); _Pragma("unroll") for (int k = 0; k < 6; ++k) d_[tid + 512 * k] = st[k]; } while (0)
    const bool xmap = (F.G == 256);
    const int ustep = xmap ? 32 : F.G;
    int unit = xmap ? ((3 * (F.bid & 7)) << 5) + (F.bid >> 3) : F.bid;
    const int uend = xmap ? unit + 96 : NBU_UNITS;
    if (unit < uend) { NB_LOAD(st0, unit, 0); NB_LOAD(st1, unit, 1); NB_STORE(st0, 0); }
    __syncthreads();
    const int koff = (part ? 16384 : (cs >> 3) * 1024) + (qi >> 2) * 1024 + (qi & 3) * 32 + (g ^ (2 * (((part ? 0 : (cs >> 3)) + (qi >> 2)) & 1))) * 8;
    const int kstep1 = 128, kstep2 = part ? 4096 : 8192;
    const int voff = (part ? 16384 : (cs >> 3) * 1024) + g * 1024 + qi * 8;
    const int vstep = part ? 4096 : 8192;
    for (; unit < uend; unit += ustep) {
        const int bh = unit >> 5, r = unit & 31, b = bh / NAH, h = bh - b * NAH, r0 = min(max(r - 4, 0), 24);
        const int qbase = b * SEQ + r * 64 + j * 16;
        bf16x8 bq[4];
        { const bf16* qp = PROJ + (size_t)(qbase + qi) * INCP + C_NQ + h * 128 + g * 8;
#pragma unroll
          for (int ks = 0; ks < 4; ++ks) bq[ks] = *(const bf16x8*)(qp + ks * 32); }
        f32x4 S[16];
        const int nxt = unit + ustep;
#pragma unroll
        for (int s = 0; s < 4; ++s) {
            if (s & 1) NB_LOAD(st1, unit, s + 2); else NB_LOAD(st0, unit, s + 2);
            __builtin_amdgcn_sched_barrier(0);
            const LAS bf16* kb_ = (const LAS bf16*)(lb + NBU_BUF0 + (s & 1) * NBU_BUFSZ) + koff;
            for (int rq = 0; rq < 1 + ((REPMASK >> 22) & 1); ++rq) { asm volatile("" ::: "memory");
#pragma unroll
            for (int t4 = 0; t4 < 4; ++t4) { const LAS bf16* kp = kb_ + (t4 & 1) * kstep1 + (t4 >> 1) * kstep2;
                f32x4 acc0 = (f32x4){0.f, 0.f, 0.f, 0.f};
#pragma unroll
                for (int ks = 0; ks < 4; ++ks) acc0 = __builtin_amdgcn_mfma_f32_16x16x32_bf16(*(const LAS bf16x8*)(kp + ks * 256), bq[ks], acc0, 0, 0, 0);
                S[4 * s + t4] = acc0; }
            }
            __builtin_amdgcn_sched_barrier(0);
            for (int rq = 0; rq < 1 + ((REPMASK >> 23) & 1); ++rq) { asm volatile("" ::: "memory");
            if (s & 1) NB_STORE(st0, 0); else NB_STORE(st1, 1); }
            if (s == 3) {
                float mx = -3.0e38f;
                if (!part) {
                    const LAS float* rb = rpb + h * 465 + (r0 - r + 7) * 31;
#pragma unroll
                    for (int kb = 0; kb < 16; ++kb)
#pragma unroll
                        for (int i = 0; i < 4; ++i) { const int e = (kb & 1) * 4 + i;
                            const float t = fmaf(S[kb][i], 0.08838834764831845f * 1.4426950408889634f, rb[(kb >> 1) * 31 + rel8[e]]);
                            const float sv = ok8[e] ? t : -3.0e38f; S[kb][i] = sv; mx = fmaxf(mx, sv); }
                } else {
#pragma unroll
                    for (int kb = 0; kb < 16; ++kb)
#pragma unroll
                        for (int i = 0; i < 4; ++i) { const float sv = S[kb][i] * (0.08838834764831845f * 1.4426950408889634f); S[kb][i] = sv; mx = fmaxf(mx, sv); }
                }
                mx = fmaxf(mx, __shfl_xor(mx, 16)); mx = fmaxf(mx, __shfl_xor(mx, 32));
                if (g == 0) stats[F.wave * 16 + qi] = mx;
            }
            __syncthreads();
        }
        const float mxa = fmaxf(stats[j * 16 + qi], stats[(4 + j) * 16 + qi]);
        float sum = 0.f;
#pragma unroll
        for (int kb = 0; kb < 16; ++kb)
#pragma unroll
            for (int i = 0; i < 4; ++i) { const float p = __builtin_amdgcn_exp2f(S[kb][i] - mxa); S[kb][i] = p; sum += p; }
        sum += __shfl_xor(sum, 16); sum += __shfl_xor(sum, 32);
        v4u P[8];
#pragma unroll
        for (int s2 = 0; s2 < 8; ++s2) { P[s2].x = pk2(S[2 * s2][0], S[2 * s2][1]); P[s2].y = pk2(S[2 * s2][2], S[2 * s2][3]); P[s2].z = pk2(S[2 * s2 + 1][0], S[2 * s2 + 1][1]); P[s2].w = pk2(S[2 * s2 + 1][2], S[2 * s2 + 1][3]); }
        f32x4 O[8];
#pragma unroll
        for (int db = 0; db < 8; ++db) O[db] = (f32x4){0.f, 0.f, 0.f, 0.f};
#pragma unroll
        for (int s = 4; s < 8; ++s) {
            if (s < 6) { if (s & 1) NB_LOAD(st1, unit, s + 2); else NB_LOAD(st0, unit, s + 2); }
            else if (nxt < uend) { if (s & 1) NB_LOAD(st1, nxt, 1); else NB_LOAD(st0, nxt, 0); }
            __builtin_amdgcn_sched_barrier(0);
            const LAS bf16* vb_ = (const LAS bf16*)(lb + NBU_BUF0 + (s & 1) * NBU_BUFSZ) + voff;
            bf16x8 vf[2][8];
#pragma unroll
            for (int t2 = 0; t2 < 2; ++t2)
#pragma unroll
                for (int db = 0; db < 8; ++db) vf[t2][db] = *(const LAS bf16x8*)(vb_ + t2 * vstep + db * 128);
            __builtin_amdgcn_sched_barrier(0);
#pragma unroll
            for (int t2 = 0; t2 < 2; ++t2) { const bf16x8 pf = __builtin_bit_cast(bf16x8, P[2 * (s - 4) + t2]);
#pragma unroll
                for (int db = 0; db < 8; ++db) O[db] = __builtin_amdgcn_mfma_f32_16x16x32_bf16(vf[t2][db], pf, O[db], 0, 0, 0); }
            __builtin_amdgcn_sched_barrier(0);
            if (s < 7 || nxt < uend) { if (s & 1) NB_STORE(st0, 0); else NB_STORE(st1, 1); }
            if (s == 7 && part) {
                LAS f32x4* xo = (LAS f32x4*)(lb + NBU_XCH) + j * 512 + lane;
#pragma unroll
                for (int db = 0; db < 8; ++db) xo[db * 64] = O[db];
                if (g == 0) stats[128 + j * 16 + qi] = sum;
            }
            __syncthreads();
        }
        if (!part) {
            const LAS f32x4* xo = (const LAS f32x4*)(lb + NBU_XCH) + j * 512 + lane;
            const float inv = 1.0f / (sum + stats[128 + j * 16 + qi]);
            bf16* op = (bf16*)(F.ws + WS_MIX) + (size_t)(qbase + qi) * DM + M_NA + h * 128 + 4 * g;
#pragma unroll
            for (int db = 0; db < 8; ++db) { const f32x4 o = O[db] + xo[db * 64]; v2u w; w.x = pk2(o[0] * inv, o[1] * inv); w.y = pk2(o[2] * inv, o[3] * inv); *(v2u*)(op + db * 16) = w; }
        }
    }
#undef NB_LOAD
#undef NB_STORE
}

__device__ __forceinline__ void p4_gla_scan(Fr F, int L, const XcdBarrier& bar) {
    RELAUNDER(F);
    for (int rep = 0; rep < 1 + ((REPMASK >> 10) & 1); ++rep)
    for (int it = F.bid; it < HYC + ((L == 0) ? HYC : 0); it += F.G) {
        if (it < HYC) hy_conv_item<SEQ>(F, it, (const float*)(F.ws + WS_KF) + ((size_t)L * HYC + it) * 4096, (const bf16*)(F.ws + WS_ZT), (const bf16*)(F.ws + WS_X0T), (bf16*)(F.ws + WS_YT));
        else hy_conv_item<CTXL>(F, it - HYC, (const float*)(F.ws + WS_KFC) + (size_t)(it - HYC) * 512, (const bf16*)(F.ws + WS_ZTC), (const bf16*)(F.ws + WS_X0TC), (bf16*)(F.ws + WS_YTC));
    }
    unsigned* ST = (unsigned*)(F.ws + WS_ST); const float* DEC = (const float*)(F.ws + WS_DEC);
    for (int rep = 0; rep < 1 + ((REPMASK >> 7) & 1); ++rep) {
    if (rep > 0) { __syncthreads(); for (int it = F.bid; it < NB * GH * GSTEPS; it += F.G) gla_g1_item(F, L, it); xcd_barrier(bar); }
    for (int e = F.bid * NTHR + F.tid; e < NB * GH * 2 * 4096; e += F.G * NTHR) {
        const int chain = e >> 12, el2 = e & 4095, i = (el2 & 31) * 2; float S0 = 0.f, S1 = 0.f;
        unsigned* p = ST + (size_t)chain * GSTEPS * 4096 + el2; const float* d = DEC + (size_t)chain * GSTEPS * 64 + i;
#pragma unroll 6
        for (int s = 0; s < GSTEPS; ++s) { const unsigned u = p[(size_t)s * 4096]; p[(size_t)s * 4096] = pk2(S0, S1); S0 = d[s * 64] * S0 + bflo(u); S1 = d[s * 64 + 1] * S1 + bfhi(u); }
    }
    if (((REPMASK >> 7) & 1) && rep == 0) xcd_barrier(bar);
    }
    LAS float* rpb = (LAS float*)F.lds;
    for (int i = F.tid; i < NAH * 465; i += NTHR) rpb[i] = INP(IN_RPB)[L * NAH * 465 + i] * 1.4426950408889634f;
    __syncthreads();
    const int gw = F.bid * NWAVES + F.wave, NGW = F.G * NWAVES;
    for (int rep = 0; rep < 1 + (REPMASK & 1); ++rep) {
    if (rep > 0) __syncthreads();
    for (int rep2 = 0; rep2 < 1 + ((REPMASK >> 20) & 1); ++rep2) { if (rep2 > 0) __syncthreads(); na_block_units(F, L, rpb); }
    for (int rep2 = 0; rep2 < 1 + ((REPMASK >> 21) & 1); ++rep2)
    if (L == 0) for (int q = gw; q < 64 * NAH; q += NGW) { const int h = q / 64, tile = q % 64; na_mfma_item<false>(F, L, tile, h, rpb); }
    }
}

__device__ __forceinline__ void gla_g3_item(const Fr& F, int L, int b, int h, int ci) {
    LAS bf16* VTs = (LAS bf16*)F.lds; LAS bf16* Qs = VTs + 128 * GLP; LAS bf16* Ks = Qs + 64 * GLP; LAS float* Cs = (LAS float*)(Ks + 64 * GLP); LAS float* red = Cs + 64;
    LAS bf16* RK = (LAS bf16*)(red + 128); LAS bf16* RQ = RK + 64 * GLP; LAS bf16* RG = RQ + 64 * GLP;
    LAS bf16* Qs1 = RG + 64 * 32; LAS bf16* Ks1 = Qs1 + 64 * GLP; LAS float* Cs1 = (LAS float*)(Ks1 + 64 * GLP);
    LAS bf16* const Qs0 = Qs; LAS bf16* const Ks0 = Ks; LAS float* const Cs0 = Cs;
    const int lane = F.lane, w = F.wave, r16 = lane & 15, g = lane >> 4, tb = w & 3, jh = w >> 2;
    const bool is_ctx = ci < 4; const int base = is_ctx ? TLAT + b * CTXL + ci * 64 : b * SEQ + (ci - 4) * 64;
    gla_stage_raw<true>(F, h, base, RK, RQ, RG, VTs);
    __syncthreads();
    float qx[8], kx[8];
    gla_load_rope(F, RQ, base + lane, is_ctx, qx); gla_load_rope(F, RK, base + lane, is_ctx, kx);
    f32x4 O[4];
#pragma unroll
    for (int jb = 0; jb < 4; ++jb) O[jb] = (f32x4){0.f, 0.f, 0.f, 0.f};
#pragma unroll 1
    for (int dir = 0; dir < 2; ++dir) {
        LAS bf16* Qs = dir ? Qs1 : Qs0; LAS bf16* Ks = dir ? Ks1 : Ks0; LAS float* Cs = dir ? Cs1 : Cs0;
        const int step = is_ctx ? (dir ? 3 - ci : ci) : (dir ? 39 - ci : ci);
        float cf[8], la[8];
        { const float* cfp = (const float*)(F.ws + WS_CF) + ((size_t)(base + lane) * 2 + dir) * 384 + h * 64 + 8 * w; const f32x4 c0 = *(const f32x4*)cfp, c1 = *(const f32x4*)(cfp + 4);
          const float cv[8] = {c0[0], c0[1], c0[2], c0[3], c1[0], c1[1], c1[2], c1[3]};
#pragma unroll
          for (int e = 0; e < 8; ++e) { cf[e] = cv[e]; const float pv = __shfl_up(cv[e], 1); la[e] = cv[e] - (lane ? pv : 0.f); } }
        { v4u qw, kw; float qt[8], kt[8];
#pragma unroll
          for (int e = 0; e < 8; ++e) { const float c = dir ? -(cf[e] - la[e]) : cf[e]; qt[e] = qx[e] * 0.125f * __expf(c); kt[e] = kx[e] * __expf(-c); if (lane == 63) Cs[8 * w + e] = cf[e]; }
          qw.x = pk2(qt[0], qt[1]); qw.y = pk2(qt[2], qt[3]); qw.z = pk2(qt[4], qt[5]); qw.w = pk2(qt[6], qt[7]); kw.x = pk2(kt[0], kt[1]); kw.y = pk2(kt[2], kt[3]); kw.z = pk2(kt[4], kt[5]); kw.w = pk2(kt[6], kt[7]);
          *(LAS v4u*)(Qs + lane * GLP + 8 * w) = qw; *(LAS v4u*)(Ks + lane * GLP + 8 * w) = kw; }
        const bf16* ST = (const bf16*)(F.ws + WS_ST) + ((size_t)((b * GH + h) * 2 + dir) * GSTEPS + step) * 8192;
        v4u sraw[4][2];
#pragma unroll
        for (int jb = 0; jb < 4; ++jb)
#pragma unroll
            for (int ks = 0; ks < 2; ++ks) sraw[jb][ks] = *(const v4u*)(ST + (16 * (4 * jh + jb) + r16) * 64 + 8 * g + 32 * ks);
        __syncthreads();
        bf16x8 qf[2];
#pragma unroll
        for (int ks = 0; ks < 2; ++ks) qf[ks] = *(const LAS bf16x8*)(Qs + (16 * tb + r16) * GLP + 8 * g + 32 * ks);
        f32x4 at[4];
#pragma unroll
        for (int sb = 0; sb < 4; ++sb) { at[sb] = (f32x4){0.f, 0.f, 0.f, 0.f};
            const bool live = dir ? (sb >= tb) : (sb <= tb);
            if (live) {
#pragma unroll
                for (int ks = 0; ks < 2; ++ks) at[sb] = __builtin_amdgcn_mfma_f32_16x16x32_bf16(*(const LAS bf16x8*)(Ks + (16 * sb + r16) * GLP + 8 * g + 32 * ks), qf[ks], at[sb], 0, 0, 0);
                if (sb == tb) {
#pragma unroll
                    for (int e = 0; e < 4; ++e) { const int sl = 4 * g + e; const bool keep = dir ? (sl >= r16) : (sl <= r16); if (!keep) at[sb][e] = 0.f; } } } }
#pragma unroll
        for (int jb = 0; jb < 4; ++jb) {
#pragma unroll
            for (int ks = 0; ks < 2; ++ks) { v4u sw = sraw[jb][ks];
                if (dir) { const unsigned wsrc[4] = {sw.x, sw.y, sw.z, sw.w}; unsigned wd[4];
#pragma unroll
                    for (int e2 = 0; e2 < 4; ++e2) wd[e2] = pk2(bflo(wsrc[e2]) * __expf(Cs[8 * g + 32 * ks + 2 * e2]), bfhi(wsrc[e2]) * __expf(Cs[8 * g + 32 * ks + 2 * e2 + 1]));
                    sw.x = wd[0]; sw.y = wd[1]; sw.z = wd[2]; sw.w = wd[3]; }
                O[jb] = __builtin_amdgcn_mfma_f32_16x16x32_bf16(__builtin_bit_cast(bf16x8, sw), qf[ks], O[jb], 0, 0, 0); }
#pragma unroll
            for (int ss = 0; ss < 2; ++ss) { const bool live = dir ? (2 * ss + 1 >= tb) : (2 * ss <= tb);
                if (live) { v4u pw; pw.x = pk2(at[2 * ss][0], at[2 * ss][1]); pw.y = pk2(at[2 * ss][2], at[2 * ss][3]); pw.z = pk2(at[2 * ss + 1][0], at[2 * ss + 1][1]); pw.w = pk2(at[2 * ss + 1][2], at[2 * ss + 1][3]);
                    const LAS bf16* vp = VTs + (16 * (4 * jh + jb) + r16) * GLP + 32 * ss + 4 * g; const v2u lo = *(const LAS v2u*)vp, hi = *(const LAS v2u*)(vp + 16);
                    v4u aw; aw.x = lo.x; aw.y = lo.y; aw.z = hi.x; aw.w = hi.y;
                    O[jb] = __builtin_amdgcn_mfma_f32_16x16x32_bf16(__builtin_bit_cast(bf16x8, aw), __builtin_bit_cast(bf16x8, pw), O[jb], 0, 0, 0); } } }
    }
    float ss2 = 0.f;
#pragma unroll
    for (int jb = 0; jb < 4; ++jb) ss2 += (O[jb][0] * O[jb][0] + O[jb][1] * O[jb][1]) + (O[jb][2] * O[jb][2] + O[jb][3] * O[jb][3]);
    ss2 += __shfl_xor(ss2, 16); ss2 += __shfl_xor(ss2, 32);
    if (g == 0) red[(16 * tb + r16) * 2 + jh] = ss2;
    __syncthreads();
    const int tl = 16 * tb + r16; const float rn = 1.0f / sqrtf((red[tl * 2] + red[tl * 2 + 1]) * (1.0f / 128.0f) + LN_EPS);
    const bf16* PROJ = (const bf16*)(F.ws + WS_PROJ); bf16* MIX = (bf16*)(F.ws + WS_MIX); const size_t otok = (size_t)base + tl;
#pragma unroll
    for (int jb = 0; jb < 4; ++jb) { const int j0 = 16 * (4 * jh + jb) + 4 * g; const v2u gw = *(const v2u*)(PROJ + otok * INCP + C_GG + h * 128 + j0); const f32x4 nw = *(const f32x4*)(INP(IN_GNW) + L * 128 + j0);
        v2u o; o.x = pk2(O[jb][0] * rn * nw[0] * silu_f(bflo(gw.x)), O[jb][1] * rn * nw[1] * silu_f(bfhi(gw.x))); o.y = pk2(O[jb][2] * rn * nw[2] * silu_f(bflo(gw.y)), O[jb][3] * rn * nw[3] * silu_f(bfhi(gw.y)));
        *(v2u*)(MIX + otok * DM + M_GLA + h * 128 + j0) = o; }
    __syncthreads();
}
__device__ __forceinline__ void p5_mixers2(Fr F, int L) {
    RELAUNDER(F);
    const int nci = (L == 0) ? 36 : 32, n_items = NB * GH * nci;
    for (int rep = 0; rep < 1 + ((REPMASK >> 2) & 1); ++rep)
    for (int it = F.bid; it < n_items; it += F.G) { const int ci = it % nci + ((L == 0) ? 0 : 4), bh = it / nci; gla_g3_item(F, L, bh / GH, bh % GH, ci); }
    for (int rep = 0; rep < 1 + ((REPMASK >> 4) & 1); ++rep)
    for (int it = F.bid; it < 128 + ((L == 0) ? 16 : 0); it += F.G) hy_post_item(F, L, it);
    const int gw = F.bid * NWAVES + F.wave, NGW = F.G * NWAVES; const int nrows = (L == 0) ? TTOT : TLAT; bf16* MIX = (bf16*)(F.ws + WS_MIX);
    for (int row = gw; row < nrows; row += NGW) {
        { v2u* p = (v2u*)(MIX + (size_t)row * DM + M_NA + F.lane * 12); const v2u w0 = p[0], w1 = p[1], w2 = p[2];
          float x[12] = {bflo(w0.x), bfhi(w0.x), bflo(w0.y), bfhi(w0.y), bflo(w1.x), bfhi(w1.x), bflo(w1.y), bfhi(w1.y), bflo(w2.x), bfhi(w2.x), bflo(w2.y), bfhi(w2.y)}; float s = 0.f;
#pragma unroll
          for (int i = 0; i < 12; ++i) s += x[i] * x[i];
          const float rn = 1.0f / sqrtf(wave_sum(s) * (1.0f / 768.0f) + LN_EPS); const float* nw = INP(IN_NANW) + L * 768 + F.lane * 12;
#pragma unroll
          for (int i = 0; i < 12; ++i) x[i] *= rn * nw[i];
          v2u o0, o1, o2; o0.x = pk2(x[0], x[1]); o0.y = pk2(x[2], x[3]); o1.x = pk2(x[4], x[5]); o1.y = pk2(x[6], x[7]); o2.x = pk2(x[8], x[9]); o2.y = pk2(x[10], x[11]);
          p[0] = o0; p[1] = o1; p[2] = o2; }
    }
}

__device__ __forceinline__ void p7_row(const Fr& F, int L, int row, f32x4 (&hv)[8]) {
    const int lane = F.lane;
    const bf16* Y = (const bf16*)(F.ws + WS_Y); bf16* X1 = (bf16*)(F.ws + WS_X1); bf16* H = (bf16*)(F.ws + WS_H);
    const float* lg = INP(IN_LN1G) + L * DM; const float* lb = INP(IN_LN1B) + L * DM;
    const float* mod = mod_ptr(F, L, row);
    const v2u* yr = (const v2u*)(Y + (size_t)row * DM) + lane;
    f32x4 v[8]; float s = 0.f;
#pragma unroll
    for (int j = 0; j < 8; ++j) { const f32x4 g1 = *((const f32x4*)(mod + 2 * DM) + lane + 64 * j); const v2u yw = yr[64 * j]; v[j] = load_x4(F, L, row, lane + 64 * j) * ALPHA + g1 * (f32x4){bflo(yw.x), bfhi(yw.x), bflo(yw.y), bfhi(yw.y)}; s += (v[j][0] + v[j][1]) + (v[j][2] + v[j][3]); }
    float mean = wave_sum(s) * (1.f / DM), s2 = 0.f;
#pragma unroll
    for (int j = 0; j < 8; ++j) { v[j] = v[j] - mean; s2 += (v[j][0] * v[j][0] + v[j][1] * v[j][1]) + (v[j][2] * v[j][2] + v[j][3] * v[j][3]); }
    float rstd = 1.f / sqrtf(wave_sum(s2) * (1.f / DM) + LN_EPS); s = 0.f;
#pragma unroll
    for (int j = 0; j < 8; ++j) { const f32x4 g = *((const f32x4*)lg + lane + 64 * j), bb = *((const f32x4*)lb + lane + 64 * j); v[j] = v[j] * rstd * g + bb;
        { v2u xw; xw.x = pk2(v[j][0], v[j][1]); xw.y = pk2(v[j][2], v[j][3]); *((v2u*)(X1 + (size_t)row * DM) + lane + 64 * j) = xw; } s += (v[j][0] + v[j][1]) + (v[j][2] + v[j][3]); }
    mean = wave_sum(s) * (1.f / DM); s2 = 0.f;
#pragma unroll
    for (int j = 0; j < 8; ++j) { v[j] = v[j] - mean; s2 += (v[j][0] * v[j][0] + v[j][1] * v[j][1]) + (v[j][2] * v[j][2] + v[j][3] * v[j][3]); }
    rstd = 1.f / sqrtf(wave_sum(s2) * (1.f / DM) + LN_EPS);
    v2u* o8 = (v2u*)(H + (size_t)row * DM) + lane;
#pragma unroll
    for (int j = 0; j < 8; ++j) { const f32x4 sh = *((const f32x4*)(mod + 3 * DM) + lane + 64 * j), sc = *((const f32x4*)(mod + 4 * DM) + lane + 64 * j);
        hv[j] = v[j] * rstd * (sc + 1.0f) + sh; v2u w; w.x = pk2(hv[j][0], hv[j][1]); w.y = pk2(hv[j][2], hv[j][3]); o8[64 * j] = w; }
}
__device__ __forceinline__ void p7_route(const Fr& F, int L, int row, const float (&a)[36], bool commit) {
    const float gl0 = a[0] + INP(IN_BRG)[L * 4 + 0], gl1 = a[1] + INP(IN_BRG)[L * 4 + 1], gl2 = a[2] + INP(IN_BRG)[L * 4 + 2], gl3 = a[3] + INP(IN_BRG)[L * 4 + 3];
    float gm = gl0; int g = 0;
    if (gl1 > gm) { gm = gl1; g = 1; }
    if (gl2 > gm) { gm = gl2; g = 2; }
    if (gl3 > gm) { gm = gl3; g = 3; }
    const float gs = __expf(gl0 - gm) + __expf(gl1 - gm) + __expf(gl2 - gm) + __expf(gl3 - gm);
    const float top_pg = 1.0f / gs;
    float le[8];
#pragma unroll
    for (int e = 0; e < 8; ++e) { const float c0 = a[4 + e], c1 = a[12 + e], c2 = a[20 + e], c3 = a[28 + e];
        const float x = (g == 0) ? c0 : (g == 1) ? c1 : (g == 2) ? c2 : c3; le[e] = x + INP(IN_BRE)[L * 32 + g * 8 + e]; }
    float v1 = -3.0e38f; int e1 = 0;
#pragma unroll
    for (int e = 0; e < 8; ++e) if (le[e] > v1) { v1 = le[e]; e1 = e; }
    float v2 = -3.0e38f; int e2 = 0;
#pragma unroll
    for (int e = 0; e < 8; ++e) if (e != e1 && le[e] > v2) { v2 = le[e]; e2 = e; }
    const float ex = __expf(v2 - v1), w1 = top_pg / (1.0f + ex), w2 = top_pg * ex / (1.0f + ex);
    if (commit) {
        unsigned* cnt = (unsigned*)(F.ctl + CW_CNT + L * 64); int* asg = (int*)(F.ws + WS_ASG) + (size_t)row * 8;
        const int ea = g * 8 + e1, eb = g * 8 + e2;
        const unsigned ra = atomicAdd(cnt + ea, 1u), rb = atomicAdd(cnt + eb, 1u);
        int* RLIST = (int*)(F.ws + WS_XG); float* GLIST = (float*)(F.ws + WS_XG + 2 * MiB);
        RLIST[ea * TTOT + (int)ra] = row; GLIST[ea * TTOT + (int)ra] = w1; RLIST[eb * TTOT + (int)rb] = row; GLIST[eb * TTOT + (int)rb] = w2;
        asg[0] = ea; asg[1] = (int)ra; asg[2] = __builtin_bit_cast(int, w1); asg[3] = 0;
        asg[4] = eb; asg[5] = (int)rb; asg[6] = __builtin_bit_cast(int, w2); asg[7] = 0;
    }
}
constexpr int RP = DM + 8;
__device__ __forceinline__ void p7_item(const Fr& F, int L, int item, bool commit) {
    const int lane = F.lane, tid = F.tid, w = F.wave, r16 = lane & 15, g = lane >> 4;
    LAS bf16* Ah = (LAS bf16*)F.lds; LAS bf16* Al = Ah + 16 * RP;
#pragma unroll 1
    for (int rr = 0; rr < 2; ++rr) { f32x4 hv[8]; p7_row(F, L, item * 16 + w * 2 + rr, hv);
#pragma unroll
        for (int j = 0; j < 8; ++j) { v2u hi, lo; float r[4];
#pragma unroll
            for (int i = 0; i < 4; ++i) r[i] = hv[j][i] - __builtin_bit_cast(float, f2bf(hv[j][i]) << 16);
            hi.x = pk2(hv[j][0], hv[j][1]); hi.y = pk2(hv[j][2], hv[j][3]); lo.x = pk2(r[0], r[1]); lo.y = pk2(r[2], r[3]);
            *(LAS v2u*)(Ah + (w * 2 + rr) * RP + lane * 4 + 256 * j) = hi; *(LAS v2u*)(Al + (w * 2 + rr) * RP + lane * 4 + 256 * j) = lo; } }
    __syncthreads();
    f32x4 acc[3];
#pragma unroll
    for (int nt = 0; nt < 3; ++nt) acc[nt] = (f32x4){0.f, 0.f, 0.f, 0.f};
    { const bf16* WRH = (const bf16*)(F.ws + WS_WRT) + ((size_t)L * 48 + r16) * DM + 256 * w + 8 * g; const bf16* WRL = (const bf16*)(F.ws + WS_WRT + 512 * 1024) + ((size_t)L * 48 + r16) * DM + 256 * w + 8 * g;
      const LAS bf16* ahp = Ah + r16 * RP + 256 * w + 8 * g; const LAS bf16* alp = Al + r16 * RP + 256 * w + 8 * g;
#pragma unroll
      for (int ks = 0; ks < 8; ++ks) { const bf16x8 ah = *(const LAS bf16x8*)(ahp + 32 * ks), al = *(const LAS bf16x8*)(alp + 32 * ks);
#pragma unroll
          for (int nt = 0; nt < 3; ++nt) { const bf16x8 bh = *(const bf16x8*)(WRH + (size_t)nt * 16 * DM + 32 * ks), bl = *(const bf16x8*)(WRL + (size_t)nt * 16 * DM + 32 * ks);
              acc[nt] = __builtin_amdgcn_mfma_f32_16x16x32_bf16(ah, bh, acc[nt], 0, 0, 0); acc[nt] = __builtin_amdgcn_mfma_f32_16x16x32_bf16(ah, bl, acc[nt], 0, 0, 0); acc[nt] = __builtin_amdgcn_mfma_f32_16x16x32_bf16(al, bh, acc[nt], 0, 0, 0); } } }
    __syncthreads();
    LAS float* Pp = (LAS float*)F.lds;
    LAS float* LG = Pp + 8 * 16 * 48;
#pragma unroll
    for (int nt = 0; nt < 3; ++nt)
#pragma unroll
        for (int e = 0; e < 4; ++e) Pp[(w * 16 + 4 * g + e) * 48 + nt * 16 + r16] = acc[nt][e];
    __syncthreads();
    for (int idx = tid; idx < 16 * 36; idx += NTHR) { const int row = idx / 36, o = idx - row * 36; float sum = 0.f;
#pragma unroll
        for (int ww = 0; ww < 8; ++ww) sum += Pp[(ww * 16 + row) * 48 + o];
        LG[idx] = sum; }
    __syncthreads();
    if (tid < 16) { float a[36];
#pragma unroll
        for (int o = 0; o < 36; ++o) a[o] = LG[tid * 36 + o];
        p7_route(F, L, item * 16 + tid, a, commit); }
    __syncthreads();
}

constexpr int MT_OFF = 0, MT_CNT = 33, MT_NT = 65, MT_TILE = 66;
__device__ __forceinline__ void moe_tables(const Fr& F, int L, LAS int* tab) {
    __syncthreads();
    if (F.tid < 64) { const int e = F.tid & 31; const unsigned* cnt = (unsigned*)(F.ctl + CW_CNT + L * 64);
        const int cn = (int)__hip_atomic_load(cnt + e, __ATOMIC_RELAXED, __HIP_MEMORY_SCOPE_AGENT), nt = (cn + 255) >> 8;
        int incl = nt;
#pragma unroll
        for (int o = 1; o < 32; o <<= 1) { const int u = __shfl_up(incl, o); if ((F.tid & 31) >= o) incl += u; }
        const int t0 = incl - nt;
        if (F.tid < 32) { tab[MT_OFF + e] = t0 * 256; tab[MT_CNT + e] = cn; for (int t = 0; t < nt; ++t) tab[MT_TILE + t0 + t] = e;
            if (e == 31) { tab[MT_OFF + 32] = incl * 256; tab[MT_NT] = incl; } } }
    __syncthreads();
}

__device__ __forceinline__ void p11_ln2(Fr F, int L, int nrows, float* outp) {
    RELAUNDER(F);
    const int gw = F.bid * NWAVES + F.wave, NGW = F.G * NWAVES, lane = F.lane;
    const bf16* X1 = (const bf16*)(F.ws + WS_X1); const bf16* DN = (const bf16*)(F.ws + WS_DN); const int* ASG = (const int*)(F.ws + WS_ASG);
    LAS int* tab = (LAS int*)(F.lds + LDSCTL_OFF + 128); moe_tables(F, L, tab);
    const float* lg = INP(IN_LN2G) + L * DM; const float* lb = INP(IN_LN2B) + L * DM;
    for (int row = gw; row < nrows; row += NGW) {
        const float* mod = mod_ptr(F, L, row); const int s0 = tab[MT_OFF + ASG[row * 8]] + ASG[row * 8 + 1], s1 = tab[MT_OFF + ASG[row * 8 + 4]] + ASG[row * 8 + 5];
        const v2u* xr = (const v2u*)(X1 + (size_t)row * DM) + lane; const v2u* d0 = (const v2u*)(DN + (size_t)s0 * DM) + lane; const v2u* d1 = (const v2u*)(DN + (size_t)s1 * DM) + lane;
        f32x4 v[8]; float s = 0.f;
#pragma unroll
        for (int j = 0; j < 8; ++j) { const f32x4 g2 = *((const f32x4*)(mod + 5 * DM) + lane + 64 * j); const v2u a = d0[64 * j], bq = d1[64 * j];
            const f32x4 f = (f32x4){bflo(a.x) + bflo(bq.x), bfhi(a.x) + bfhi(bq.x), bflo(a.y) + bflo(bq.y), bfhi(a.y) + bfhi(bq.y)};
            const v2u xw = xr[64 * j]; v[j] = (f32x4){bflo(xw.x), bfhi(xw.x), bflo(xw.y), bfhi(xw.y)} * ALPHA + g2 * f; s += (v[j][0] + v[j][1]) + (v[j][2] + v[j][3]); }
        const float mean = wave_sum(s) * (1.f / DM); float s2 = 0.f;
#pragma unroll
        for (int j = 0; j < 8; ++j) { v[j] = v[j] - mean; s2 += (v[j][0] * v[j][0] + v[j][1] * v[j][1]) + (v[j][2] * v[j][2] + v[j][3] * v[j][3]); }
        const float rstd = 1.f / sqrtf(wave_sum(s2) * (1.f / DM) + LN_EPS);
        float sn = 0.f;
#pragma unroll
        for (int j = 0; j < 8; ++j) { const f32x4 g = *((const f32x4*)lg + lane + 64 * j), bb = *((const f32x4*)lb + lane + 64 * j);
            v[j] = v[j] * rstd * g + bb; sn += (v[j][0] + v[j][1]) + (v[j][2] + v[j][3]);
            if (L == NLAYER - 1) *((f32x4*)(outp + (size_t)row * DM) + lane + 64 * j) = v[j];
            else { v2u xw; xw.x = pk2(v[j][0], v[j][1]); xw.y = pk2(v[j][2], v[j][3]); *((v2u*)((bf16*)(F.ws + WS_X2) + (size_t)row * DM) + lane + 64 * j) = xw; } }
        if (L + 1 < NLAYER) {
            const float* modn = mod_ptr(F, L + 1, row); const float mn = wave_sum(sn) * (1.f / DM); float s3 = 0.f;
#pragma unroll
            for (int j = 0; j < 8; ++j) { v[j] = v[j] - mn; s3 += (v[j][0] * v[j][0] + v[j][1] * v[j][1]) + (v[j][2] * v[j][2] + v[j][3] * v[j][3]); }
            const float rs = 1.f / sqrtf(wave_sum(s3) * (1.f / DM) + LN_EPS);
            v2u* o8 = (v2u*)((bf16*)(F.ws + WS_H) + (size_t)row * DM) + lane;
#pragma unroll
            for (int j = 0; j < 8; ++j) { const f32x4 sh = *((const f32x4*)(modn) + lane + 64 * j), sc = *((const f32x4*)(modn + DM) + lane + 64 * j);
                const f32x4 hh = v[j] * rs * (sc + 1.0f) + sh; v2u w; w.x = pk2(hh[0], hh[1]); w.y = pk2(hh[2], hh[3]); o8[64 * j] = w; }
        }
    }
}

constexpr int PH_PER_LAYER = 11, N_PHASES = 1 + NLAYER * PH_PER_LAYER;
struct Args { const float* in[33]; float* out; unsigned char* ws; int ph_lo, ph_hi, use_bar, pad; };
#ifndef PHMASK
#define PHMASK 0xFFFF
#endif
#define IN(k) (lo <= (k) && (k) < hi)
#define EN(j) ((PHMASK >> (j)) & 1)
#define SEAM(k) do { if (IN(k) && IN((k) + 1)) { xcd_barrier(bar); if ((REPMASK >> 14) & 1) xcd_barrier(bar); } } while (0)

#ifndef QUOTA_P2
#define QUOTA_P2 2
#define QUOTA_P6 1
#define QUOTA_P9 1
#define QUOTA_P10 0
#endif
template <int L> __device__ __forceinline__ void layer_phases(const Fr& F, const XcdBarrier& bar, const int lo, const int hi) {
        const int pb = 1 + L * PH_PER_LAYER;
        const int nrows = (L == 0) ? TTOT : TLAT;
        if (L == 0) { if (EN(1) && IN(pb + 0)) { p1_ln_mod(F, L); if ((REPMASK >> 6) & 1) p1_ln_mod(F, L); } SEAM(pb + 0); }
        if (EN(2) && IN(pb + 1)) {
            Fr Fp = F; RELAUNDER(Fp);
            pg8::Gemm g{(const pg8::bf16_t*)(Fp.ws + WS_H), (const pg8::bf16_t*)(Fp.ws + WS_WIN) + (size_t)L * INCP * DM, TTOT, INCP, DM};
            pg8::StaticOrder S; S.init(TTOT, INCP, Fp.G, Fp.bid);
            pg8::EpiBf16P E{(pg8::bf16_t*)(Fp.ws + WS_PROJ), INCP};
            for (int rep = 0; rep < 1 + (((REPMASK >> 5) | (REPMASK >> 16)) & 1); ++rep) pg8::gemm_phase<pg8::EpiBf16P, pg8::StaticOrder, true, true>(Fp.lds, g, S, E);
                    if (L == 0) { const int n_ = (TTOT / 256) * (INCP / 256), mx_ = (n_ + Fp.G - 1) / Fp.G, my_ = (Fp.bid < n_) ? (n_ - Fp.bid + Fp.G - 1) / Fp.G : 0; if (my_ < mx_) conv_bubble(Fp, QUOTA_P2); }
        } SEAM(pb + 1);
        if (EN(3) && IN(pb + 2)) { p3_mixers1(F, L); } SEAM(pb + 2);
        if (EN(4) && IN(pb + 3)) { p4_gla_scan(F, L, bar); } SEAM(pb + 3);
        if (EN(5) && IN(pb + 4)) { p5_mixers2(F, L); } SEAM(pb + 4);
        if (EN(6) && IN(pb + 5)) {
            Fr Fp = F; RELAUNDER(Fp);
            pg8::Gemm g{(const pg8::bf16_t*)(Fp.ws + WS_MIX), (const pg8::bf16_t*)(Fp.ws + WS_WOUT) + (size_t)L * DM * DM, nrows, DM, DM};
            pg8::StaticOrder S; S.init(nrows, DM, Fp.G, Fp.bid);
            pg8::EpiBf16P E{(pg8::bf16_t*)(Fp.ws + WS_Y), DM};
            for (int rep = 0; rep < 1 + (((REPMASK >> 5) | (REPMASK >> 17)) & 1); ++rep) pg8::gemm_phase<pg8::EpiBf16P, pg8::StaticOrder, true, true>(Fp.lds, g, S, E);
                    if (L == 0) { const int n_ = (nrows / 256) * (DM / 256), mx_ = (n_ + Fp.G - 1) / Fp.G, my_ = (Fp.bid < n_) ? (n_ - Fp.bid + Fp.G - 1) / Fp.G : 0; if (my_ < mx_) conv_bubble(Fp, QUOTA_P6); }
        } SEAM(pb + 5);
        if (EN(7) && IN(pb + 6)) { Fr Fp = F; RELAUNDER(Fp); for (int rep = ((REPMASK >> 9) & 1) ? 0 : 1; rep < 2; ++rep) { _Pragma("unroll 1") for (int it = Fp.bid; it < nrows / 16; it += Fp.G) p7_item(Fp, L, it, rep == 1); } } SEAM(pb + 6);
        if (EN(9) && IN(pb + 8)) {
            Fr Fp = F; RELAUNDER(Fp);
            LAS int* tab = (LAS int*)(Fp.lds + LDSCTL_OFF + 128); moe_tables(Fp, L, tab); const int ntiles = __builtin_amdgcn_readfirstlane(tab[MT_NT]);
            const int NUP = ntiles * 4, NU = NUP + ntiles * 8;
            GAS unsigned* mq = Fp.ctl + CW_MQ + L * 64; GAS unsigned* done = Fp.ctl + CW_DONE + L * 1536;
            volatile LAS int* slot = (volatile LAS int*)(Fp.lds + LDSCTL_OFF + 96);
            const size_t ws_act = L ? WS_ACT1 : WS_ACT;
            pg8::EpiAct EU{(pg8::bf16_t*)(Fp.ws + ws_act), (const float*)(Fp.ws + WS_XG + 2 * MiB)};
            pg8::EpiDn ED{(pg8::bf16_t*)(Fp.ws + WS_DN)};
            int Lc = Fp.bid;
            while (Lc < NU) {
                int nxt = 0;
                if (Fp.tid == 0) nxt = Fp.G + (int)__hip_atomic_fetch_add(mq, 1u, __ATOMIC_RELAXED, __HIP_MEMORY_SCOPE_AGENT);
                if (Lc < NUP) {
                    const int t = Lc >> 2, j = Lc & 3;
                    pg8::moe_unit<true, pg8::EpiAct>(Fp.lds, (const pg8::bf16_t*)(Fp.ws + WS_H), (const int*)(Fp.ws + WS_XG), INP(IN_WUP) + (size_t)L * NEXP * DM * 1024, tab, t, j, EU);
                    asm volatile("s_waitcnt vmcnt(0)" ::: "memory");
                    __syncthreads();
                    if (Fp.tid == 0) { __builtin_amdgcn_fence(__ATOMIC_RELEASE, "agent"); asm volatile("s_waitcnt vmcnt(0)" ::: "memory"); (void)__hip_atomic_fetch_add(done + t * 8, 1u, __ATOMIC_RELAXED, __HIP_MEMORY_SCOPE_AGENT); }
                } else {
                    const int d = Lc - NUP, t = d >> 3, j = d & 7;
                    if (Fp.tid == 0) { unsigned sp = 0;
                        while (__hip_atomic_load(done + t * 8, __ATOMIC_RELAXED, __HIP_MEMORY_SCOPE_AGENT) < 4u) { __builtin_amdgcn_s_sleep(2); if (++sp > (1u << 18)) break; }
                        __builtin_amdgcn_fence(__ATOMIC_ACQUIRE, "agent");
                        asm volatile("s_waitcnt vmcnt(0)" ::: "memory"); }
                    __syncthreads();
                    pg8::moe_unit<false, pg8::EpiDn>(Fp.lds, (const pg8::bf16_t*)(Fp.ws + ws_act), nullptr, INP(IN_WDN) + (size_t)L * NEXP * DEXP * DM, tab, t, j, ED);
                }
                if (Fp.tid == 0) *slot = nxt;
                __syncthreads();
                Lc = __builtin_amdgcn_readfirstlane(*slot);
                __syncthreads();
            }
            if (L == 0) conv_bubble(Fp, QUOTA_P9);
        } SEAM(pb + 8);
        if (EN(11) && IN(pb + 10)) { p11_ln2(F, L, nrows, (L == NLAYER - 1) ? (float*)F.out : (float*)(F.ws + WS_X2)); if ((REPMASK >> 6) & 1) p11_ln2(F, L, nrows, (L == NLAYER - 1) ? (float*)F.out : (float*)(F.ws + WS_X2)); }
        if (L + 1 < NLAYER) { if (IN(pb + 10)) { __syncthreads(); conv_bubble(F, -1); } SEAM(pb + 10); }
    }
__global__ void __launch_bounds__(NTHR, 2) fwd_kernel(Args args) {
    extern __shared__ __attribute__((aligned(16))) unsigned char lds_raw[];
    Fr F;
    F.lds = (LAS unsigned char*)lds_raw;
    F.tid = threadIdx.x; F.lane = F.tid & 63; F.wave = __builtin_amdgcn_readfirstlane(F.tid >> 6);
    F.G = gridDim.x; F.bid = blockIdx.x;
    F.in = (const GAS float* const KAS*)__builtin_amdgcn_kernarg_segment_ptr();
    F.out = (GAS float*)args.out; F.ws = (GAS unsigned char*)args.ws; F.ctl = (GAS unsigned*)(args.ws + WS_CTL);
    for (int u = F.tid; u < (LDS_BYTES - LDSCTL_OFF) / 4; u += NTHR) ((LAS unsigned*)(F.lds + LDSCTL_OFF))[u] = 0u;
    __syncthreads();
    XcdBarrier bar; bar.bar = (unsigned*)(F.ctl + CW_BAR); bar.x = 0; bar.st = nullptr;
    if (args.use_bar) bar = xcd_barrier_post((unsigned*)(F.ctl + CW_BAR), (volatile LAS unsigned*)(F.lds + LDSCTL_OFF + 32));
    const int lo = args.ph_lo, hi = args.ph_hi;
    if (EN(0) && IN(0)) { p0_prologue(F); if ((REPMASK >> 3) & 1) { __syncthreads(); p0_prologue(F); } } SEAM(0);
    layer_phases<0>(F, bar, lo, hi);
    layer_phases<1>(F, bar, lo, hi);
#undef IN
#undef SEAM
}

#ifndef MK_ONE_LAUNCH
#define MK_ONE_LAUNCH 0
#endif
extern "C" void kernel_launch(void* const* d_in, const int* in_sizes, int n_in, void* d_out, int out_size, void* d_ws, size_t ws_size, hipStream_t stream) {
    static int grid = 0;
    if (grid == 0) {
        if (n_in != 33 || out_size != TLAT * DM || ws_size < WS_END) { fprintf(stderr, "kernel_launch: unexpected shapes: n_in %d out %d ws %zu (need %zu)\n", n_in, out_size, ws_size, (size_t)WS_END); grid = -1; return; }
        int dev = 0, cus = 0, per_cu = 0;
        if (hipGetDevice(&dev) != hipSuccess || hipDeviceGetAttribute(&cus, hipDeviceAttributeMultiprocessorCount, dev) != hipSuccess) { grid = -1; return; }
        if (hipFuncSetAttribute((const void*)fwd_kernel, hipFuncAttributeMaxDynamicSharedMemorySize, LDS_BYTES) != hipSuccess) { fprintf(stderr, "kernel_launch: hipFuncSetAttribute failed\n"); grid = -1; return; }
        if (hipOccupancyMaxActiveBlocksPerMultiprocessor(&per_cu, (const void*)fwd_kernel, NTHR, LDS_BYTES) != hipSuccess || per_cu < 1) fprintf(stderr, "kernel_launch: occupancy query says %d\n", per_cu);
        (void)hipGetLastError();
        grid = cus;
    }
    if (grid < 0) return;
    if (hipMemsetAsync((char*)d_ws + WS_CTL, 0, CTL_ZERO_BYTES, stream) != hipSuccess) return;
    Args a{};
    for (int i = 0; i < 33; ++i) a.in[i] = (const float*)d_in[i];
    a.out = (float*)d_out; a.ws = (unsigned char*)d_ws; a.pad = 0;
#if MK_ONE_LAUNCH
    a.ph_lo = 0; a.ph_hi = N_PHASES; a.use_bar = 1;
    hipLaunchKernelGGL(fwd_kernel, dim3(grid), dim3(NTHR), LDS_BYTES, stream, a);
    if ((REPMASK >> 15) & 1) {
        (void)hipMemsetAsync((char*)d_ws + WS_CTL, 0, CTL_ZERO_BYTES, stream);
        hipLaunchKernelGGL(fwd_kernel, dim3(grid), dim3(NTHR), LDS_BYTES, stream, a); }
#else
    for (int p = 0; p < N_PHASES; ++p) { a.ph_lo = p; a.ph_hi = p + 1; a.use_bar = 0;
        hipLaunchKernelGGL(fwd_kernel, dim3(grid), dim3(NTHR), LDS_BYTES, stream, a); }
#endif
}
```

```cpp
#include <hip/hip_runtime.h>
#include <cstdio>
#include <cstdint>
#define MK_ONE_LAUNCH 1
namespace pg8 {
#define PG8_LAS __attribute__((address_space(3)))
typedef unsigned short bf16_t;
typedef short bf16x8 __attribute__((ext_vector_type(8)));
typedef float f32x4 __attribute__((ext_vector_type(4)));
typedef unsigned u32x4 __attribute__((ext_vector_type(4)));
constexpr int BM = 256, BK = 64, HALF = 128, HTB = HALF * BK * 2  , STAGE_BYTES = 8 * HTB, NXCD = 8, WGM = 8;

__host__ __device__ __forceinline__ int lds_byte(int r, int c) { const int st = (r >> 4) * 2 + (c >> 5), rr = r & 15, cc = c & 31, ob = rr * 64 + cc * 2; return st * 1024 + (ob ^ (((ob >> 9) & 1) << 5)); }
__host__ __device__ __forceinline__ void stage_rc(int b, int& R, int& C) { const int st = b / 1024, sb = b % 1024, swz = sb ^ (((sb >> 9) & 1) << 5); R = (st >> 1) * 16 + swz / 64; C = (st & 1) * 32 + (swz % 64) / 2; }
__host__ __device__ __forceinline__ int perm32(int rho) { const int n = rho >> 4, i = rho & 15; return 8 * (i >> 2) + 4 * n + (i & 3); }

struct Unit { int pm, pn; };
struct Gemm { const bf16_t* A; const bf16_t* Bt; int M, N, K; };

struct StaticOrder {
    int nM, nN, nwg, G, c;
    __host__ __device__ void init(int M, int N, int G_, int c_) { nM = M / BM; nN = N / BM; nwg = nM * nN; G = G_; c = c_; }
    __host__ __device__ bool next(int i, Unit& u) const {
        const long L = (long)i * G + c; if (L >= nwg) return false;
        int wgid = (int)L; { const int q = nwg / NXCD, r = nwg % NXCD, xcd = wgid % NXCD, off = wgid / NXCD; wgid = (xcd < r ? xcd * (q + 1) : r * (q + 1) + (xcd - r) * q) + off; }
        const int nig = WGM * nN, gid = wgid / nig, fm = gid * WGM, gsz = (nM - fm) < WGM ? (nM - fm) : WGM;
        u.pm = fm + ((wgid % nig) % gsz); u.pn = (wgid % nig) / gsz; return true;
    }
    __device__ __forceinline__ void a_ready(const Unit&) const {}
    __device__ __forceinline__ void done(const Unit&) const {}
};
__device__ __forceinline__ unsigned cvt_pk_bf16(float lo, float hi) { unsigned r; asm volatile("v_cvt_pk_bf16_f32 %0, %1, %2" : "=v"(r) : "v"(lo), "v"(hi)); return r; }
typedef float f32x2 __attribute__((ext_vector_type(2)));
struct EpiBf16P {
    static constexpr bool PERM = true, AFTER_DRAIN = false;
    bf16_t* O; int ldc;
    __device__ __forceinline__ void operator()(const f32x4 (&acc)[2][2][4][2], const Unit& u, int wr, int wc, int fr, int fq) const {
        const int row0 = u.pm * BM + wr * 64 + fr, col0 = u.pn * BM + wc * 32 + 8 * fq;
        bf16_t* Ob = O; asm volatile("" : "+s"(Ob));
#pragma unroll
        for (int ai = 0; ai < 2; ++ai)
#pragma unroll
            for (int m = 0; m < 4; ++m) { bf16_t* rowp = Ob + (size_t)(row0 + ai * HALF + m * 16) * ldc + col0;
#pragma unroll
                for (int bj = 0; bj < 2; ++bj) { const f32x4 v0 = acc[ai][bj][m][0], v1 = acc[ai][bj][m][1];
                    u32x4 w; w.x = cvt_pk_bf16(v0[0], v0[1]); w.y = cvt_pk_bf16(v0[2], v0[3]); w.z = cvt_pk_bf16(v1[0], v1[1]); w.w = cvt_pk_bf16(v1[2], v1[3]);
                    *(u32x4*)(rowp + bj * HALF) = w; } }
    }
};
struct EpiF32P {
    static constexpr bool PERM = false, AFTER_DRAIN = false;
    float* C; int ldc;
    __device__ __forceinline__ void operator()(const f32x4 (&acc)[2][2][4][2], const Unit& u, int wr, int wc, int fr, int fq) const {
        const int row0 = u.pm * BM + wr * 64 + fr, col0 = u.pn * BM + wc * 32 + 4 * fq;
        float* Cb = C; asm volatile("" : "+s"(Cb));
#pragma unroll
        for (int ai = 0; ai < 2; ++ai)
#pragma unroll
            for (int m = 0; m < 4; ++m) { float* rowp = Cb + (size_t)(row0 + ai * HALF + m * 16) * ldc + col0;
#pragma unroll
                for (int bj = 0; bj < 2; ++bj)
#pragma unroll
                    for (int n = 0; n < 2; ++n) *(f32x4*)(rowp + bj * HALF + n * 16) = acc[ai][bj][m][n]; }
    }
};
struct EpiAct {
    static constexpr bool PERM = true, AFTER_DRAIN = false;
    bf16_t* O; const float* gate;
    __device__ __forceinline__ void operator()(const f32x4 (&acc)[2][2][4][2], const Unit& u, int wr, int wc, int fr, int fq) const {
        const int row0 = u.pm * BM + wr * 64 + fr, col0 = (u.pn & 3) * 128 + wc * 32 + 8 * fq;
        bf16_t* Ob = O; const float* gb = gate; asm volatile("" : "+s"(Ob), "+s"(gb));
        const __amdgpu_buffer_rsrc_t orsrc = __builtin_amdgcn_make_buffer_rsrc(Ob, 0, 26624 * 512 * 2, 0x00020000);
#pragma unroll
        for (int ai = 0; ai < 2; ++ai)
#pragma unroll
            for (int m = 0; m < 4; ++m) { const int row = row0 + ai * HALF + m * 16; const float gt = gb[row];
                float o[8];
#pragma unroll
                for (int n = 0; n < 2; ++n)
#pragma unroll
                    for (int i = 0; i < 4; ++i) { const float g = acc[ai][0][m][n][i], up = acc[ai][1][m][n][i]; o[n * 4 + i] = g / (1.0f + __expf(-g)) * up * gt; }
                u32x4 w; w.x = cvt_pk_bf16(o[0], o[1]); w.y = cvt_pk_bf16(o[2], o[3]); w.z = cvt_pk_bf16(o[4], o[5]); w.w = cvt_pk_bf16(o[6], o[7]);
                __builtin_amdgcn_raw_buffer_store_b128(w, orsrc, (unsigned)((row * 512 + col0) * 2), 0,   16); }
    }
};
struct EpiDn {
    static constexpr bool PERM = true, AFTER_DRAIN = false;
    bf16_t* O;
    __device__ __forceinline__ void operator()(const f32x4 (&acc)[2][2][4][2], const Unit& u, int wr, int wc, int fr, int fq) const {
        const int row0 = u.pm * BM + wr * 64 + fr, col0 = (u.pn & 7) * BM + wc * 32 + 8 * fq;
        bf16_t* Ob = O; asm volatile("" : "+s"(Ob));
#pragma unroll
        for (int ai = 0; ai < 2; ++ai)
#pragma unroll
            for (int m = 0; m < 4; ++m) { bf16_t* rowp = Ob + (size_t)(row0 + ai * HALF + m * 16) * 2048 + col0;
#pragma unroll
                for (int bj = 0; bj < 2; ++bj) { const f32x4 v0 = acc[ai][bj][m][0], v1 = acc[ai][bj][m][1];
                    u32x4 w; w.x = cvt_pk_bf16(v0[0], v0[1]); w.y = cvt_pk_bf16(v0[2], v0[3]); w.z = cvt_pk_bf16(v1[0], v1[1]); w.w = cvt_pk_bf16(v1[2], v1[3]);
                    *(u32x4*)(rowp + bj * HALF) = w; } }
    }
};
struct MoeOrder {
    const int* tile_e; int ntiles, nsub, G, c;
    __device__ __forceinline__ bool next(int i, Unit& u) const {
        const int L = i * G + c; if (L >= ntiles * nsub) return false;
        const int t = L / nsub, j = L - t * nsub; u.pm = t; u.pn = tile_e[t] * nsub + j; return true;
    }
    __device__ __forceinline__ void a_ready(const Unit&) const {}
    __device__ __forceinline__ void done(const Unit&) const {}
};
template <class Epi, class Sched, bool ALIGN_EPI = false, bool SP2 = false>
__device__ __forceinline__ void gemm_phase(PG8_LAS unsigned char* lds, const Gemm g, const Sched& S, const Epi& E) {
    int tid_ = threadIdx.x; asm volatile("" : "+v"(tid_));
    const int tid = tid_, wid = __builtin_amdgcn_readfirstlane(tid >> 6), lane = tid & 63, wr = wid >> 2, wc = wid & 3, fr = lane & 15, fq = lane >> 4;
    const int K = g.K, nt = K / BK;
    unsigned voffA[2], voffB[2];
#pragma unroll
    for (int i = 0; i < 2; ++i) { int R, C; stage_rc(tid * 16 + i * 8192, R, C); const int Rb = Epi::PERM ? ((R & ~31) + perm32(R & 31)) : R;
        voffA[i] = (unsigned)(R * K + C) * 2u; voffB[i] = (unsigned)(Rb * K + C) * 2u; }
    const size_t kstep = (size_t)(BK * 2);
    const size_t hstep = (size_t)HALF * K * 2;
    const size_t tstep = 2 * hstep;
    const unsigned ldsw = (unsigned)wid * 1024u;
    const int aoff = lds_byte(wr * 64 + fr, fq * 8), boff = lds_byte(wc * 32 + fr, fq * 8);
#define PG8_SA(b, h) (((b) * 2 + (h)) * HTB)
#define PG8_SB(b, h) ((4 + (b) * 2 + (h)) * HTB)
#define PG8_STAGE(bufoff, gbase, voff) do { _Pragma("unroll") for (int _i = 0; _i < 2; ++_i) \
        __builtin_amdgcn_global_load_lds((const unsigned*)((const char*)(gbase) + (voff)[_i]), (PG8_LAS unsigned*)(lds + (bufoff) + ldsw + _i * 8192), 16, 0, 0); } while (0)
#define PG8_LDA(dst, b, h) do { _Pragma("unroll") for (int m = 0; m < 4; ++m) _Pragma("unroll") for (int k = 0; k < 2; ++k) dst[m][k] = *(const PG8_LAS bf16x8*)(lds + PG8_SA(b, h) + aoff + m * 2048 + k * 1024); } while (0)
#define PG8_LDB(dst, b, h) do { _Pragma("unroll") for (int n = 0; n < 2; ++n) _Pragma("unroll") for (int k = 0; k < 2; ++k) dst[n][k] = *(const PG8_LAS bf16x8*)(lds + PG8_SB(b, h) + boff + n * 2048 + k * 1024); } while (0)
#define PG8_MMA(ai, bj, At, Bt) do { __builtin_amdgcn_s_setprio(1); _Pragma("unroll") for (int m = 0; m < 4; ++m) _Pragma("unroll") for (int n = 0; n < 2; ++n) _Pragma("unroll") for (int k = 0; k < 2; ++k) \
        acc[ai][bj][m][n] = __builtin_amdgcn_mfma_f32_16x16x32_bf16(Bt[n][k], At[m][k], acc[ai][bj][m][n], 0, 0, 0); __builtin_amdgcn_s_setprio(0); } while (0)
#define PG8_WAIT_V(n) asm volatile("s_waitcnt vmcnt(" #n ")" ::: "memory")
#define PG8_WAIT_L(n) asm volatile("s_waitcnt lgkmcnt(" #n ")" ::: "memory")
#define PG8_BAR __builtin_amdgcn_s_barrier()
#define PG8_SCHED __builtin_amdgcn_sched_barrier(0)
    Unit cur, nxt; int ui = 0;
    if (!S.next(0, cur)) return;
    f32x4 acc[2][2][4][2];
#pragma unroll
    for (int a = 0; a < 2; ++a)
#pragma unroll
        for (int b = 0; b < 2; ++b)
#pragma unroll
            for (int m = 0; m < 4; ++m)
#pragma unroll
                for (int n = 0; n < 2; ++n) acc[a][b][m][n] = (f32x4){0.f, 0.f, 0.f, 0.f};
    bf16x8 At[4][2], B0[2][2], B1[2][2];
    const char* cA = (const char*)g.A + (size_t)cur.pm * tstep; const char* cB = (const char*)g.Bt + (size_t)cur.pn * tstep;
    S.a_ready(cur);
    if constexpr (SP2) {
        PG8_STAGE(PG8_SB(0, 0), cB, voffB); PG8_STAGE(PG8_SB(0, 1), cB + hstep, voffB); PG8_STAGE(PG8_SA(0, 0), cA, voffA); PG8_STAGE(PG8_SA(0, 1), cA + hstep, voffA);
        if (wr == 1) PG8_BAR;
        PG8_WAIT_V(2); PG8_BAR;
        PG8_STAGE(PG8_SB(1, 0), cB + kstep, voffB); PG8_STAGE(PG8_SA(1, 0), cA + kstep, voffA); PG8_STAGE(PG8_SB(1, 1), cB + hstep + kstep, voffB);
        PG8_WAIT_V(6); PG8_BAR;
    } else {
        PG8_STAGE(PG8_SB(0, 0), cB, voffB); PG8_STAGE(PG8_SA(0, 0), cA, voffA); PG8_STAGE(PG8_SB(0, 1), cB + hstep, voffB); PG8_STAGE(PG8_SA(0, 1), cA + hstep, voffA);
        if (wr == 1) PG8_BAR;
        PG8_WAIT_V(4); PG8_BAR;
        PG8_STAGE(PG8_SB(1, 0), cB + kstep, voffB); PG8_STAGE(PG8_SA(1, 0), cA + kstep, voffA); PG8_STAGE(PG8_SB(1, 1), cB + hstep + kstep, voffB);
        PG8_WAIT_V(6); PG8_BAR;
    }
    for (;;) {
        const bool has_next = S.next(ui + 1, nxt);
        const char* nA = has_next ? (const char*)g.A + (size_t)nxt.pm * tstep : cA; const char* nB = has_next ? (const char*)g.Bt + (size_t)nxt.pn * tstep : cB;
        for (int t = 0; t < nt; t += 2) {
            const bool last = (t == nt - 2);
            const char* a1 = cA + (size_t)(t + 1) * kstep;
            const char* a2 = last ? nA : cA + (size_t)(t + 2) * kstep; const char* b2 = last ? nB : cB + (size_t)(t + 2) * kstep;
            const char* a3 = a2 + kstep; const char* b3 = b2 + kstep;
            if (last && has_next) S.a_ready(nxt);
            if constexpr (SP2) {
            PG8_LDB(B0, 0, 0); PG8_LDB(B1, 0, 1); PG8_SCHED; PG8_LDA(At, 0, 0); PG8_STAGE(PG8_SA(1, 1), a1 + hstep, voffA);
            PG8_WAIT_V(8); PG8_WAIT_L(0); PG8_BAR; PG8_MMA(0, 0, At, B0); PG8_MMA(0, 1, At, B1); PG8_BAR; PG8_SCHED;
            PG8_LDA(At, 0, 1); PG8_STAGE(PG8_SB(0, 0), b2, voffB); PG8_STAGE(PG8_SB(0, 1), b2 + hstep, voffB); PG8_STAGE(PG8_SA(0, 0), a2, voffA);
            PG8_WAIT_V(8); PG8_WAIT_L(0); PG8_BAR; PG8_MMA(1, 0, At, B0); PG8_MMA(1, 1, At, B1); PG8_BAR; PG8_SCHED;
            PG8_LDB(B0, 1, 0); PG8_LDB(B1, 1, 1); PG8_SCHED; PG8_LDA(At, 1, 0); PG8_STAGE(PG8_SA(0, 1), a2 + hstep, voffA);
            PG8_WAIT_V(8); PG8_WAIT_L(0); PG8_BAR; PG8_MMA(0, 0, At, B0); PG8_MMA(0, 1, At, B1); PG8_BAR; PG8_SCHED;
            PG8_LDA(At, 1, 1); PG8_STAGE(PG8_SB(1, 0), b3, voffB); PG8_STAGE(PG8_SB(1, 1), b3 + hstep, voffB); PG8_STAGE(PG8_SA(1, 0), a3, voffA);
            PG8_WAIT_V(8); PG8_WAIT_L(0); PG8_BAR; PG8_MMA(1, 0, At, B0); PG8_MMA(1, 1, At, B1); PG8_BAR; PG8_SCHED;
            } else {
            PG8_LDB(B0, 0, 0); PG8_SCHED; PG8_LDA(At, 0, 0); PG8_STAGE(PG8_SA(1, 1), a1 + hstep, voffA);
            PG8_WAIT_L(8); PG8_BAR; PG8_WAIT_L(0); PG8_MMA(0, 0, At, B0); PG8_BAR; PG8_SCHED;
            PG8_LDB(B1, 0, 1); PG8_STAGE(PG8_SB(0, 0), b2, voffB);
            PG8_BAR; PG8_WAIT_L(0); PG8_MMA(0, 1, At, B1); PG8_BAR;
            PG8_LDA(At, 0, 1); PG8_STAGE(PG8_SA(0, 0), a2, voffA);
            PG8_BAR; PG8_WAIT_L(0); PG8_MMA(1, 0, At, B0); PG8_BAR; PG8_SCHED;
            PG8_STAGE(PG8_SB(0, 1), b2 + hstep, voffB);
            PG8_WAIT_V(6); PG8_BAR; PG8_MMA(1, 1, At, B1); PG8_BAR;
            PG8_LDB(B0, 1, 0); PG8_SCHED; PG8_LDA(At, 1, 0); PG8_STAGE(PG8_SA(0, 1), a2 + hstep, voffA);
            PG8_WAIT_L(8); PG8_BAR; PG8_WAIT_L(0); PG8_MMA(0, 0, At, B0); PG8_BAR; PG8_SCHED;
            PG8_LDB(B1, 1, 1); PG8_STAGE(PG8_SB(1, 0), b3, voffB);
            PG8_BAR; PG8_WAIT_L(0); PG8_MMA(0, 1, At, B1); PG8_BAR;
            PG8_LDA(At, 1, 1); PG8_STAGE(PG8_SA(1, 0), a3, voffA);
            PG8_BAR; PG8_WAIT_L(0); PG8_MMA(1, 0, At, B0); PG8_BAR; PG8_SCHED;
            PG8_STAGE(PG8_SB(1, 1), b3 + hstep, voffB);
            PG8_WAIT_V(6); PG8_BAR; PG8_MMA(1, 1, At, B1); PG8_BAR;
            }
        }
        if constexpr (ALIGN_EPI) { if (wr == 0) PG8_BAR; }
        if constexpr (!Epi::AFTER_DRAIN) { E(acc, cur, wr, wc, fr, fq); S.done(cur); }
        if (!has_next) break;
#pragma unroll
        for (int a = 0; a < 2; ++a)
#pragma unroll
            for (int b = 0; b < 2; ++b)
#pragma unroll
                for (int m = 0; m < 4; ++m)
#pragma unroll
                    for (int n = 0; n < 2; ++n) acc[a][b][m][n] = (f32x4){0.f, 0.f, 0.f, 0.f};
        cur = nxt; cA = nA; cB = nB; ++ui;
        if constexpr (ALIGN_EPI) { if (wr == 1) PG8_BAR; }
    }
    PG8_WAIT_V(0);
    if constexpr (!ALIGN_EPI) { if (wr == 0) PG8_BAR; }
    PG8_BAR;
    if constexpr (Epi::AFTER_DRAIN) { E.fused(acc, cur, wr, wc, fr, fq, lds, wid, lane); S.done(cur); }
#undef PG8_SA
#undef PG8_SB
#undef PG8_STAGE
#undef PG8_LDA
#undef PG8_LDB
#undef PG8_MMA
#undef PG8_WAIT_V
#undef PG8_WAIT_L
#undef PG8_BAR
#undef PG8_SCHED
}
struct MoeCtx { const bf16_t* H; const int* rlist; const float* Wup; const float* Wdn; int NUP, NU; };
template <bool IS_UP, class Epi>
__device__ __forceinline__ void moe_unit(PG8_LAS unsigned char* lds, const bf16_t* A, const int* rlist, const float* W, const PG8_LAS int* tab, const int t, const int j, const Epi& E,
                                         f32x4 (&wv)[8], bool& wpre, const MoeCtx& X, int nxt_reg, volatile PG8_LAS int* slot, int& Ln) {
    constexpr int MT_OFF = 0, MT_CNT = 33, MT_TILE = 66, CAP = 9216;
    constexpr int K = IS_UP ? 2048 : 512, NSUB = IS_UP ? 4 : 8, NT = K / 64, WN = IS_UP ? 1024 : 2048;
    int tid_ = threadIdx.x; asm volatile("" : "+v"(tid_));
    const int tid = tid_, wid = __builtin_amdgcn_readfirstlane(tid >> 6), lane = tid & 63, wr = wid >> 2, wc = wid & 3, fr = lane & 15, fq = lane >> 4;
    const int key = (fr >> 1) & 7;
    const int arow = 64 * wr + fr, brow = 32 * wc + fr;
    const int ch0 = ((fq) ^ key) << 4, ch1 = ((fq + 4) ^ key) << 4;
    int bwo[4];
    const int achunk = ((tid & 7) ^ ((tid >> 4) & 7)) << 4;
#pragma unroll
    for (int cc = 0; cc < 4; ++cc) { const int rho = 32 * (lane >> 3) + 16 * (lane & 1) + 4 * ((lane >> 1) & 3) + cc; bwo[cc] = rho * 128 + ((wid ^ ((rho >> 1) & 7) ^ ((rho >> 4) & 1)) << 4); }
    int e = 0, eoff = 0, ecnt = 0; const char* agp[4] = {nullptr, nullptr, nullptr, nullptr}; const float* wg = nullptr;
#define MG_UNIT() do { { \
        e = __builtin_amdgcn_readfirstlane(tab[MT_TILE + t]); eoff = __builtin_amdgcn_readfirstlane(tab[MT_OFF + e]); ecnt = __builtin_amdgcn_readfirstlane(tab[MT_CNT + e]); \
        _Pragma("unroll") for (int p = 0; p < 4; ++p) { const int sr = t * 256 + (tid >> 3) + 64 * p, li = sr - eoff;     \
            const size_t ar_ = IS_UP ? (size_t)((li < ecnt) ? rlist[e * CAP + li] : 0) : (size_t)sr; agp[p] = (const char*)(A + ar_ * K) + achunk; } \
        wg = W + (size_t)e * K * WN + (size_t)(8 * wid) * WN + (IS_UP ? ((lane < 32) ? j * 128 + 4 * lane : 512 + j * 128 + 4 * (lane - 32)) : j * 256 + 4 * lane); } } while (0)
#define MG_LOADA(kt, buf) do { _Pragma("unroll") for (int p = 0; p < 4; ++p) \
            __builtin_amdgcn_global_load_lds((const unsigned*)(agp[p] + (kt) * 128), (PG8_LAS unsigned*)(lds + (buf) * 32768 + (64 * p + 8 * wid) * 128), 16, 0, 0); } while (0)
#define MG_LOAD(kt, buf) do { MG_LOADA(kt, buf); \
        _Pragma("unroll") for (int i = 0; i < 8; ++i) wv[i] = *(const f32x4*)(wg + (size_t)((kt) * 64 + i) * WN); } while (0)
#define MG_WRITE(buf) do { PG8_LAS unsigned char* bb_ = lds + 65536 + (buf) * 32768; \
        _Pragma("unroll") for (int cc = 0; cc < 4; ++cc) { u32x4 o; o.x = cvt_pk_bf16(wv[0][cc], wv[1][cc]); o.y = cvt_pk_bf16(wv[2][cc], wv[3][cc]); o.z = cvt_pk_bf16(wv[4][cc], wv[5][cc]); o.w = cvt_pk_bf16(wv[6][cc], wv[7][cc]); \
            *(PG8_LAS u32x4*)(bb_ + bwo[cc]) = o; } } while (0)
    MG_UNIT();
    MG_LOADA(0, 0);
    if (!wpre) { _Pragma("unroll") for (int i = 0; i < 8; ++i) wv[i] = *(const f32x4*)(wg + (size_t)i * WN); }
    {
        f32x4 acc[2][2][4][2];
#pragma unroll
        for (int a = 0; a < 2; ++a)
#pragma unroll
            for (int b = 0; b < 2; ++b)
#pragma unroll
                for (int m = 0; m < 4; ++m)
#pragma unroll
                    for (int n = 0; n < 2; ++n) acc[a][b][m][n] = (f32x4){0.f, 0.f, 0.f, 0.f};
        MG_WRITE(0);
        asm volatile("s_waitcnt vmcnt(0)" ::: "memory");
        __syncthreads();
#pragma unroll 1
        for (int kt = 0; kt < NT; ++kt) {
            const int cur = kt & 1;
            if (kt + 1 < NT) MG_LOAD(kt + 1, cur ^ 1);
            __builtin_amdgcn_sched_barrier(0);
            __builtin_amdgcn_s_setprio(1);
            { const PG8_LAS unsigned char* ab = lds + cur * 32768; const PG8_LAS unsigned char* bb = lds + 65536 + cur * 32768;
#pragma unroll
              for (int k = 0; k < 2; ++k) { const int chk = k ? ch1 : ch0;
                  bf16x8 Bf[2][2];
#pragma unroll
                  for (int bj = 0; bj < 2; ++bj)
#pragma unroll
                      for (int n = 0; n < 2; ++n) Bf[bj][n] = *(const PG8_LAS bf16x8*)(bb + (128 * bj + 16 * n + brow) * 128 + (n ? chk ^ 16 : chk));
                  bf16x8 Ac = *(const PG8_LAS bf16x8*)(ab + arow * 128 + chk), An = *(const PG8_LAS bf16x8*)(ab + (16 + arow) * 128 + chk);
#pragma unroll
                  for (int im = 0; im < 8; ++im) { const int ai = im >> 2, m = im & 3; bf16x8 Af = An;
                      if (im + 2 < 8) Af = *(const PG8_LAS bf16x8*)(ab + (128 * ((im + 2) >> 2) + 16 * ((im + 2) & 3) + arow) * 128 + chk);
                      __builtin_amdgcn_sched_barrier(0);
#pragma unroll
                      for (int bj = 0; bj < 2; ++bj)
#pragma unroll
                          for (int n = 0; n < 2; ++n) acc[ai][bj][m][n] = __builtin_amdgcn_mfma_f32_16x16x32_bf16(Bf[bj][n], Ac, acc[ai][bj][m][n], 0, 0, 0);
                      __builtin_amdgcn_sched_barrier(0);
                      Ac = An; An = Af; } } }
            __builtin_amdgcn_s_setprio(0);
            __builtin_amdgcn_sched_barrier(0);
            if (kt + 1 < NT) MG_WRITE(cur ^ 1);
            if (kt + 1 == NT && tid == 0) *slot = nxt_reg;
            asm volatile("s_waitcnt vmcnt(0)" ::: "memory");
            __syncthreads();
        }
        Ln = __builtin_amdgcn_readfirstlane(*slot); wpre = false;
        if (Ln < X.NU) { const bool nup = Ln < X.NUP; const int d_ = nup ? Ln : Ln - X.NUP, tn = nup ? (d_ >> 2) : (d_ >> 3), jn = nup ? (d_ & 3) : (d_ & 7);
            const int en = __builtin_amdgcn_readfirstlane(tab[MT_TILE + tn]);
            const float* wb = nup ? X.Wup + (size_t)en * 2048 * 1024 + (size_t)(8 * wid) * 1024 : X.Wdn + (size_t)en * 512 * 2048 + (size_t)(8 * wid) * 2048;
            const int wst = nup ? 1024 : 2048, wof = nup ? ((lane < 32) ? jn * 128 + 4 * lane : 512 + jn * 128 + 4 * (lane - 32)) : jn * 256 + 4 * lane;
            const float* wn = wb + wof;
            _Pragma("unroll") for (int i = 0; i < 8; ++i) wv[i] = *(const f32x4*)(wn + (size_t)i * wst);
            wpre = true; }
        const Unit u{t, j}; const float* gbase = nullptr; if constexpr (IS_UP) gbase = E.gate + (size_t)e * CAP - eoff;
        if constexpr (IS_UP) { Epi E2 = E; E2.gate = gbase; E2(acc, u, wr, wc, fr, fq); }
        else E(acc, u, wr, wc, fr, fq);
    }
#undef MG_UNIT
#undef MG_LOAD
#undef MG_LOADA
#undef MG_WRITE
}
}
#define LAS __attribute__((address_space(3)))
#define XB_TMO      128
#define XB_XCNT(j)  (256  + 64 * (j))
#define XB_XSUB(j)  (1280 + 64 * (j))
#define XB_XGEN(j)  (2304 + 64 * (j))
#define XB_TOP      3328
#define XB_TOPGEN   3392
#define XCD_BAR_WORDS 3456
#define XB_SPIN_CAP (1u << 18)

__device__ __forceinline__ unsigned xb_ld(unsigned* p)              { return __hip_atomic_load(p, __ATOMIC_RELAXED, __HIP_MEMORY_SCOPE_AGENT); }
__device__ __forceinline__ unsigned xb_add(unsigned* p, unsigned v) { return __hip_atomic_fetch_add(p, v, __ATOMIC_RELAXED, __HIP_MEMORY_SCOPE_AGENT); }
__device__ __forceinline__ unsigned xb_xcc_id() { return (unsigned)__builtin_amdgcn_s_getreg((3 << 11) | 20) & 0xFu; }
#define XB_SPIN(cond, bar) do { unsigned _sp = 0; while (cond) { __builtin_amdgcn_s_sleep(1); \
    if ((++_sp & 255u) == 0u) { if (xb_ld(&(bar)[XB_TMO])) break; if (_sp > XB_SPIN_CAP) { atomicAdd(&(bar)[XB_TMO], 1u); break; } } } } while (0)

struct XcdBarrier {
    unsigned* bar; unsigned x;
    volatile LAS unsigned* st;
};

__device__ __forceinline__ XcdBarrier xcd_barrier_post(unsigned* bar, volatile LAS unsigned* st) {
    XcdBarrier b; b.bar = bar; b.x = xb_xcc_id(); b.st = st;
    if (threadIdx.x == 0) (void)xb_add(&bar[XB_XCNT(b.x)], 1u);
    return b;
}
__device__ __forceinline__ void xcd_barrier_complete(unsigned* bar, unsigned x, unsigned& nloc, unsigned& nx) {
    const unsigned G = gridDim.x * gridDim.y * gridDim.z;
    unsigned sum, cnt, mine, sp = 0u;
    for (;;) {
        sum = 0u; cnt = 0u; mine = 0u;
#pragma unroll
        for (unsigned j = 0; j < 16; ++j) { const unsigned c = xb_ld(&bar[XB_XCNT(j)]); sum += c; cnt += (c > 0u) ? 1u : 0u; mine = (j == x) ? c : mine; }
        if (sum == G) break;
        __builtin_amdgcn_s_sleep(1);
        if ((++sp & 255u) == 0u) { if (xb_ld(&bar[XB_TMO])) break; if (sp > XB_SPIN_CAP) { atomicAdd(&bar[XB_TMO], 1u); break; } }
    }
    nloc = mine > 0u ? mine : 1u; nx = cnt > 0u ? cnt : 1u;
}

__device__ __forceinline__ void xcd_barrier(const XcdBarrier& b) {
    asm volatile("s_waitcnt vmcnt(0)" ::: "memory");
    __syncthreads();
    if (threadIdx.x == 0) {
        unsigned* bar = b.bar;
        __builtin_amdgcn_s_waitcnt(0);
        unsigned nloc = b.st[0], nx = b.st[1];
        if (nloc == 0u) { xcd_barrier_complete(bar, b.x, nloc, nx); b.st[0] = nloc; b.st[1] = nx; }
        const unsigned old = xb_add(&bar[XB_XSUB(b.x)], 1u);
        const unsigned gen = old / nloc;
        if (old + 1u == (gen + 1u) * nloc) {
            __builtin_amdgcn_fence(__ATOMIC_RELEASE, "agent");
            asm volatile("s_waitcnt vmcnt(0)" ::: "memory");
            const unsigned og = xb_add(&bar[XB_TOP], 1u);
            const unsigned tg = og / nx;
            if (og + 1u == (tg + 1u) * nx) xb_add(&bar[XB_TOPGEN], 1u);
            else XB_SPIN(xb_ld(&bar[XB_TOPGEN]) == tg, bar);
            __builtin_amdgcn_fence(__ATOMIC_ACQUIRE, "agent");
            xb_add(&bar[XB_XGEN(b.x)], 1u);
            asm volatile("s_waitcnt vmcnt(0)" ::: "memory");
        } else {
            XB_SPIN(xb_ld(&bar[XB_XGEN(b.x)]) == gen, bar);
            __builtin_amdgcn_fence(__ATOMIC_ACQUIRE, "agent");
            asm volatile("s_waitcnt vmcnt(0)" ::: "memory");
        }
    }
    __syncthreads();
}
constexpr int DM = 2048, NB = 4, SEQ = 2048, CTXL = 256, TLAT = NB * SEQ, TCTX = NB * CTXL, TTOT = TLAT + TCTX;
constexpr int INC = 6176, INCP = 6400;
constexpr int C_HY = 0, C_NQ = 1536, C_NK = 2304, C_NV = 3072, C_GQ = 3840, C_GK = 4224, C_GV = 4608, C_GG = 5376, C_GA = 6144;
constexpr int M_NA = 512, M_GLA = 1280;
constexpr int HYC = 512, NAH = 6, GH = 6;
constexpr int NEXP = 32, DEXP = 512;
constexpr int NLAYER = 2;
constexpr float LN_EPS = 1e-6f;
constexpr float ALPHA = 1.41421356237f;
constexpr int MAXSLOTS = 26624;
constexpr int GSTEPS = 36;

constexpr size_t MiB = 1u << 20;
constexpr size_t WS_CTL = 0, CTL_ZERO_BYTES = 64 * 1024;
constexpr size_t WS_WIN = 2 * MiB;
constexpr size_t WS_WOUT = 52 * MiB;
constexpr size_t WS_WUP = 68 * MiB;
constexpr size_t WS_WDN = 324 * MiB;
constexpr size_t WS_KF = 452 * MiB;
constexpr size_t WS_KFC = 468 * MiB;
constexpr size_t WS_WRT = 469 * MiB;
constexpr size_t WS_H = 470 * MiB;
constexpr size_t WS_PROJ = 506 * MiB;
constexpr size_t WS_MIX = 620 * MiB;
constexpr size_t WS_Y = 656 * MiB;
constexpr size_t WS_X1 = 728 * MiB;
constexpr size_t WS_X2 = 800 * MiB;
constexpr size_t WS_XG = 872 * MiB;
constexpr size_t WS_ACT = 976 * MiB;
constexpr size_t WS_ACT1 = 68 * MiB;
constexpr size_t WS_DN = 1002 * MiB;
constexpr size_t WS_ST = 1106 * MiB;
constexpr size_t WS_DEC = 1160 * MiB;
constexpr size_t WS_ASG = 1161 * MiB;
constexpr size_t WS_SLOT = 1162 * MiB;
constexpr size_t WS_GATE = 1162 * MiB + 512 * 1024;
constexpr size_t WS_TILE = 1163 * MiB;
constexpr size_t WS_VTL = 1164 * MiB;
constexpr size_t WS_VTC = 1177 * MiB;
constexpr size_t WS_KTL = 1206 * MiB;
constexpr size_t WS_KTC = 1219 * MiB;
constexpr size_t WS_ZT = 1179 * MiB;
constexpr size_t WS_X0T = 1187 * MiB;
constexpr size_t WS_YT = 1195 * MiB;
constexpr size_t WS_ZTC = 1203 * MiB, WS_X0TC = 1204 * MiB, WS_YTC = 1205 * MiB;
constexpr size_t WS_CF = 1221 * MiB;
constexpr size_t WS_END = 1250 * MiB;
constexpr int CW_BAR = 4096;
constexpr int CW_CNT = 8192;
constexpr int CW_MOD = 65536;

constexpr int RING_BYTES = 131072;
constexpr int LDSCTL_OFF = 143360, LDS_BYTES = 147456;
constexpr int NWAVES = 8, NTHR = 512;


typedef unsigned short bf16;
typedef unsigned v4u __attribute__((ext_vector_type(4)));
typedef unsigned v2u __attribute__((ext_vector_type(2)));
typedef float f32x4 __attribute__((ext_vector_type(4)));
typedef short bf16x8 __attribute__((ext_vector_type(8)));
#define LDS_WAIT() asm volatile("s_waitcnt lgkmcnt(0)" ::: "memory")
__device__ __forceinline__ unsigned f2bf(float f) { unsigned u = __builtin_bit_cast(unsigned, f); return (u + 0x7fffu + ((u >> 16) & 1u)) >> 16; }
__device__ __forceinline__ unsigned pk2(float lo, float hi) { return f2bf(lo) | (f2bf(hi) << 16); }
__device__ __forceinline__ float bf2f(unsigned short b) { return __builtin_bit_cast(float, (unsigned)b << 16); }
__device__ __forceinline__ float bflo(unsigned w) { return __builtin_bit_cast(float, w << 16); }
__device__ __forceinline__ float bfhi(unsigned w) { return __builtin_bit_cast(float, w & 0xffff0000u); }
__device__ __forceinline__ float wave_sum(float v) {
#pragma unroll
    for (int o = 1; o < 64; o <<= 1) v += __shfl_xor(v, o);
    return v;
}
__device__ __forceinline__ float wave_max(float v) {
#pragma unroll
    for (int o = 1; o < 64; o <<= 1) v = fmaxf(v, __shfl_xor(v, o));
    return v;
}
__device__ __forceinline__ float silu_f(float x) { return x / (1.0f + __expf(-x)); }
__device__ __forceinline__ float logsigmoid_f(float z) { return fminf(z, 0.f) - __logf(1.0f + __expf(-fabsf(z))); }

#define KAS __attribute__((address_space(4)))
#define GAS __attribute__((address_space(1)))
#define RELAUNDER(F) do { asm volatile("" : "+s"(F.ws), "+s"(F.in)); asm volatile("" : "+v"(F.tid)); F.lane = F.tid & 63; F.wave = __builtin_amdgcn_readfirstlane(F.tid >> 6); F.ctl = (GAS unsigned*)F.ws; } while (0)
#define INP(i) ((const float*)F.in[i])
struct Fr {
    LAS unsigned char* lds;
    int tid, lane, wave, G, bid;
    const GAS float* const KAS* in;
    GAS float* out; GAS unsigned char* ws;
    GAS unsigned* ctl;
};
#define IN_X 0
#define IN_C 1
#define IN_CTX 2
#define IN_CCTX 3
#define IN_WADA 4
#define IN_BADA 5
#define IN_WIN 6
#define IN_HYSW 7
#define IN_HYSB 8
#define IN_HYW1 9
#define IN_HYB1 10
#define IN_HYW2 11
#define IN_HYB2 12
#define IN_HYW3 13
#define IN_HYFR 14
#define IN_HYBIAS 15
#define IN_HYNW 16
#define IN_RPB 17
#define IN_NANW 18
#define IN_GAW2 19
#define IN_GAB 20
#define IN_GNW 21
#define IN_WOUT 22
#define IN_LN1G 23
#define IN_LN1B 24
#define IN_WRG 25
#define IN_BRG 26
#define IN_WRE 27
#define IN_BRE 28
#define IN_WUP 29
#define IN_WDN 30
#define IN_LN2G 31
#define IN_LN2B 32

__device__ __forceinline__ void transpose_item(const float* W, int ldw, bf16* WT, int ldt, int k0, int n0, int dst_row0, bool full, LAS float* scr, int lane) {
    const float* src = W + (size_t)k0 * ldw + n0 + lane; const bool ok = full || lane < 32;
    float v[64];
#pragma unroll
    for (int kk = 0; kk < 64; ++kk) v[kk] = ok ? __builtin_nontemporal_load(src + (size_t)kk * ldw) : 0.f;
#pragma unroll
    for (int kk = 0; kk < 64; ++kk) scr[kk * 65 + lane] = v[kk];
    LDS_WAIT(); asm volatile("" ::: "memory");
    const int c = lane & 7;
#pragma unroll
    for (int j = 0; j < 8; ++j) { const int n = (lane >> 3) + 8 * j; const LAS float* s = scr + (8 * c) * 65 + n;
        v4u o; o.x = pk2(s[0 * 65], s[1 * 65]); o.y = pk2(s[2 * 65], s[3 * 65]); o.z = pk2(s[4 * 65], s[5 * 65]); o.w = pk2(s[6 * 65], s[7 * 65]);
        if (full || n < 32) *(v4u*)(WT + (size_t)(dst_row0 + n) * ldt + k0 + 8 * c) = o; }
    LDS_WAIT(); asm volatile("" ::: "memory");
}

__device__ __forceinline__ void hy_filter_item(const Fr& F, int L, int l, int pb, float* KFo) {
    LAS float* zf = (LAS float*)F.lds;
    LAS float* h1 = zf + 32 * 33;
    LAS float* h2 = h1 + 32 * 64;
    const int n0 = pb * 32, tid = F.tid;
    const float* w1 = INP(IN_HYW1) + L * 33 * 64; const float* b1 = INP(IN_HYB1) + L * 64;
    const float* w2 = INP(IN_HYW2) + L * 64 * 64; const float* b2 = INP(IN_HYB2) + L * 64;
    const float* w3 = INP(IN_HYW3) + L * 64 * 1024; const float* fr = INP(IN_HYFR) + L * 64;
    const float tden = 1.0f / (float)(l - 1);
    for (int idx = tid; idx < 32 * 33; idx += NTHR) {
        const int p = idx / 33, i = idx - p * 33; const float n = (float)(n0 + p); float val;
        if (i == 0) val = n * tden;
        else { const int j = (i - 1) & 15; const float band = 1e-4f + (float)j * ((15.0f - 1e-4f) / 15.0f);
            float turns = n * band * (1.0f / (float)l); turns -= floorf(turns);
            const float ang = 6.283185307179586f * turns;
            val = (i <= 16) ? __cosf(ang) : -__sinf(ang); }
        zf[idx] = val;
    }
    __syncthreads();
    { const int j = tid & 63, pq = tid >> 6; const float frj = fr[j];
      { float wc[33];
#pragma unroll
        for (int i = 0; i < 33; ++i) wc[i] = w1[i * 64 + j];
        const float bj = b1[j];
#pragma unroll 1
        for (int k = 0; k < 4; ++k) { const int p = pq + 8 * k; float s = bj;
#pragma unroll
            for (int i = 0; i < 33; ++i) s += zf[p * 33 + i] * wc[i];
            h1[p * 64 + j] = __sinf(frj * s); } }
      __syncthreads();
      { float wc[64];
#pragma unroll
        for (int i = 0; i < 64; ++i) wc[i] = w2[i * 64 + j];
        const float bj = b2[j];
#pragma unroll 1
        for (int k = 0; k < 4; ++k) { const int p = pq + 8 * k; float s = bj;
#pragma unroll
            for (int i = 0; i < 64; ++i) s += h1[p * 64 + i] * wc[i];
            h2[p * 64 + j] = __sinf(frj * s); } }
      __syncthreads(); }
    const int c = tid;
    const float dmin = -3.0701134573253943f, dmax = -15.350567286626972f;
    const float delta = fabsf(dmin + (float)c * ((dmax - dmin) / 511.0f));
    const float hb = INP(IN_HYBIAS)[L * HYC + c];
#pragma unroll 1
    for (int dh = 0; dh < 4; ++dh) {
        const int dir = dh >> 1, p0 = (dh & 1) * 16; const int col = dir * 512 + c; float acc[16];
#pragma unroll
        for (int p = 0; p < 16; ++p) acc[p] = 0.f;
        float wv[64];
#pragma unroll
        for (int i = 0; i < 64; ++i) wv[i] = w3[i * 1024 + col];
#pragma unroll
        for (int i = 0; i < 64; ++i) { const float w = wv[i];
#pragma unroll
            for (int p = 0; p < 16; ++p) acc[p] += h2[(p0 + p) * 64 + i] * w;
            asm volatile("" : "+v"(acc[0]), "+v"(acc[1]), "+v"(acc[2]), "+v"(acc[3]), "+v"(acc[4]), "+v"(acc[5]), "+v"(acc[6]), "+v"(acc[7]));
            asm volatile("" : "+v"(acc[8]), "+v"(acc[9]), "+v"(acc[10]), "+v"(acc[11]), "+v"(acc[12]), "+v"(acc[13]), "+v"(acc[14]), "+v"(acc[15])); }
        LAS float* outl = (LAS float*)(F.lds + 32768);
#pragma unroll
        for (int p = 0; p < 16; ++p) { const int n = n0 + p0 + p; const float t = (float)n * tden; float v = acc[p] * __expf(-t * delta);
            if (dir == 0 && n == 0) v += hb;
            outl[c * 17 + p] = v; }
        __syncthreads();
#pragma unroll 4
        for (int k = 0; k < 16; ++k) { const int ch = (tid >> 4) + 32 * k, p = tid & 15, n = n0 + p0 + p; const float v = outl[ch * 17 + p]; float* kf = KFo + (size_t)ch * (2 * l);
            if (dir == 0) { kf[l + n] = v; if (n == 0) kf[0] = 0.f; }
            else if (n >= 1) kf[l - n] = v; }
        __syncthreads();
    }
    __syncthreads();
}

constexpr int I_IN = 32 * 97, I_OUT = 32 * 32, I_UP = 32 * 16, I_DN = 8 * 32;
constexpr int CONV_PER_LAYER = I_IN + I_OUT;
constexpr int CW_MQ = 12800, CW_DONE = 13312;
constexpr int CW_Q = 12288;
__device__ __forceinline__ void conv_item(const Fr& F, int L, int r, LAS float* scr) {
    const int lane = F.lane;
    bf16* WinT = (bf16*)(F.ws + WS_WIN); bf16* WoutT = (bf16*)(F.ws + WS_WOUT); bf16* WupT = (bf16*)(F.ws + WS_WUP); bf16* WdnT = (bf16*)(F.ws + WS_WDN);
    if (r < I_IN) { const int kb = r / 97, nb = r % 97;
        transpose_item(INP(IN_WIN) + (size_t)L * DM * INC, INC, WinT + (size_t)L * INCP * DM, DM, kb * 64, nb * 64, nb * 64, nb < 96, scr, lane); return; }
    r -= I_IN;
    if (r < I_OUT) { const int kb = r / 32, nb = r % 32;
        transpose_item(INP(IN_WOUT) + (size_t)L * DM * DM, DM, WoutT + (size_t)L * DM * DM, DM, kb * 64, nb * 64, nb * 64, true, scr, lane); return; }
    r -= I_OUT;
    if (r < NEXP * I_UP) { const int le = L * NEXP + r / I_UP, q = r % I_UP, kb = q / 16, nb = q % 16;
        const int n0 = nb * 64, bj = n0 / 512, rem = n0 % 512, j = rem / 128, cc = rem % 128;
        transpose_item(INP(IN_WUP) + (size_t)le * DM * 1024, 1024, WupT + (size_t)le * 1024 * DM, DM, kb * 64, n0, j * 256 + bj * 128 + cc, true, scr, lane); return; }
    r -= NEXP * I_UP;
    { const int le = L * NEXP + r / I_DN, q = r % I_DN, kb = q / 32, nb = q % 32;
        transpose_item(INP(IN_WDN) + (size_t)le * DEXP * DM, DM, WdnT + (size_t)le * DM * DEXP, DEXP, kb * 64, nb * 64, nb * 64, true, scr, lane); }
}
constexpr int CONV_Q_TOTAL = I_OUT + CONV_PER_LAYER;
__device__ __forceinline__ void conv_bubble(Fr F, int quota, int limit = -1) {
    RELAUNDER(F);
    LAS float* scr = (LAS float*)(F.lds + F.wave * 16640);
    LAS unsigned* slot = (LAS unsigned*)(F.lds + LDSCTL_OFF + 64);
    unsigned* q = (unsigned*)(F.ctl + CW_Q);
    for (int n = 0; quota < 0 || n < quota; ++n) {
        __syncthreads();
        if (F.tid == 0) { unsigned b_ = 0xffffffffu;
            if (limit < 0 || __hip_atomic_load(q, __ATOMIC_RELAXED, __HIP_MEMORY_SCOPE_AGENT) < (unsigned)limit) b_ = __hip_atomic_fetch_add(q, 32u, __ATOMIC_RELAXED, __HIP_MEMORY_SCOPE_AGENT);
            *slot = b_; }
        __syncthreads();
        const unsigned base = *slot;
        if (base >= (unsigned)CONV_Q_TOTAL) break;
#pragma unroll 1
        for (int j = 0; j < 4; ++j) { const unsigned it = base + 8 * j + F.wave;
            if (it < (unsigned)I_OUT) conv_item(F, 0, I_IN + (int)it, scr); else if (it < (unsigned)CONV_Q_TOTAL) conv_item(F, 1, (int)it - I_OUT, scr); }
    }
    __syncthreads();
}
#ifndef P0MASK
#define P0MASK 7
#endif
#ifndef REPMASK
#define REPMASK 0
#endif
__device__ __forceinline__ void mod_items(const Fr& F, int first, int step, int end) {
    const int lane = F.lane;
    __syncthreads();
    if (first >= end) return;
    float* MOD = (float*)(F.ctl + CW_MOD); LAS float* sc = (LAS float*)F.lds;
    LAS f32x4* part = (LAS f32x4*)(F.lds + 65536);
    for (int i = F.tid; i < 5 * DM; i += NTHR) { const int r = i / DM, k = i % DM; sc[k * 8 + r] = silu_f((r < 4) ? INP(IN_C)[r * DM + k] : INP(IN_CCTX)[k]); }
    __syncthreads();
    for (int it = first; it < end; it += step) {
          const int kg = (lane >= 24) ? 1 : 0, ln24 = lane - 24 * kg;
          const int L = it >> 7, col = (it & 127) * 96 + (lane < 48 ? ln24 : 0) * 4;
          const float* wp = INP(IN_WADA) + (size_t)L * DM * 12288 + (size_t)(F.wave * 256 + kg) * 12288 + col;
          f32x4 acc[5];
#pragma unroll
          for (int r = 0; r < 5; ++r) acc[r] = (f32x4){0.f, 0.f, 0.f, 0.f};
          if (lane < 48) {
#pragma unroll 16
              for (int k2 = 0; k2 < 128; ++k2) { const f32x4 w = __builtin_nontemporal_load((const f32x4*)(wp + (size_t)k2 * 2 * 12288));     const LAS float* sk = sc + (F.wave * 256 + 2 * k2 + kg) * 8;
                  const f32x4 s03 = *(const LAS f32x4*)sk; const float s4 = sk[4];
                  acc[0] += w * s03[0]; acc[1] += w * s03[1]; acc[2] += w * s03[2]; acc[3] += w * s03[3]; acc[4] += w * s4; }
#pragma unroll
              for (int r = 0; r < 5; ++r) part[((F.wave * 2 + kg) * 5 + r) * 24 + ln24] = acc[r]; }
          __syncthreads();
          for (int idx = F.tid; idx < 5 * 24; idx += NTHR) { const int r = idx / 24, ln = idx % 24; f32x4 sum = *(const f32x4*)(INP(IN_BADA) + L * 12288 + (it & 127) * 96 + ln * 4);
#pragma unroll
              for (int w = 0; w < 16; ++w) sum += part[(w * 5 + r) * 24 + ln];
              *(f32x4*)(MOD + (size_t)(L * 5 + r) * 12288 + (it & 127) * 96 + ln * 4) = sum; }
          __syncthreads();
    }
}

__device__ __forceinline__ void p0_prologue(Fr F) {
    RELAUNDER(F);
    LAS float* scr = (LAS float*)(F.lds + F.wave * 16640);
    const int gw = F.bid * NWAVES + F.wave, NGW = F.G * NWAVES, lane = F.lane;
    bf16* WinT = (bf16*)(F.ws + WS_WIN);
    const bool pdeal = (F.G == 256);
    { if (pdeal) { if (F.bid < 184) for (int it = gw; it < I_IN; it += 184 * NWAVES) conv_item(F, 0, it, scr); }
      else for (int it = gw; it < I_IN; it += NGW) conv_item(F, 0, it, scr); }
    for (int i = F.bid * NTHR + F.tid; i < NLAYER * (INCP - INC) * (DM * 2 / 16); i += F.G * NTHR) {
        const int L = i / ((INCP - INC) * 256), q = i % ((INCP - INC) * 256);
        ((v4u*)(WinT + (size_t)L * INCP * DM + (size_t)INC * DM))[q] = (v4u){0u, 0u, 0u, 0u}; }
    { bf16* WRH = (bf16*)(F.ws + WS_WRT); bf16* WRL = (bf16*)(F.ws + WS_WRT + 512 * 1024);
      for (int i = F.bid * NTHR + F.tid; i < NLAYER * 48 * DM; i += F.G * NTHR) { const int L = i / (48 * DM), q = i % (48 * DM), o = q / DM, k = q % DM;
          const float w = (o < 4) ? INP(IN_WRG)[(size_t)L * DM * 4 + k * 4 + o] : (o < 36) ? INP(IN_WRE)[(size_t)L * DM * 32 + k * 32 + (o - 4)] : 0.f;
          const unsigned hi = f2bf(w); WRH[i] = (bf16)hi; WRL[i] = (bf16)f2bf(w - __builtin_bit_cast(float, hi << 16)); } }
    if (pdeal) mod_items(F, (F.bid < 128) ? F.bid : NLAYER * 128, F.G, 128); else mod_items(F, F.bid, F.G, NLAYER * 128);
    __syncthreads();
    if (P0MASK & 4)
    for (int rep = 0; rep < 1 + ((REPMASK >> 13) & 1); ++rep)
    if (pdeal) { const int it = F.G - 1 - F.bid;
        if (it < 64) hy_filter_item(F, 0, SEQ, it, (float*)(F.ws + WS_KF));
        else if (it < 72) hy_filter_item(F, 0, CTXL, it - 64, (float*)(F.ws + WS_KFC));
    } else
    for (int it = F.G - 1 - F.bid; it < 136; it += F.G) {
        if (it < 128) { const int L = it >> 6; hy_filter_item(F, L, SEQ, it & 63, (float*)(F.ws + WS_KF) + (size_t)L * HYC * 4096); }
        else hy_filter_item(F, 0, CTXL, it - 128, (float*)(F.ws + WS_KFC));
    }
}

__device__ __forceinline__ const float* mod_ptr(const Fr& F, int L, int row) {
    const int r = row < TLAT ? (row >> 11) : 4; return (const float*)(F.ctl + CW_MOD) + (size_t)(L * 5 + r) * 12288;
}
__device__ __forceinline__ f32x4 load_x4(const Fr& F, int L, int row, int idx4) {
    if (L == 0) return *((const f32x4*)(row < TLAT ? INP(IN_X) + (size_t)row * DM : INP(IN_CTX) + (size_t)(row - TLAT) * DM) + idx4);
    const v2u w = *((const v2u*)((const bf16*)(F.ws + WS_X2) + (size_t)row * DM) + idx4); return (f32x4){bflo(w.x), bfhi(w.x), bflo(w.y), bfhi(w.y)};
}
__device__ __forceinline__ void p1_ln_mod(Fr F, int L) {
    RELAUNDER(F);
    const int gw = F.bid * NWAVES + F.wave, NGW = F.G * NWAVES, lane = F.lane;
    bf16* H = (bf16*)(F.ws + WS_H);
    for (int row = gw; row < TTOT; row += NGW) {
        const float* mod = mod_ptr(F, L, row);
        f32x4 v[8]; float s = 0.f;
#pragma unroll
        for (int j = 0; j < 8; ++j) { v[j] = load_x4(F, L, row, lane + 64 * j); s += (v[j][0] + v[j][1]) + (v[j][2] + v[j][3]); }
        const float mean = wave_sum(s) * (1.f / DM); float s2 = 0.f;
#pragma unroll
        for (int j = 0; j < 8; ++j) { v[j] = v[j] - mean; s2 += (v[j][0] * v[j][0] + v[j][1] * v[j][1]) + (v[j][2] * v[j][2] + v[j][3] * v[j][3]); }
        const float rstd = 1.f / sqrtf(wave_sum(s2) * (1.f / DM) + LN_EPS);
        v2u* o8 = (v2u*)(H + (size_t)row * DM) + lane;
#pragma unroll
        for (int j = 0; j < 8; ++j) { const f32x4 sh = *((const f32x4*)(mod) + lane + 64 * j), sc = *((const f32x4*)(mod + DM) + lane + 64 * j);
            const f32x4 h = v[j] * rstd * (sc + 1.0f) + sh; v2u w; w.x = pk2(h[0], h[1]); w.y = pk2(h[2], h[3]); o8[64 * j] = w; }
    }
}

__device__ __forceinline__ void hy_pre_item(const Fr& F, int L, int item, LAS bf16* zt, LAS bf16* xt) {
    const int lane = F.lane; const bf16* PROJ = (const bf16*)(F.ws + WS_PROJ);
    int cb, n0, bt, lseq, tokbase; bf16 *ZT, *X0T;
    if (item < 1024) { cb = item & 7; const int tb = item >> 3; bt = tb >> 5; n0 = (tb & 31) * 64; lseq = SEQ; tokbase = bt * SEQ; ZT = (bf16*)(F.ws + WS_ZT); X0T = (bf16*)(F.ws + WS_X0T); }
    else { const int it = item - 1024; cb = it & 7; const int tb = it >> 3; bt = tb >> 2; n0 = (tb & 3) * 64; lseq = CTXL; tokbase = TLAT + bt * CTXL; ZT = (bf16*)(F.ws + WS_ZTC); X0T = (bf16*)(F.ws + WS_X0TC); }
    const int q = lane & 7, c0 = cb * 64 + 8 * q;
    float wgt[3][3][8], bias[3][8];
#pragma unroll
    for (int j = 0; j < 3; ++j) {
#pragma unroll
        for (int e = 0; e < 8; ++e) bias[j][e] = INP(IN_HYSB)[L * 1536 + j * 512 + c0 + e];
#pragma unroll
        for (int t = 0; t < 3; ++t)
#pragma unroll
            for (int e = 0; e < 8; ++e) wgt[j][t][e] = INP(IN_HYSW)[(L * 3 + t) * 1536 + j * 512 + c0 + e]; }
#pragma unroll 4
    for (int it = 0; it < 8; ++it) { const int tl = (lane >> 3) + 8 * it, n = n0 + tl; const bf16* rowp = PROJ + (size_t)(tokbase + n) * INCP + c0;
        float sj[3][8];
#pragma unroll
        for (int j = 0; j < 3; ++j) { const v4u z4 = (v4u){0u, 0u, 0u, 0u};
            const v4u rm = (n > 0) ? *(const v4u*)(rowp - INCP + j * 512) : z4, r0 = *(const v4u*)(rowp + j * 512), rp = (n < lseq - 1) ? *(const v4u*)(rowp + INCP + j * 512) : z4;
            const unsigned am[4] = {rm.x, rm.y, rm.z, rm.w}, a0[4] = {r0.x, r0.y, r0.z, r0.w}, ap[4] = {rp.x, rp.y, rp.z, rp.w};
#pragma unroll
            for (int e2 = 0; e2 < 4; ++e2) {
                sj[j][2 * e2] = wgt[j][0][2 * e2] * bflo(am[e2]) + wgt[j][1][2 * e2] * bflo(a0[e2]) + wgt[j][2][2 * e2] * bflo(ap[e2]) + bias[j][2 * e2];
                sj[j][2 * e2 + 1] = wgt[j][0][2 * e2 + 1] * bfhi(am[e2]) + wgt[j][1][2 * e2 + 1] * bfhi(a0[e2]) + wgt[j][2][2 * e2 + 1] * bfhi(ap[e2]) + bias[j][2 * e2 + 1]; } }
#pragma unroll
        for (int e = 0; e < 8; ++e) { zt[(8 * q + e) * 66 + tl] = (bf16)f2bf(sj[1][e] * sj[2][e]); xt[(8 * q + e) * 66 + tl] = (bf16)f2bf(sj[0][e]); } }
    LDS_WAIT(); asm volatile("" ::: "memory");
#pragma unroll 4
    for (int ch = 0; ch < 64; ++ch) { const size_t o = ((size_t)(cb * 64 + ch) * 4 + bt) * lseq + n0 + lane; ZT[o] = zt[ch * 66 + lane]; X0T[o] = xt[ch * 66 + lane]; }
    LDS_WAIT(); asm volatile("" ::: "memory");
}

template <int LSEQ>
__device__ __forceinline__ void hy_conv_item(const Fr& F, int c, const float* kfg, const bf16* ZT, const bf16* X0T, bf16* YT) {
    constexpr int CPLEN = 2 * LSEQ + 16, YOFF = LSEQ, ZOFF = 192, ZLEN = LSEQ + 416, NW = LSEQ / 256, NKS = (LSEQ + 192) / 32;
    LAS bf16* CP = (LAS bf16*)F.lds;
    LAS bf16* Z = CP + 8 * CPLEN;
    const int tid = F.tid;
#pragma unroll 8
    for (int idx = tid; idx < 8 * CPLEN; idx += NTHR) { const int sft = idx / CPLEN, y = idx - sft * CPLEN, k = 2 * LSEQ + sft - y;
        CP[idx] = (bf16)((k >= 1 && k <= 2 * LSEQ - 1) ? f2bf(kfg[k]) : 0u); }
#pragma unroll 3
    for (int idx = tid; idx < 4 * ZLEN / 8; idx += NTHR) { const int bt = idx / (ZLEN / 8), p8 = (idx - bt * (ZLEN / 8)) * 8, n = p8 - ZOFF;
        v4u v = (v4u){0u, 0u, 0u, 0u}; if (n >= 0 && n < LSEQ) v = *(const v4u*)(ZT + ((size_t)c * 4 + bt) * LSEQ + n);
        *(LAS v4u*)(Z + bt * ZLEN + p8) = v; }
    __syncthreads();
    if (F.wave < NW) {
        const int lane = F.lane, r16 = lane & 15, g = lane >> 4, a0 = 4 * F.wave, a = a0 + (r16 >> 2), bt = r16 & 3, jlo = -64 * (a0 + 3);
        const LAS bf16* ap = CP + (r16 & 7) * CPLEN + YOFF + jlo + 8 * g - 8 * (r16 >> 3);
        const LAS bf16* bp = Z + bt * ZLEN + ZOFF + 64 * a + jlo + 8 * g;
        f32x4 acc[4];
#pragma unroll
        for (int mb = 0; mb < 4; ++mb) acc[mb] = (f32x4){0.f, 0.f, 0.f, 0.f};
        bf16x8 T0 = *(const LAS bf16x8*)(ap), T1 = *(const LAS bf16x8*)(ap - 16), T2 = *(const LAS bf16x8*)(ap - 32), T3 = *(const LAS bf16x8*)(ap - 48);
#pragma unroll 2
        for (int ks = 0; ks < NKS; ++ks) {
            const bf16x8 B = *(const LAS bf16x8*)(bp + 32 * ks);
            acc[0] = __builtin_amdgcn_mfma_f32_16x16x32_bf16(T0, B, acc[0], 0, 0, 0); acc[1] = __builtin_amdgcn_mfma_f32_16x16x32_bf16(T1, B, acc[1], 0, 0, 0);
            acc[2] = __builtin_amdgcn_mfma_f32_16x16x32_bf16(T2, B, acc[2], 0, 0, 0); acc[3] = __builtin_amdgcn_mfma_f32_16x16x32_bf16(T3, B, acc[3], 0, 0, 0);
            T2 = T0; T3 = T1; T0 = *(const LAS bf16x8*)(ap + 32 * (ks + 1)); T1 = *(const LAS bf16x8*)(ap + 32 * (ks + 1) - 16);
        }
        const size_t rowo = ((size_t)c * 4 + bt) * LSEQ + 64 * a + 4 * g;
#pragma unroll
        for (int mb = 0; mb < 4; ++mb) { const v2u xw = *(const v2u*)(X0T + rowo + 16 * mb);
            v2u o; o.x = pk2(acc[mb][0] * bflo(xw.x), acc[mb][1] * bfhi(xw.x)); o.y = pk2(acc[mb][2] * bflo(xw.y), acc[mb][3] * bfhi(xw.y));
            *(v2u*)(YT + rowo + 16 * mb) = o; }
    }
    __syncthreads();
}

__device__ __forceinline__ void hy_post_item(const Fr& F, int L, int item) {
    const int lane = F.lane, w = F.wave;
    int bt, n0, lseq, tokbase; const bf16* YT;
    if (item < 128) { bt = item >> 5; n0 = (item & 31) * 64; lseq = SEQ; tokbase = bt * SEQ; YT = (const bf16*)(F.ws + WS_YT); }
    else { const int it = item - 128; bt = it >> 2; n0 = (it & 3) * 64; lseq = CTXL; tokbase = TLAT + bt * CTXL; YT = (const bf16*)(F.ws + WS_YTC); }
    LAS bf16* ys = (LAS bf16*)F.lds + w * (64 * 72);
    LAS float* part = (LAS float*)(F.lds + 8 * 64 * 72 * 2);
    float ss = 0.f;
#pragma unroll 16
    for (int ch = 0; ch < 64; ++ch) { const bf16 v = YT[((size_t)(64 * w + ch) * 4 + bt) * lseq + n0 + lane]; const float f = bf2f(v); ss += f * f; ys[lane * 72 + ch] = v; }
    part[w * 64 + lane] = ss;
    __syncthreads();
    bf16* MIX = (bf16*)(F.ws + WS_MIX); const float* nw = INP(IN_HYNW) + L * HYC + 64 * w + 8 * (lane & 7);
#pragma unroll 1
    for (int it = 0; it < 8; ++it) { const int tl = (lane >> 3) + 8 * it; float tot = 0.f;
#pragma unroll
        for (int ww = 0; ww < 8; ++ww) tot += part[ww * 64 + tl];
        const float rn = 1.0f / sqrtf(tot * (1.0f / 512.0f) + LN_EPS);
        const v4u v = *(const LAS v4u*)(ys + tl * 72 + 8 * (lane & 7));
        v4u o; o.x = pk2(bflo(v.x) * rn * nw[0], bfhi(v.x) * rn * nw[1]); o.y = pk2(bflo(v.y) * rn * nw[2], bfhi(v.y) * rn * nw[3]); o.z = pk2(bflo(v.z) * rn * nw[4], bfhi(v.z) * rn * nw[5]); o.w = pk2(bflo(v.w) * rn * nw[6], bfhi(v.w) * rn * nw[7]);
        *(v4u*)(MIX + (size_t)(tokbase + n0 + tl) * DM + 64 * w + 8 * (lane & 7)) = o; }
    __syncthreads();
}

__device__ __forceinline__ int gla_chunk_base(int b, int dir, int s, bool& is_ctx) {
    if (s < 4) { is_ctx = true; const int cc = dir ? 3 - s : s; return TLAT + b * CTXL + cc * 64; }
    is_ctx = false; const int lc = dir ? 35 - s : s - 4; return b * SEQ + lc * 64;
}
constexpr int GLP = 72;
template <bool WITH_Q>
__device__ __forceinline__ void gla_stage_raw(const Fr& F, int h, int base, LAS bf16* RK, LAS bf16* RQ, LAS bf16* RG, LAS bf16* VTs) {
    const bf16* PROJ = (const bf16*)(F.ws + WS_PROJ); const int tl = 8 * F.wave + (F.lane >> 3), c = F.lane & 7;
    const bf16* rp = PROJ + (size_t)(base + tl) * INCP;
    *(LAS v4u*)(RK + tl * GLP + 8 * c) = *(const v4u*)(rp + C_GK + h * 64 + 8 * c);
    if (WITH_Q) *(LAS v4u*)(RQ + tl * GLP + 8 * c) = *(const v4u*)(rp + C_GQ + h * 64 + 8 * c);
    if (c < 4) *(LAS v4u*)(RG + tl * 32 + 8 * c) = *(const v4u*)(rp + C_GA + 8 * c);
    const v4u a = *(const v4u*)(rp + C_GV + h * 128 + 8 * c), b = *(const v4u*)(rp + C_GV + h * 128 + 64 + 8 * c);
    const unsigned wa[4] = {a.x, a.y, a.z, a.w}, wb[4] = {b.x, b.y, b.z, b.w};
#pragma unroll
    for (int e = 0; e < 4; ++e) { VTs[(8 * c + 2 * e) * GLP + tl] = (bf16)(wa[e] & 0xffffu); VTs[(8 * c + 2 * e + 1) * GLP + tl] = (bf16)(wa[e] >> 16);
        VTs[(64 + 8 * c + 2 * e) * GLP + tl] = (bf16)(wb[e] & 0xffffu); VTs[(64 + 8 * c + 2 * e + 1) * GLP + tl] = (bf16)(wb[e] >> 16); }
}
__device__ __forceinline__ void gla_gate_scan(const Fr& F, int L, int h, int dir, const LAS bf16* RG, float (&cf)[8], float (&la)[8]) {
    const int lane = F.lane;
    const v4u g0 = *(const LAS v4u*)(RG + lane * 32 + dir * 16), g1 = *(const LAS v4u*)(RG + lane * 32 + dir * 16 + 8);
    const float ga[16] = {bflo(g0.x), bfhi(g0.x), bflo(g0.y), bfhi(g0.y), bflo(g0.z), bfhi(g0.z), bflo(g0.w), bfhi(g0.w), bflo(g1.x), bfhi(g1.x), bflo(g1.y), bfhi(g1.y), bflo(g1.z), bfhi(g1.z), bflo(g1.w), bfhi(g1.w)};
    const float* w2 = INP(IN_GAW2) + (size_t)(L * 2 + dir) * 16 * 384 + h * 64 + F.wave * 8; const float* gb = INP(IN_GAB) + (L * 2 + dir) * 384 + h * 64 + F.wave * 8;
#pragma unroll
    for (int e = 0; e < 8; ++e) { float z = gb[e];
#pragma unroll
        for (int r = 0; r < 16; ++r) z += ga[r] * w2[r * 384 + e];
        la[e] = logsigmoid_f(z) * (1.0f / 16.0f);
        float v = la[e];
#pragma unroll
        for (int off = 1; off < 64; off <<= 1) { const float u = __shfl_up(v, off); if (lane >= off) v += u; }
        cf[e] = v; }
}
__device__ __forceinline__ void gla_load_rope(const Fr& F, const LAS bf16* R, int tok, bool is_ctx, float (&x)[8]) {
    const int w = F.wave; const LAS bf16* p = R + F.lane * GLP + 8 * w; const v4u a = *(const LAS v4u*)p;
    const float own[8] = {bflo(a.x), bfhi(a.x), bflo(a.y), bfhi(a.y), bflo(a.z), bfhi(a.z), bflo(a.w), bfhi(a.w)};
    if (is_ctx) {
#pragma unroll
        for (int e = 0; e < 8; ++e) x[e] = own[e];
        return; }
    const bool first = (w & 3) < 2;
    const v4u bq = *(const LAS v4u*)(first ? p + 16 : p - 16);
    const float oth[8] = {bflo(bq.x), bfhi(bq.x), bflo(bq.y), bfhi(bq.y), bflo(bq.z), bfhi(bq.z), bflo(bq.w), bfhi(bq.w)};
    const int t = tok & (SEQ - 1); const float pos = (w >= 4) ? (float)(t & 63) : (float)(t >> 6);
#pragma unroll
    for (int e = 0; e < 8; ++e) { const int ai = (8 * w + e) & 15; const float ang = pos * __expf(-(float)ai * (9.210340371976184f / 16.0f)); const float sn = __sinf(ang), cs = __cosf(ang);
        x[e] = first ? own[e] * cs - oth[e] * sn : oth[e] * sn + own[e] * cs; }
}
__device__ __forceinline__ void gla_g1_item(const Fr& F, int L, int item) {
    const int ci = item % GSTEPS, bh = item / GSTEPS, h = bh % GH, b = bh / GH;
    const bool is_ctx = ci < 4; const int base = is_ctx ? TLAT + b * CTXL + ci * 64 : b * SEQ + (ci - 4) * 64;
    LAS bf16* VTs = (LAS bf16*)F.lds; LAS bf16* KT0 = VTs + 128 * GLP; LAS bf16* KT1 = KT0 + 64 * GLP; LAS float* Cs = (LAS float*)(KT1 + 64 * GLP); LAS bf16* RK = (LAS bf16*)(Cs + 128); LAS bf16* RG = RK + 64 * GLP;
    const int lane = F.lane, w = F.wave;
    gla_stage_raw<false>(F, h, base, RK, nullptr, RG, VTs);
    __syncthreads();
    float kx[8];
    gla_load_rope(F, RK, base + lane, is_ctx, kx);
#pragma unroll
    for (int dir = 0; dir < 2; ++dir) { float cf[8], la[8];
        gla_gate_scan(F, L, h, dir, RG, cf, la);
        { float* cfp = (float*)(F.ws + WS_CF) + ((size_t)(base + lane) * 2 + dir) * 384 + h * 64 + 8 * w;
          *(f32x4*)cfp = (f32x4){cf[0], cf[1], cf[2], cf[3]}; *(f32x4*)(cfp + 4) = (f32x4){cf[4], cf[5], cf[6], cf[7]}; }
        LAS bf16* KTs = dir ? KT1 : KT0;
#pragma unroll
        for (int e = 0; e < 8; ++e) { const float kt = kx[e] * __expf(dir ? (cf[e] - la[e]) : -cf[e]); KTs[(8 * w + e) * GLP + lane] = (bf16)f2bf(kt); if (lane == 63) Cs[dir * 64 + 8 * w + e] = cf[e]; } }
    __syncthreads();
    const int r16 = lane & 15, g = lane >> 4;
    bf16x8 va[2];
#pragma unroll
    for (int ks = 0; ks < 2; ++ks) va[ks] = *(const LAS bf16x8*)(VTs + (16 * w + r16) * GLP + 8 * g + 32 * ks);
#pragma unroll
    for (int dir = 0; dir < 2; ++dir) {
        const int step = is_ctx ? (dir ? 3 - ci : ci) : (dir ? 39 - ci : ci); const size_t slot = (size_t)((b * GH + h) * 2 + dir) * GSTEPS + step;
        if (F.tid < 64) ((float*)(F.ws + WS_DEC))[slot * 64 + F.tid] = __expf(Cs[dir * 64 + F.tid]);
        const LAS bf16* KTs = dir ? KT1 : KT0; bf16* U = (bf16*)(F.ws + WS_ST) + slot * 8192;
#pragma unroll
        for (int ib = 0; ib < 4; ++ib) { f32x4 acc = (f32x4){0.f, 0.f, 0.f, 0.f};
#pragma unroll
            for (int ks = 0; ks < 2; ++ks) acc = __builtin_amdgcn_mfma_f32_16x16x32_bf16(va[ks], *(const LAS bf16x8*)(KTs + (16 * ib + r16) * GLP + 8 * g + 32 * ks), acc, 0, 0, 0);
            const int i = 16 * ib + r16; const float sc = dir ? 1.0f : __expf(Cs[i]);
#pragma unroll
            for (int e = 0; e < 4; ++e) U[(16 * w + 4 * g + e) * 64 + i] = (bf16)f2bf(acc[e] * sc); } }
    __syncthreads();
}

__device__ __forceinline__ void vt_item(const Fr& F, int item, LAS unsigned* st) {
    const int lane = F.lane; const bf16* PROJ = (const bf16*)(F.ws + WS_PROJ);
    int b, h, tok0, t0; bf16 *VT, *KT;
    if (item < NB * NAH * 32) { const int tb = item & 31, bh = item >> 5; b = bh / NAH; h = bh % NAH; t0 = tb * 64; tok0 = b * SEQ + t0; VT = (bf16*)(F.ws + WS_VTL) + (size_t)bh * 128 * SEQ; KT = (bf16*)(F.ws + WS_KTL) + (size_t)bh * 128 * SEQ; }
    else { const int it = item - NB * NAH * 32, tb = it & 3, bh = it >> 2; b = bh / NAH; h = bh % NAH; t0 = tb * 64; tok0 = TLAT + b * CTXL + t0; VT = (bf16*)(F.ws + WS_VTC) + (size_t)bh * 128 * CTXL; KT = (bf16*)(F.ws + WS_KTC) + (size_t)bh * 128 * CTXL; }
#pragma unroll 8
    for (int idx = lane; idx < 64 * 16; idx += 64) { const int tok = idx >> 4, ch = idx & 15; const bf16* rp = PROJ + (size_t)(tok0 + tok) * INCP + h * 128 + ch * 8;
        const v4u w = *(const v4u*)(rp + C_NV), kq = *(const v4u*)(rp + C_NK);
        LAS unsigned* p = st + tok * 65 + ch * 4; p[0] = w.x; p[1] = w.y; p[2] = w.z; p[3] = w.w;
        *(v4u*)(KT + (size_t)((t0 + tok) >> 3) * 1024 + (ch >> 2) * 256 + (tok & 7) * 32 + ((ch & 3) ^ (2 * (((t0 + tok) >> 3) & 1))) * 8) = kq; }
    LDS_WAIT(); asm volatile("" ::: "memory");
    bf16* vo = VT + (size_t)((t0 + lane) >> 3) * 1024 + (lane & 7);
#pragma unroll 4
    for (int d2 = 0; d2 < 64; ++d2) { const unsigned w = st[lane * 65 + d2]; vo[(2 * d2) * 8] = (bf16)(w & 0xffffu); vo[(2 * d2 + 1) * 8] = (bf16)(w >> 16); }
    LDS_WAIT(); asm volatile("" ::: "memory");
}
template <bool LAT>
__device__ __forceinline__ void na_mfma_item(const Fr& F, int L, int tile, int h, const LAS float* rpb) {
    const int lane = F.lane, qi = lane & 15, g = lane >> 4;
    const bf16* PROJ = (const bf16*)(F.ws + WS_PROJ);
    int b, r = 0, j = 0, qbase;
    if (LAT) { b = tile >> 7; const int rem = tile & 127; r = rem >> 2; j = rem & 3; qbase = b * SEQ + r * 64 + j * 16; }
    else { b = tile >> 4; qbase = TLAT + b * CTXL + (tile & 15) * 16; }
    const int r0 = min(max(r - 4, 0), 24), cs = min(max(16 * j - 8, 0), 32), c = 16 * j + qi, c0 = min(max(c - 8, 0), 48);
    const int ctx0 = TLAT + b * CTXL;
    bf16x8 bq[4];
    { const bf16* qp = PROJ + (size_t)(qbase + qi) * INCP + C_NQ + h * 128 + g * 8;
#pragma unroll
      for (int ks = 0; ks < 4; ++ks) bq[ks] = *(const bf16x8*)(qp + ks * 32); }
    constexpr int NKB = LAT ? 32 : 16, NLOC = LAT ? 16 : 0;
    f32x4 S[NKB];
    const bf16* ktl = (const bf16*)(F.ws + WS_KTL) + (size_t)(b * NAH + h) * 128 * SEQ + (qi >> 2) * 1024 + (qi & 3) * 32 + (g ^ (2 * (((cs >> 3) + (qi >> 2)) & 1))) * 8;
    const bf16* ktc = (const bf16*)(F.ws + WS_KTC) + (size_t)(b * NAH + h) * 128 * CTXL + (qi >> 2) * 1024 + (qi & 3) * 32 + (g ^ (2 * ((qi >> 2) & 1))) * 8;
#define NA_KP(kb) (((kb) < NLOC) ? ktl + (((r0 + ((kb) >> 1)) * 64 + cs) >> 3) * 1024 + ((kb) & 1) * 128 : ktc + (((kb) - NLOC) >> 1) * 4096 + ((kb) & 1) * 128)
#define NA_LOADK(dst, kb) do { const bf16* kp_ = NA_KP(kb); _Pragma("unroll") for (int ks = 0; ks < 4; ++ks) dst[ks] = *(const bf16x8*)(kp_ + ks * 256); } while (0)
    bf16x8 k0[4], k1[4], k2[4], k3[4], k4[4];
#define NA_QK(ka, kb_) do { f32x4 acc0 = (f32x4){0.f, 0.f, 0.f, 0.f}; \
        _Pragma("unroll") for (int ks = 0; ks < 4; ++ks) acc0 = __builtin_amdgcn_mfma_f32_16x16x32_bf16(ka[ks], bq[ks], acc0, 0, 0, 0); \
        S[kb_] = acc0; } while (0)
    NA_LOADK(k0, 0); NA_LOADK(k1, 1); NA_LOADK(k2, 2); NA_LOADK(k3, 3);
    if (0 < NKB) { if (0 + 4 < NKB) NA_LOADK(k4, 0 + 4); __builtin_amdgcn_sched_barrier(0); NA_QK(k0, 0); __builtin_amdgcn_sched_barrier(0); }
    if (1 < NKB) { if (1 + 4 < NKB) NA_LOADK(k0, 1 + 4); __builtin_amdgcn_sched_barrier(0); NA_QK(k1, 1); __builtin_amdgcn_sched_barrier(0); }
    if (2 < NKB) { if (2 + 4 < NKB) NA_LOADK(k1, 2 + 4); __builtin_amdgcn_sched_barrier(0); NA_QK(k2, 2); __builtin_amdgcn_sched_barrier(0); }
    if (3 < NKB) { if (3 + 4 < NKB) NA_LOADK(k2, 3 + 4); __builtin_amdgcn_sched_barrier(0); NA_QK(k3, 3); __builtin_amdgcn_sched_barrier(0); }
    if (4 < NKB) { if (4 + 4 < NKB) NA_LOADK(k3, 4 + 4); __builtin_amdgcn_sched_barrier(0); NA_QK(k4, 4); __builtin_amdgcn_sched_barrier(0); }
    if (5 < NKB) { if (5 + 4 < NKB) NA_LOADK(k4, 5 + 4); __builtin_amdgcn_sched_barrier(0); NA_QK(k0, 5); __builtin_amdgcn_sched_barrier(0); }
    if (6 < NKB) { if (6 + 4 < NKB) NA_LOADK(k0, 6 + 4); __builtin_amdgcn_sched_barrier(0); NA_QK(k1, 6); __builtin_amdgcn_sched_barrier(0); }
    if (7 < NKB) { if (7 + 4 < NKB) NA_LOADK(k1, 7 + 4); __builtin_amdgcn_sched_barrier(0); NA_QK(k2, 7); __builtin_amdgcn_sched_barrier(0); }
    if (8 < NKB) { if (8 + 4 < NKB) NA_LOADK(k2, 8 + 4); __builtin_amdgcn_sched_barrier(0); NA_QK(k3, 8); __builtin_amdgcn_sched_barrier(0); }
    if (9 < NKB) { if (9 + 4 < NKB) NA_LOADK(k3, 9 + 4); __builtin_amdgcn_sched_barrier(0); NA_QK(k4, 9); __builtin_amdgcn_sched_barrier(0); }
    if (10 < NKB) { if (10 + 4 < NKB) NA_LOADK(k4, 10 + 4); __builtin_amdgcn_sched_barrier(0); NA_QK(k0, 10); __builtin_amdgcn_sched_barrier(0); }
    if (11 < NKB) { if (11 + 4 < NKB) NA_LOADK(k0, 11 + 4); __builtin_amdgcn_sched_barrier(0); NA_QK(k1, 11); __builtin_amdgcn_sched_barrier(0); }
    if (12 < NKB) { if (12 + 4 < NKB) NA_LOADK(k1, 12 + 4); __builtin_amdgcn_sched_barrier(0); NA_QK(k2, 12); __builtin_amdgcn_sched_barrier(0); }
    if (13 < NKB) { if (13 + 4 < NKB) NA_LOADK(k2, 13 + 4); __builtin_amdgcn_sched_barrier(0); NA_QK(k3, 13); __builtin_amdgcn_sched_barrier(0); }
    if (14 < NKB) { if (14 + 4 < NKB) NA_LOADK(k3, 14 + 4); __builtin_amdgcn_sched_barrier(0); NA_QK(k4, 14); __builtin_amdgcn_sched_barrier(0); }
    if (15 < NKB) { if (15 + 4 < NKB) NA_LOADK(k4, 15 + 4); __builtin_amdgcn_sched_barrier(0); NA_QK(k0, 15); __builtin_amdgcn_sched_barrier(0); }
    if (16 < NKB) { if (16 + 4 < NKB) NA_LOADK(k0, 16 + 4); __builtin_amdgcn_sched_barrier(0); NA_QK(k1, 16); __builtin_amdgcn_sched_barrier(0); }
    if (17 < NKB) { if (17 + 4 < NKB) NA_LOADK(k1, 17 + 4); __builtin_amdgcn_sched_barrier(0); NA_QK(k2, 17); __builtin_amdgcn_sched_barrier(0); }
    if (18 < NKB) { if (18 + 4 < NKB) NA_LOADK(k2, 18 + 4); __builtin_amdgcn_sched_barrier(0); NA_QK(k3, 18); __builtin_amdgcn_sched_barrier(0); }
    if (19 < NKB) { if (19 + 4 < NKB) NA_LOADK(k3, 19 + 4); __builtin_amdgcn_sched_barrier(0); NA_QK(k4, 19); __builtin_amdgcn_sched_barrier(0); }
    if (20 < NKB) { if (20 + 4 < NKB) NA_LOADK(k4, 20 + 4); __builtin_amdgcn_sched_barrier(0); NA_QK(k0, 20); __builtin_amdgcn_sched_barrier(0); }
    if (21 < NKB) { if (21 + 4 < NKB) NA_LOADK(k0, 21 + 4); __builtin_amdgcn_sched_barrier(0); NA_QK(k1, 21); __builtin_amdgcn_sched_barrier(0); }
    if (22 < NKB) { if (22 + 4 < NKB) NA_LOADK(k1, 22 + 4); __builtin_amdgcn_sched_barrier(0); NA_QK(k2, 22); __builtin_amdgcn_sched_barrier(0); }
    if (23 < NKB) { if (23 + 4 < NKB) NA_LOADK(k2, 23 + 4); __builtin_amdgcn_sched_barrier(0); NA_QK(k3, 23); __builtin_amdgcn_sched_barrier(0); }
    if (24 < NKB) { if (24 + 4 < NKB) NA_LOADK(k3, 24 + 4); __builtin_amdgcn_sched_barrier(0); NA_QK(k4, 24); __builtin_amdgcn_sched_barrier(0); }
    if (25 < NKB) { if (25 + 4 < NKB) NA_LOADK(k4, 25 + 4); __builtin_amdgcn_sched_barrier(0); NA_QK(k0, 25); __builtin_amdgcn_sched_barrier(0); }
    if (26 < NKB) { if (26 + 4 < NKB) NA_LOADK(k0, 26 + 4); __builtin_amdgcn_sched_barrier(0); NA_QK(k1, 26); __builtin_amdgcn_sched_barrier(0); }
    if (27 < NKB) { if (27 + 4 < NKB) NA_LOADK(k1, 27 + 4); __builtin_amdgcn_sched_barrier(0); NA_QK(k2, 27); __builtin_amdgcn_sched_barrier(0); }
    if (28 < NKB) { if (28 + 4 < NKB) NA_LOADK(k2, 28 + 4); __builtin_amdgcn_sched_barrier(0); NA_QK(k3, 28); __builtin_amdgcn_sched_barrier(0); }
    if (29 < NKB) { if (29 + 4 < NKB) NA_LOADK(k3, 29 + 4); __builtin_amdgcn_sched_barrier(0); NA_QK(k4, 29); __builtin_amdgcn_sched_barrier(0); }
    if (30 < NKB) { if (30 + 4 < NKB) NA_LOADK(k4, 30 + 4); __builtin_amdgcn_sched_barrier(0); NA_QK(k0, 30); __builtin_amdgcn_sched_barrier(0); }
    if (31 < NKB) { if (31 + 4 < NKB) NA_LOADK(k0, 31 + 4); __builtin_amdgcn_sched_barrier(0); NA_QK(k1, 31); __builtin_amdgcn_sched_barrier(0); }
#undef NA_QK
#undef NA_LOADK
#undef NA_KP
    float mx = -3.0e38f;
#pragma unroll
    for (int kb = 0; kb < NKB; ++kb)
#pragma unroll
        for (int i = 0; i < 4; ++i) { float sv = S[kb][i] * 0.08838834764831845f;
            if (kb < NLOC) { const int kc = cs + (kb & 1) * 4 + 8 * g + i; const bool ok = (kc >= c0) && (kc < c0 + 16); const int rel = min(max(kc - c + 15, 0), 30);
                const float bias = rpb[h * 465 + (r0 + (kb >> 1) - r + 7) * 31 + rel]; sv = ok ? sv + bias * 0.6931471805599453f : -3.0e38f;     }
            S[kb][i] = sv; mx = fmaxf(mx, sv); }
    mx = fmaxf(mx, __shfl_xor(mx, 16)); mx = fmaxf(mx, __shfl_xor(mx, 32));
    float sum = 0.f;
#pragma unroll
    for (int kb = 0; kb < NKB; ++kb)
#pragma unroll
        for (int i = 0; i < 4; ++i) { const float p = __expf(S[kb][i] - mx); S[kb][i] = p; sum += p; }
    sum += __shfl_xor(sum, 16); sum += __shfl_xor(sum, 32);
    const float inv = 1.0f / sum;
    f32x4 O[8];
#pragma unroll
    for (int db = 0; db < 8; ++db) O[db] = (f32x4){0.f, 0.f, 0.f, 0.f};
    const bf16* VTL = (const bf16*)(F.ws + WS_VTL) + (size_t)(b * NAH + h) * 128 * SEQ + g * 1024 + qi * 8;
    const bf16* VTC = (const bf16*)(F.ws + WS_VTC) + (size_t)(b * NAH + h) * 128 * CTXL + g * 1024 + qi * 8;
#define NA_VB(s2) (((s2) < NLOC / 2) ? VTL + (((r0 + (s2)) * 64 + cs) >> 3) * 1024 : VTC + ((s2) - NLOC / 2) * 4096)
#define NA_LOADV(dst, s2) do { const bf16* vb_ = NA_VB(s2); _Pragma("unroll") for (int db = 0; db < 8; ++db) dst[db] = *(const v4u*)(vb_ + db * 128); } while (0)
#define NA_PV(src, s2) do { const bf16x8 pf = __builtin_bit_cast(bf16x8, P[s2]); _Pragma("unroll") for (int db = 0; db < 8; ++db) O[db] = __builtin_amdgcn_mfma_f32_16x16x32_bf16(__builtin_bit_cast(bf16x8, src[db]), pf, O[db], 0, 0, 0); } while (0)
    v4u P[NKB / 2];
#pragma unroll
    for (int s2 = 0; s2 < NKB / 2; ++s2) { P[s2].x = pk2(S[2 * s2][0], S[2 * s2][1]); P[s2].y = pk2(S[2 * s2][2], S[2 * s2][3]); P[s2].z = pk2(S[2 * s2 + 1][0], S[2 * s2 + 1][1]); P[s2].w = pk2(S[2 * s2 + 1][2], S[2 * s2 + 1][3]); }
#pragma unroll
    for (int s2 = 0; s2 < NKB / 2; ++s2) asm volatile("" : "+v"(P[s2]));
    v4u va[8], vb[8];
    NA_LOADV(va, 0);
#pragma unroll
    for (int s2 = 0; s2 < NKB / 2; s2 += 2) {
        NA_LOADV(vb, s2 + 1);
        __builtin_amdgcn_sched_barrier(0);
        NA_PV(va, s2);
        __builtin_amdgcn_sched_barrier(0);
        if (s2 + 2 < NKB / 2) NA_LOADV(va, s2 + 2);
        __builtin_amdgcn_sched_barrier(0);
        NA_PV(vb, s2 + 1);
        __builtin_amdgcn_sched_barrier(0);
    }
#undef NA_VB
#undef NA_LOADV
#undef NA_PV
    bf16* op = (bf16*)(F.ws + WS_MIX) + (size_t)(qbase + qi) * DM + M_NA + h * 128 + 4 * g;
#pragma unroll
    for (int db = 0; db < 8; ++db) { v2u w; w.x = pk2(O[db][0] * inv, O[db][1] * inv); w.y = pk2(O[db][2] * inv, O[db][3] * inv); *(v2u*)(op + db * 16) = w; }
}

__device__ __forceinline__ void p3_mixers1(Fr F, int L) {
    RELAUNDER(F);
#ifndef REPMASK
#define REPMASK 0
#endif
    for (int rep = 0; rep < 1 + ((REPMASK >> 1) & 1); ++rep)
    for (int it = F.bid; it < NB * GH * GSTEPS; it += F.G) gla_g1_item(F, L, it);
    __syncthreads();
    const int gw = F.bid * NWAVES + F.wave, NGW = F.G * NWAVES;
    { LAS unsigned* st = (LAS unsigned*)(F.lds + F.wave * 16640);
      for (int rep = 0; rep < 1 + ((REPMASK >> 4) & 1); ++rep)
      for (int it = gw; it < NB * NAH * 36; it += NGW) vt_item(F, it, st); }
    __syncthreads();
    { LAS bf16* zt = (LAS bf16*)(F.lds + F.wave * 16896); LAS bf16* xt = zt + 64 * 66;
      const int n_pre = 1024 + ((L == 0) ? 128 : 0);
      for (int rep = 0; rep < 1 + ((REPMASK >> 4) & 1); ++rep)
      for (int it = NGW - 1 - gw; it < n_pre; it += NGW) hy_pre_item(F, L, it, zt, xt); }
}

constexpr int NBU_STATS = 11264, NBU_BUF0 = 12288, NBU_BUFSZ = 49152, NBU_XCH = 110592, NBU_UNITS = NB * NAH * 32;
__device__ __forceinline__ void na_block_units(const Fr& F, int L, const LAS float* rpb) {
    const int lane = F.lane, qi = lane & 15, g = lane >> 4, tid = F.tid, j = F.wave & 3, part = F.wave >> 2;
    LAS unsigned char* lb = F.lds;
    LAS float* stats = (LAS float*)(lb + NBU_STATS);
    const bf16* PROJ = (const bf16*)(F.ws + WS_PROJ);
    const int cs = min(max(16 * j - 8, 0), 32), c = 16 * j + qi, c0 = min(max(c - 8, 0), 48);
    int rel8[8]; bool ok8[8];
#pragma unroll
    for (int e = 0; e < 8; ++e) { const int kc = cs + (e >> 2) * 4 + 8 * g + (e & 3); ok8[e] = (kc >= c0) && (kc < c0 + 16); rel8[e] = min(max(kc - c + 15, 0), 30); }
    v4u st0[6], st1[6];
#define NB_LOAD(st, unit_, s_) do { const int bh_ = (unit_) >> 5, r_ = (unit_) & 31, r0_ = min(max(r_ - 4, 0), 24), sk_ = (s_) & 3; \
        const bf16* sl_ = (const bf16*)(F.ws + (((s_) < 4) ? WS_KTL : WS_VTL)) + (size_t)bh_ * 128 * SEQ + (size_t)(r0_ + 2 * sk_) * 8192; \
        const bf16* sc_ = (const bf16*)(F.ws + (((s_) < 4) ? WS_KTC : WS_VTC)) + (size_t)bh_ * 128 * CTXL + sk_ * 8192; \
        _Pragma("unroll") for (int k = 0; k < 4; ++k) st[k] = *(const v4u*)(sl_ + (tid + 512 * k) * 8); \
        _Pragma("unroll") for (int k = 0; k < 2; ++k) st[4 + k] = *(const v4u*)(sc_ + (tid + 512 * k) * 8); } while (0)
#define NB_STORE(st, buf_) do { LAS v4u* d_ = (LAS v4u*)(lb + NBU_BUF0 + (buf_) * NBU_BUFSZ); _Pragma("unroll") for (int k = 0; k < 6; ++k) d_[tid + 512 * k] = st[k]; } while (0)
    const bool xmap = (F.G == 256);
    const int ustep = xmap ? 32 : F.G;
    int unit = xmap ? ((3 * (F.bid & 7)) << 5) + (F.bid >> 3) : F.bid;
    const int uend = xmap ? unit + 96 : NBU_UNITS;
    if (unit < uend) { NB_LOAD(st0, unit, 0); NB_LOAD(st1, unit, 1); NB_STORE(st0, 0); }
    __syncthreads();
    const int koff = (part ? 16384 : (cs >> 3) * 1024) + (qi >> 2) * 1024 + (qi & 3) * 32 + (g ^ (2 * (((part ? 0 : (cs >> 3)) + (qi >> 2)) & 1))) * 8;
    const int kstep1 = 128, kstep2 = part ? 4096 : 8192;
    const int voff = (part ? 16384 : (cs >> 3) * 1024) + g * 1024 + qi * 8;
    const int vstep = part ? 4096 : 8192;
    for (; unit < uend; unit += ustep) {
        const int bh = unit >> 5, r = unit & 31, b = bh / NAH, h = bh - b * NAH, r0 = min(max(r - 4, 0), 24);
        const int qbase = b * SEQ + r * 64 + j * 16;
        bf16x8 bq[4];
        { const bf16* qp = PROJ + (size_t)(qbase + qi) * INCP + C_NQ + h * 128 + g * 8;
#pragma unroll
          for (int ks = 0; ks < 4; ++ks) bq[ks] = *(const bf16x8*)(qp + ks * 32); }
        f32x4 S[16];
        const int nxt = unit + ustep;
#pragma unroll
        for (int s = 0; s < 4; ++s) {
            if (s & 1) NB_LOAD(st1, unit, s + 2); else NB_LOAD(st0, unit, s + 2);
            __builtin_amdgcn_sched_barrier(0);
            const LAS bf16* kb_ = (const LAS bf16*)(lb + NBU_BUF0 + (s & 1) * NBU_BUFSZ) + koff;
            for (int rq = 0; rq < 1 + ((REPMASK >> 22) & 1); ++rq) { asm volatile("" ::: "memory");
#pragma unroll
            for (int t4 = 0; t4 < 4; ++t4) { const LAS bf16* kp = kb_ + (t4 & 1) * kstep1 + (t4 >> 1) * kstep2;
                f32x4 acc0 = (f32x4){0.f, 0.f, 0.f, 0.f};
#pragma unroll
                for (int ks = 0; ks < 4; ++ks) acc0 = __builtin_amdgcn_mfma_f32_16x16x32_bf16(*(const LAS bf16x8*)(kp + ks * 256), bq[ks], acc0, 0, 0, 0);
                S[4 * s + t4] = acc0; }
            }
            __builtin_amdgcn_sched_barrier(0);
            for (int rq = 0; rq < 1 + ((REPMASK >> 23) & 1); ++rq) { asm volatile("" ::: "memory");
            if (s & 1) NB_STORE(st0, 0); else NB_STORE(st1, 1); }
            if (s == 3) {
                float mx = -3.0e38f;
                if (!part) {
                    const LAS float* rb = rpb + h * 465 + (r0 - r + 7) * 31;
#pragma unroll
                    for (int kb = 0; kb < 16; ++kb)
#pragma unroll
                        for (int i = 0; i < 4; ++i) { const int e = (kb & 1) * 4 + i;
                            const float t = fmaf(S[kb][i], 0.08838834764831845f * 1.4426950408889634f, rb[(kb >> 1) * 31 + rel8[e]]);
                            const float sv = ok8[e] ? t : -3.0e38f; S[kb][i] = sv; mx = fmaxf(mx, sv); }
                } else {
#pragma unroll
                    for (int kb = 0; kb < 16; ++kb)
#pragma unroll
                        for (int i = 0; i < 4; ++i) { const float sv = S[kb][i] * (0.08838834764831845f * 1.4426950408889634f); S[kb][i] = sv; mx = fmaxf(mx, sv); }
                }
                mx = fmaxf(mx, __shfl_xor(mx, 16)); mx = fmaxf(mx, __shfl_xor(mx, 32));
                if (g == 0) stats[F.wave * 16 + qi] = mx;
            }
            __syncthreads();
        }
        const float mxa = fmaxf(stats[j * 16 + qi], stats[(4 + j) * 16 + qi]);
        float sum = 0.f;
#pragma unroll
        for (int kb = 0; kb < 16; ++kb)
#pragma unroll
            for (int i = 0; i < 4; ++i) { const float p = __builtin_amdgcn_exp2f(S[kb][i] - mxa); S[kb][i] = p; sum += p; }
        sum += __shfl_xor(sum, 16); sum += __shfl_xor(sum, 32);
        v4u P[8];
#pragma unroll
        for (int s2 = 0; s2 < 8; ++s2) { P[s2].x = pk2(S[2 * s2][0], S[2 * s2][1]); P[s2].y = pk2(S[2 * s2][2], S[2 * s2][3]); P[s2].z = pk2(S[2 * s2 + 1][0], S[2 * s2 + 1][1]); P[s2].w = pk2(S[2 * s2 + 1][2], S[2 * s2 + 1][3]); }
        f32x4 O[8];
#pragma unroll
        for (int db = 0; db < 8; ++db) O[db] = (f32x4){0.f, 0.f, 0.f, 0.f};
#pragma unroll
        for (int s = 4; s < 8; ++s) {
            if (s < 6) { if (s & 1) NB_LOAD(st1, unit, s + 2); else NB_LOAD(st0, unit, s + 2); }
            else if (nxt < uend) { if (s & 1) NB_LOAD(st1, nxt, 1); else NB_LOAD(st0, nxt, 0); }
            __builtin_amdgcn_sched_barrier(0);
            const LAS bf16* vb_ = (const LAS bf16*)(lb + NBU_BUF0 + (s & 1) * NBU_BUFSZ) + voff;
            bf16x8 vf[2][8];
#pragma unroll
            for (int t2 = 0; t2 < 2; ++t2)
#pragma unroll
                for (int db = 0; db < 8; ++db) vf[t2][db] = *(const LAS bf16x8*)(vb_ + t2 * vstep + db * 128);
            __builtin_amdgcn_sched_barrier(0);
#pragma unroll
            for (int t2 = 0; t2 < 2; ++t2) { const bf16x8 pf = __builtin_bit_cast(bf16x8, P[2 * (s - 4) + t2]);
#pragma unroll
                for (int db = 0; db < 8; ++db) O[db] = __builtin_amdgcn_mfma_f32_16x16x32_bf16(vf[t2][db], pf, O[db], 0, 0, 0); }
            __builtin_amdgcn_sched_barrier(0);
            if (s < 7 || nxt < uend) { if (s & 1) NB_STORE(st0, 0); else NB_STORE(st1, 1); }
            if (s == 7 && part) {
                LAS f32x4* xo = (LAS f32x4*)(lb + NBU_XCH) + j * 512 + lane;
#pragma unroll
                for (int db = 0; db < 8; ++db) xo[db * 64] = O[db];
                if (g == 0) stats[128 + j * 16 + qi] = sum;
            }
            __syncthreads();
        }
        if (!part) {
            const LAS f32x4* xo = (const LAS f32x4*)(lb + NBU_XCH) + j * 512 + lane;
            const float inv = 1.0f / (sum + stats[128 + j * 16 + qi]);
            bf16* op = (bf16*)(F.ws + WS_MIX) + (size_t)(qbase + qi) * DM + M_NA + h * 128 + 4 * g;
#pragma unroll
            for (int db = 0; db < 8; ++db) { const f32x4 o = O[db] + xo[db * 64]; v2u w; w.x = pk2(o[0] * inv, o[1] * inv); w.y = pk2(o[2] * inv, o[3] * inv); *(v2u*)(op + db * 16) = w; }
        }
    }
#undef NB_LOAD
#undef NB_STORE
}

__device__ __forceinline__ void p4_gla_scan(Fr F, int L, const XcdBarrier& bar) {
    RELAUNDER(F);
    for (int rep = 0; rep < 1 + ((REPMASK >> 10) & 1); ++rep)
    for (int it = F.bid; it < HYC + ((L == 0) ? HYC : 0); it += F.G) {
        if (it < HYC) hy_conv_item<SEQ>(F, it, (const float*)(F.ws + WS_KF) + ((size_t)L * HYC + it) * 4096, (const bf16*)(F.ws + WS_ZT), (const bf16*)(F.ws + WS_X0T), (bf16*)(F.ws + WS_YT));
        else hy_conv_item<CTXL>(F, it - HYC, (const float*)(F.ws + WS_KFC) + (size_t)(it - HYC) * 512, (const bf16*)(F.ws + WS_ZTC), (const bf16*)(F.ws + WS_X0TC), (bf16*)(F.ws + WS_YTC));
    }
    unsigned* ST = (unsigned*)(F.ws + WS_ST); const float* DEC = (const float*)(F.ws + WS_DEC);
    for (int rep = 0; rep < 1 + ((REPMASK >> 7) & 1); ++rep) {
    if (rep > 0) { __syncthreads(); for (int it = F.bid; it < NB * GH * GSTEPS; it += F.G) gla_g1_item(F, L, it); xcd_barrier(bar); }
    for (int e = F.bid * NTHR + F.tid; e < NB * GH * 2 * 4096; e += F.G * NTHR) {
        const int chain = e >> 12, el2 = e & 4095, i = (el2 & 31) * 2; float S0 = 0.f, S1 = 0.f;
        unsigned* p = ST + (size_t)chain * GSTEPS * 4096 + el2; const float* d = DEC + (size_t)chain * GSTEPS * 64 + i;
#pragma unroll 6
        for (int s = 0; s < GSTEPS; ++s) { const unsigned u = p[(size_t)s * 4096]; p[(size_t)s * 4096] = pk2(S0, S1); S0 = d[s * 64] * S0 + bflo(u); S1 = d[s * 64 + 1] * S1 + bfhi(u); }
    }
    if (((REPMASK >> 7) & 1) && rep == 0) xcd_barrier(bar);
    }
    LAS float* rpb = (LAS float*)F.lds;
    for (int i = F.tid; i < NAH * 465; i += NTHR) rpb[i] = INP(IN_RPB)[L * NAH * 465 + i] * 1.4426950408889634f;
    __syncthreads();
    const int gw = F.bid * NWAVES + F.wave, NGW = F.G * NWAVES;
    for (int rep = 0; rep < 1 + (REPMASK & 1); ++rep) {
    if (rep > 0) __syncthreads();
    for (int rep2 = 0; rep2 < 1 + ((REPMASK >> 20) & 1); ++rep2) { if (rep2 > 0) __syncthreads(); na_block_units(F, L, rpb); }
    for (int rep2 = 0; rep2 < 1 + ((REPMASK >> 21) & 1); ++rep2)
    if (L == 0) for (int q = F.bid + F.G * F.wave; q < 64 * NAH; q += NGW) { const int h = q / 64, tile = q % 64; na_mfma_item<false>(F, L, tile, h, rpb); }
    }
}

__device__ __forceinline__ void gla_g3_item(const Fr& F, int L, int b, int h, int ci) {
    LAS bf16* VTs = (LAS bf16*)F.lds; LAS bf16* Qs = VTs + 128 * GLP; LAS bf16* Ks = Qs + 64 * GLP; LAS float* Cs = (LAS float*)(Ks + 64 * GLP); LAS float* red = Cs + 64;
    LAS bf16* RK = (LAS bf16*)(red + 128); LAS bf16* RQ = RK + 64 * GLP; LAS bf16* RG = RQ + 64 * GLP;
    LAS bf16* Qs1 = RG + 64 * 32; LAS bf16* Ks1 = Qs1 + 64 * GLP; LAS float* Cs1 = (LAS float*)(Ks1 + 64 * GLP);
    LAS bf16* const Qs0 = Qs; LAS bf16* const Ks0 = Ks; LAS float* const Cs0 = Cs;
    const int lane = F.lane, w = F.wave, r16 = lane & 15, g = lane >> 4, tb = w & 3, jh = w >> 2;
    const bool is_ctx = ci < 4; const int base = is_ctx ? TLAT + b * CTXL + ci * 64 : b * SEQ + (ci - 4) * 64;
    gla_stage_raw<true>(F, h, base, RK, RQ, RG, VTs);
    __syncthreads();
    float qx[8], kx[8];
    gla_load_rope(F, RQ, base + lane, is_ctx, qx); gla_load_rope(F, RK, base + lane, is_ctx, kx);
    f32x4 O[4];
#pragma unroll
    for (int jb = 0; jb < 4; ++jb) O[jb] = (f32x4){0.f, 0.f, 0.f, 0.f};
#pragma unroll 1
    for (int dir = 0; dir < 2; ++dir) {
        LAS bf16* Qs = dir ? Qs1 : Qs0; LAS bf16* Ks = dir ? Ks1 : Ks0; LAS float* Cs = dir ? Cs1 : Cs0;
        const int step = is_ctx ? (dir ? 3 - ci : ci) : (dir ? 39 - ci : ci);
        float cf[8], la[8];
        { const float* cfp = (const float*)(F.ws + WS_CF) + ((size_t)(base + lane) * 2 + dir) * 384 + h * 64 + 8 * w; const f32x4 c0 = *(const f32x4*)cfp, c1 = *(const f32x4*)(cfp + 4);
          const float cv[8] = {c0[0], c0[1], c0[2], c0[3], c1[0], c1[1], c1[2], c1[3]};
#pragma unroll
          for (int e = 0; e < 8; ++e) { cf[e] = cv[e]; const float pv = __shfl_up(cv[e], 1); la[e] = cv[e] - (lane ? pv : 0.f); } }
        { v4u qw, kw; float qt[8], kt[8];
#pragma unroll
          for (int e = 0; e < 8; ++e) { const float c = dir ? -(cf[e] - la[e]) : cf[e]; qt[e] = qx[e] * 0.125f * __expf(c); kt[e] = kx[e] * __expf(-c); if (lane == 63) Cs[8 * w + e] = cf[e]; }
          qw.x = pk2(qt[0], qt[1]); qw.y = pk2(qt[2], qt[3]); qw.z = pk2(qt[4], qt[5]); qw.w = pk2(qt[6], qt[7]); kw.x = pk2(kt[0], kt[1]); kw.y = pk2(kt[2], kt[3]); kw.z = pk2(kt[4], kt[5]); kw.w = pk2(kt[6], kt[7]);
          *(LAS v4u*)(Qs + lane * GLP + 8 * w) = qw; *(LAS v4u*)(Ks + lane * GLP + 8 * w) = kw; }
        const bf16* ST = (const bf16*)(F.ws + WS_ST) + ((size_t)((b * GH + h) * 2 + dir) * GSTEPS + step) * 8192;
        v4u sraw[4][2];
#pragma unroll
        for (int jb = 0; jb < 4; ++jb)
#pragma unroll
            for (int ks = 0; ks < 2; ++ks) sraw[jb][ks] = *(const v4u*)(ST + (16 * (4 * jh + jb) + r16) * 64 + 8 * g + 32 * ks);
        __syncthreads();
        bf16x8 qf[2];
#pragma unroll
        for (int ks = 0; ks < 2; ++ks) qf[ks] = *(const LAS bf16x8*)(Qs + (16 * tb + r16) * GLP + 8 * g + 32 * ks);
        f32x4 at[4];
#pragma unroll
        for (int sb = 0; sb < 4; ++sb) { at[sb] = (f32x4){0.f, 0.f, 0.f, 0.f};
            const bool live = dir ? (sb >= tb) : (sb <= tb);
            if (live) {
#pragma unroll
                for (int ks = 0; ks < 2; ++ks) at[sb] = __builtin_amdgcn_mfma_f32_16x16x32_bf16(*(const LAS bf16x8*)(Ks + (16 * sb + r16) * GLP + 8 * g + 32 * ks), qf[ks], at[sb], 0, 0, 0);
                if (sb == tb) {
#pragma unroll
                    for (int e = 0; e < 4; ++e) { const int sl = 4 * g + e; const bool keep = dir ? (sl >= r16) : (sl <= r16); if (!keep) at[sb][e] = 0.f; } } } }
#pragma unroll
        for (int jb = 0; jb < 4; ++jb) {
#pragma unroll
            for (int ks = 0; ks < 2; ++ks) { v4u sw = sraw[jb][ks];
                if (dir) { const unsigned wsrc[4] = {sw.x, sw.y, sw.z, sw.w}; unsigned wd[4];
#pragma unroll
                    for (int e2 = 0; e2 < 4; ++e2) wd[e2] = pk2(bflo(wsrc[e2]) * __expf(Cs[8 * g + 32 * ks + 2 * e2]), bfhi(wsrc[e2]) * __expf(Cs[8 * g + 32 * ks + 2 * e2 + 1]));
                    sw.x = wd[0]; sw.y = wd[1]; sw.z = wd[2]; sw.w = wd[3]; }
                O[jb] = __builtin_amdgcn_mfma_f32_16x16x32_bf16(__builtin_bit_cast(bf16x8, sw), qf[ks], O[jb], 0, 0, 0); }
#pragma unroll
            for (int ss = 0; ss < 2; ++ss) { const bool live = dir ? (2 * ss + 1 >= tb) : (2 * ss <= tb);
                if (live) { v4u pw; pw.x = pk2(at[2 * ss][0], at[2 * ss][1]); pw.y = pk2(at[2 * ss][2], at[2 * ss][3]); pw.z = pk2(at[2 * ss + 1][0], at[2 * ss + 1][1]); pw.w = pk2(at[2 * ss + 1][2], at[2 * ss + 1][3]);
                    const LAS bf16* vp = VTs + (16 * (4 * jh + jb) + r16) * GLP + 32 * ss + 4 * g; const v2u lo = *(const LAS v2u*)vp, hi = *(const LAS v2u*)(vp + 16);
                    v4u aw; aw.x = lo.x; aw.y = lo.y; aw.z = hi.x; aw.w = hi.y;
                    O[jb] = __builtin_amdgcn_mfma_f32_16x16x32_bf16(__builtin_bit_cast(bf16x8, aw), __builtin_bit_cast(bf16x8, pw), O[jb], 0, 0, 0); } } }
    }
    float ss2 = 0.f;
#pragma unroll
    for (int jb = 0; jb < 4; ++jb) ss2 += (O[jb][0] * O[jb][0] + O[jb][1] * O[jb][1]) + (O[jb][2] * O[jb][2] + O[jb][3] * O[jb][3]);
    ss2 += __shfl_xor(ss2, 16); ss2 += __shfl_xor(ss2, 32);
    if (g == 0) red[(16 * tb + r16) * 2 + jh] = ss2;
    __syncthreads();
    const int tl = 16 * tb + r16; const float rn = 1.0f / sqrtf((red[tl * 2] + red[tl * 2 + 1]) * (1.0f / 128.0f) + LN_EPS);
    const bf16* PROJ = (const bf16*)(F.ws + WS_PROJ); bf16* MIX = (bf16*)(F.ws + WS_MIX); const size_t otok = (size_t)base + tl;
#pragma unroll
    for (int jb = 0; jb < 4; ++jb) { const int j0 = 16 * (4 * jh + jb) + 4 * g; const v2u gw = *(const v2u*)(PROJ + otok * INCP + C_GG + h * 128 + j0); const f32x4 nw = *(const f32x4*)(INP(IN_GNW) + L * 128 + j0);
        v2u o; o.x = pk2(O[jb][0] * rn * nw[0] * silu_f(bflo(gw.x)), O[jb][1] * rn * nw[1] * silu_f(bfhi(gw.x))); o.y = pk2(O[jb][2] * rn * nw[2] * silu_f(bflo(gw.y)), O[jb][3] * rn * nw[3] * silu_f(bfhi(gw.y)));
        *(v2u*)(MIX + otok * DM + M_GLA + h * 128 + j0) = o; }
    __syncthreads();
}
__device__ __forceinline__ void p5_mixers2(Fr F, int L) {
    RELAUNDER(F);
    const int nci = (L == 0) ? 36 : 32, n_items = NB * GH * nci;
    for (int rep = 0; rep < 1 + ((REPMASK >> 2) & 1); ++rep)
    for (int it = F.bid; it < n_items; it += F.G) { const int ci = it % nci + ((L == 0) ? 0 : 4), bh = it / nci; gla_g3_item(F, L, bh / GH, bh % GH, ci); }
    for (int rep = 0; rep < 1 + ((REPMASK >> 4) & 1); ++rep)
    for (int it = F.G - 1 - F.bid; it < 128 + ((L == 0) ? 16 : 0); it += F.G) hy_post_item(F, L, it);
    const int gw = F.bid * NWAVES + F.wave, NGW = F.G * NWAVES; const int nrows = (L == 0) ? TTOT : TLAT; bf16* MIX = (bf16*)(F.ws + WS_MIX);
    for (int row = gw; row < nrows; row += NGW) {
        { v2u* p = (v2u*)(MIX + (size_t)row * DM + M_NA + F.lane * 12); const v2u w0 = p[0], w1 = p[1], w2 = p[2];
          float x[12] = {bflo(w0.x), bfhi(w0.x), bflo(w0.y), bfhi(w0.y), bflo(w1.x), bfhi(w1.x), bflo(w1.y), bfhi(w1.y), bflo(w2.x), bfhi(w2.x), bflo(w2.y), bfhi(w2.y)}; float s = 0.f;
#pragma unroll
          for (int i = 0; i < 12; ++i) s += x[i] * x[i];
          const float rn = 1.0f / sqrtf(wave_sum(s) * (1.0f / 768.0f) + LN_EPS); const float* nw = INP(IN_NANW) + L * 768 + F.lane * 12;
#pragma unroll
          for (int i = 0; i < 12; ++i) x[i] *= rn * nw[i];
          v2u o0, o1, o2; o0.x = pk2(x[0], x[1]); o0.y = pk2(x[2], x[3]); o1.x = pk2(x[4], x[5]); o1.y = pk2(x[6], x[7]); o2.x = pk2(x[8], x[9]); o2.y = pk2(x[10], x[11]);
          p[0] = o0; p[1] = o1; p[2] = o2; }
    }
}

__device__ __forceinline__ void p7_row(const Fr& F, int L, int row, f32x4 (&hv)[8]) {
    const int lane = F.lane;
    const bf16* Y = (const bf16*)(F.ws + WS_Y); bf16* X1 = (bf16*)(F.ws + WS_X1); bf16* H = (bf16*)(F.ws + WS_H);
    const float* lg = INP(IN_LN1G) + L * DM; const float* lb = INP(IN_LN1B) + L * DM;
    const float* mod = mod_ptr(F, L, row);
    const v2u* yr = (const v2u*)(Y + (size_t)row * DM) + lane;
    f32x4 v[8]; float s = 0.f;
#pragma unroll
    for (int j = 0; j < 8; ++j) { const f32x4 g1 = *((const f32x4*)(mod + 2 * DM) + lane + 64 * j); const v2u yw = yr[64 * j]; v[j] = load_x4(F, L, row, lane + 64 * j) * ALPHA + g1 * (f32x4){bflo(yw.x), bfhi(yw.x), bflo(yw.y), bfhi(yw.y)}; s += (v[j][0] + v[j][1]) + (v[j][2] + v[j][3]); }
    float mean = wave_sum(s) * (1.f / DM), s2 = 0.f;
#pragma unroll
    for (int j = 0; j < 8; ++j) { v[j] = v[j] - mean; s2 += (v[j][0] * v[j][0] + v[j][1] * v[j][1]) + (v[j][2] * v[j][2] + v[j][3] * v[j][3]); }
    float rstd = 1.f / sqrtf(wave_sum(s2) * (1.f / DM) + LN_EPS); s = 0.f;
#pragma unroll
    for (int j = 0; j < 8; ++j) { const f32x4 g = *((const f32x4*)lg + lane + 64 * j), bb = *((const f32x4*)lb + lane + 64 * j); v[j] = v[j] * rstd * g + bb;
        { v2u xw; xw.x = pk2(v[j][0], v[j][1]); xw.y = pk2(v[j][2], v[j][3]); *((v2u*)(X1 + (size_t)row * DM) + lane + 64 * j) = xw; } s += (v[j][0] + v[j][1]) + (v[j][2] + v[j][3]); }
    mean = wave_sum(s) * (1.f / DM); s2 = 0.f;
#pragma unroll
    for (int j = 0; j < 8; ++j) { v[j] = v[j] - mean; s2 += (v[j][0] * v[j][0] + v[j][1] * v[j][1]) + (v[j][2] * v[j][2] + v[j][3] * v[j][3]); }
    rstd = 1.f / sqrtf(wave_sum(s2) * (1.f / DM) + LN_EPS);
    v2u* o8 = (v2u*)(H + (size_t)row * DM) + lane;
#pragma unroll
    for (int j = 0; j < 8; ++j) { const f32x4 sh = *((const f32x4*)(mod + 3 * DM) + lane + 64 * j), sc = *((const f32x4*)(mod + 4 * DM) + lane + 64 * j);
        hv[j] = v[j] * rstd * (sc + 1.0f) + sh; v2u w; w.x = pk2(hv[j][0], hv[j][1]); w.y = pk2(hv[j][2], hv[j][3]); o8[64 * j] = w; }
}
__device__ __forceinline__ void p7_route(const Fr& F, int L, int row, const float (&a)[36], bool commit) {
    const float gl0 = a[0] + INP(IN_BRG)[L * 4 + 0], gl1 = a[1] + INP(IN_BRG)[L * 4 + 1], gl2 = a[2] + INP(IN_BRG)[L * 4 + 2], gl3 = a[3] + INP(IN_BRG)[L * 4 + 3];
    float gm = gl0; int g = 0;
    if (gl1 > gm) { gm = gl1; g = 1; }
    if (gl2 > gm) { gm = gl2; g = 2; }
    if (gl3 > gm) { gm = gl3; g = 3; }
    const float gs = __expf(gl0 - gm) + __expf(gl1 - gm) + __expf(gl2 - gm) + __expf(gl3 - gm);
    const float top_pg = 1.0f / gs;
    float le[8];
#pragma unroll
    for (int e = 0; e < 8; ++e) { const float c0 = a[4 + e], c1 = a[12 + e], c2 = a[20 + e], c3 = a[28 + e];
        const float x = (g == 0) ? c0 : (g == 1) ? c1 : (g == 2) ? c2 : c3; le[e] = x + INP(IN_BRE)[L * 32 + g * 8 + e]; }
    float v1 = -3.0e38f; int e1 = 0;
#pragma unroll
    for (int e = 0; e < 8; ++e) if (le[e] > v1) { v1 = le[e]; e1 = e; }
    float v2 = -3.0e38f; int e2 = 0;
#pragma unroll
    for (int e = 0; e < 8; ++e) if (e != e1 && le[e] > v2) { v2 = le[e]; e2 = e; }
    const float ex = __expf(v2 - v1), w1 = top_pg / (1.0f + ex), w2 = top_pg * ex / (1.0f + ex);
    if (commit) {
        unsigned* cnt = (unsigned*)(F.ctl + CW_CNT + L * 64); int* asg = (int*)(F.ws + WS_ASG) + (size_t)row * 8;
        const int ea = g * 8 + e1, eb = g * 8 + e2;
        const unsigned ra = atomicAdd(cnt + ea, 1u), rb = atomicAdd(cnt + eb, 1u);
        int* RLIST = (int*)(F.ws + WS_XG); float* GLIST = (float*)(F.ws + WS_XG + 2 * MiB);
        RLIST[ea * TTOT + (int)ra] = row; GLIST[ea * TTOT + (int)ra] = w1; RLIST[eb * TTOT + (int)rb] = row; GLIST[eb * TTOT + (int)rb] = w2;
        asg[0] = ea; asg[1] = (int)ra; asg[2] = __builtin_bit_cast(int, w1); asg[3] = 0;
        asg[4] = eb; asg[5] = (int)rb; asg[6] = __builtin_bit_cast(int, w2); asg[7] = 0;
    }
}
constexpr int RP = DM + 8;
__device__ __forceinline__ void p7_item(const Fr& F, int L, int item, bool commit) {
    const int lane = F.lane, tid = F.tid, w = F.wave, r16 = lane & 15, g = lane >> 4;
    LAS bf16* Ah = (LAS bf16*)F.lds; LAS bf16* Al = Ah + 16 * RP;
#pragma unroll 1
    for (int rr = 0; rr < 2; ++rr) { f32x4 hv[8]; p7_row(F, L, item * 16 + w * 2 + rr, hv);
#pragma unroll
        for (int j = 0; j < 8; ++j) { v2u hi, lo; float r[4];
#pragma unroll
            for (int i = 0; i < 4; ++i) r[i] = hv[j][i] - __builtin_bit_cast(float, f2bf(hv[j][i]) << 16);
            hi.x = pk2(hv[j][0], hv[j][1]); hi.y = pk2(hv[j][2], hv[j][3]); lo.x = pk2(r[0], r[1]); lo.y = pk2(r[2], r[3]);
            *(LAS v2u*)(Ah + (w * 2 + rr) * RP + lane * 4 + 256 * j) = hi; *(LAS v2u*)(Al + (w * 2 + rr) * RP + lane * 4 + 256 * j) = lo; } }
    __syncthreads();
    f32x4 acc[3];
#pragma unroll
    for (int nt = 0; nt < 3; ++nt) acc[nt] = (f32x4){0.f, 0.f, 0.f, 0.f};
    { const bf16* WRH = (const bf16*)(F.ws + WS_WRT) + ((size_t)L * 48 + r16) * DM + 256 * w + 8 * g; const bf16* WRL = (const bf16*)(F.ws + WS_WRT + 512 * 1024) + ((size_t)L * 48 + r16) * DM + 256 * w + 8 * g;
      const LAS bf16* ahp = Ah + r16 * RP + 256 * w + 8 * g; const LAS bf16* alp = Al + r16 * RP + 256 * w + 8 * g;
#pragma unroll
      for (int ks = 0; ks < 8; ++ks) { const bf16x8 ah = *(const LAS bf16x8*)(ahp + 32 * ks), al = *(const LAS bf16x8*)(alp + 32 * ks);
#pragma unroll
          for (int nt = 0; nt < 3; ++nt) { const bf16x8 bh = *(const bf16x8*)(WRH + (size_t)nt * 16 * DM + 32 * ks), bl = *(const bf16x8*)(WRL + (size_t)nt * 16 * DM + 32 * ks);
              acc[nt] = __builtin_amdgcn_mfma_f32_16x16x32_bf16(ah, bh, acc[nt], 0, 0, 0); acc[nt] = __builtin_amdgcn_mfma_f32_16x16x32_bf16(ah, bl, acc[nt], 0, 0, 0); acc[nt] = __builtin_amdgcn_mfma_f32_16x16x32_bf16(al, bh, acc[nt], 0, 0, 0); } } }
    __syncthreads();
    LAS float* Pp = (LAS float*)F.lds;
    LAS float* LG = Pp + 8 * 16 * 48;
#pragma unroll
    for (int nt = 0; nt < 3; ++nt)
#pragma unroll
        for (int e = 0; e < 4; ++e) Pp[(w * 16 + 4 * g + e) * 48 + nt * 16 + r16] = acc[nt][e];
    __syncthreads();
    for (int idx = tid; idx < 16 * 36; idx += NTHR) { const int row = idx / 36, o = idx - row * 36; float sum = 0.f;
#pragma unroll
        for (int ww = 0; ww < 8; ++ww) sum += Pp[(ww * 16 + row) * 48 + o];
        LG[idx] = sum; }
    __syncthreads();
    if (tid < 16) { float a[36];
#pragma unroll
        for (int o = 0; o < 36; ++o) a[o] = LG[tid * 36 + o];
        p7_route(F, L, item * 16 + tid, a, commit); }
    __syncthreads();
}

constexpr int MT_OFF = 0, MT_CNT = 33, MT_NT = 65, MT_TILE = 66;
__device__ __forceinline__ void moe_tables(const Fr& F, int L, LAS int* tab) {
    __syncthreads();
    if (F.tid < 64) { const int e = F.tid & 31; const unsigned* cnt = (unsigned*)(F.ctl + CW_CNT + L * 64);
        const int cn = (int)__hip_atomic_load(cnt + e, __ATOMIC_RELAXED, __HIP_MEMORY_SCOPE_AGENT), nt = (cn + 255) >> 8;
        int incl = nt;
#pragma unroll
        for (int o = 1; o < 32; o <<= 1) { const int u = __shfl_up(incl, o); if ((F.tid & 31) >= o) incl += u; }
        const int t0 = incl - nt;
        if (F.tid < 32) { tab[MT_OFF + e] = t0 * 256; tab[MT_CNT + e] = cn; for (int t = 0; t < nt; ++t) tab[MT_TILE + t0 + t] = e;
            if (e == 31) { tab[MT_OFF + 32] = incl * 256; tab[MT_NT] = incl; } } }
    __syncthreads();
}

__device__ __forceinline__ void p11_ln2(Fr F, int L, int nrows, float* outp) {
    RELAUNDER(F);
    const int gw = F.bid * NWAVES + F.wave, NGW = F.G * NWAVES, lane = F.lane;
    const bf16* X1 = (const bf16*)(F.ws + WS_X1); const bf16* DN = (const bf16*)(F.ws + WS_DN); const int* ASG = (const int*)(F.ws + WS_ASG);
    LAS int* tab = (LAS int*)(F.lds + LDSCTL_OFF + 128); moe_tables(F, L, tab);
    const float* lg = INP(IN_LN2G) + L * DM; const float* lb = INP(IN_LN2B) + L * DM;
    for (int row = gw; row < nrows; row += NGW) {
        const float* mod = mod_ptr(F, L, row); const int s0 = tab[MT_OFF + ASG[row * 8]] + ASG[row * 8 + 1], s1 = tab[MT_OFF + ASG[row * 8 + 4]] + ASG[row * 8 + 5];
        const v2u* xr = (const v2u*)(X1 + (size_t)row * DM) + lane; const v2u* d0 = (const v2u*)(DN + (size_t)s0 * DM) + lane; const v2u* d1 = (const v2u*)(DN + (size_t)s1 * DM) + lane;
        f32x4 v[8]; float s = 0.f;
#pragma unroll
        for (int j = 0; j < 8; ++j) { const f32x4 g2 = *((const f32x4*)(mod + 5 * DM) + lane + 64 * j); const v2u a = d0[64 * j], bq = d1[64 * j];
            const f32x4 f = (f32x4){bflo(a.x) + bflo(bq.x), bfhi(a.x) + bfhi(bq.x), bflo(a.y) + bflo(bq.y), bfhi(a.y) + bfhi(bq.y)};
            const v2u xw = xr[64 * j]; v[j] = (f32x4){bflo(xw.x), bfhi(xw.x), bflo(xw.y), bfhi(xw.y)} * ALPHA + g2 * f; s += (v[j][0] + v[j][1]) + (v[j][2] + v[j][3]); }
        const float mean = wave_sum(s) * (1.f / DM); float s2 = 0.f;
#pragma unroll
        for (int j = 0; j < 8; ++j) { v[j] = v[j] - mean; s2 += (v[j][0] * v[j][0] + v[j][1] * v[j][1]) + (v[j][2] * v[j][2] + v[j][3] * v[j][3]); }
        const float rstd = 1.f / sqrtf(wave_sum(s2) * (1.f / DM) + LN_EPS);
        float sn = 0.f;
#pragma unroll
        for (int j = 0; j < 8; ++j) { const f32x4 g = *((const f32x4*)lg + lane + 64 * j), bb = *((const f32x4*)lb + lane + 64 * j);
            v[j] = v[j] * rstd * g + bb; sn += (v[j][0] + v[j][1]) + (v[j][2] + v[j][3]);
            if (L == NLAYER - 1) *((f32x4*)(outp + (size_t)row * DM) + lane + 64 * j) = v[j];
            else { v2u xw; xw.x = pk2(v[j][0], v[j][1]); xw.y = pk2(v[j][2], v[j][3]); *((v2u*)((bf16*)(F.ws + WS_X2) + (size_t)row * DM) + lane + 64 * j) = xw; } }
        if (L + 1 < NLAYER) {
            const float* modn = mod_ptr(F, L + 1, row); const float mn = wave_sum(sn) * (1.f / DM); float s3 = 0.f;
#pragma unroll
            for (int j = 0; j < 8; ++j) { v[j] = v[j] - mn; s3 += (v[j][0] * v[j][0] + v[j][1] * v[j][1]) + (v[j][2] * v[j][2] + v[j][3] * v[j][3]); }
            const float rs = 1.f / sqrtf(wave_sum(s3) * (1.f / DM) + LN_EPS);
            v2u* o8 = (v2u*)((bf16*)(F.ws + WS_H) + (size_t)row * DM) + lane;
#pragma unroll
            for (int j = 0; j < 8; ++j) { const f32x4 sh = *((const f32x4*)(modn) + lane + 64 * j), sc = *((const f32x4*)(modn + DM) + lane + 64 * j);
                const f32x4 hh = v[j] * rs * (sc + 1.0f) + sh; v2u w; w.x = pk2(hh[0], hh[1]); w.y = pk2(hh[2], hh[3]); o8[64 * j] = w; }
        }
    }
}

constexpr int PH_PER_LAYER = 11, N_PHASES = 1 + NLAYER * PH_PER_LAYER;
struct Args { const float* in[33]; float* out; unsigned char* ws; int ph_lo, ph_hi, use_bar, pad; };
#ifndef PHMASK
#define PHMASK 0xFFFF
#endif
#define IN(k) (lo <= (k) && (k) < hi)
#define EN(j) ((PHMASK >> (j)) & 1)
#define SEAM(k) do { if (IN(k) && IN((k) + 1)) { xcd_barrier(bar); if ((REPMASK >> 14) & 1) xcd_barrier(bar); } } while (0)

#ifndef QUOTA_P2
#define QUOTA_P2 2
#define QUOTA_P6 1
#define QUOTA_P9 1
#define QUOTA_P10 0
#endif
template <int L> __device__ __forceinline__ void layer_phases(const Fr& F, const XcdBarrier& bar, const int lo, const int hi) {
        const int pb = 1 + L * PH_PER_LAYER;
        const int nrows = (L == 0) ? TTOT : TLAT;
        if (L == 0) { if (EN(1) && IN(pb + 0)) { p1_ln_mod(F, L); if ((REPMASK >> 6) & 1) p1_ln_mod(F, L); } SEAM(pb + 0); }
        if (EN(2) && IN(pb + 1)) {
            Fr Fp = F; RELAUNDER(Fp);
            pg8::Gemm g{(const pg8::bf16_t*)(Fp.ws + WS_H), (const pg8::bf16_t*)(Fp.ws + WS_WIN) + (size_t)L * INCP * DM, TTOT, INCP, DM};
            pg8::StaticOrder S; S.init(TTOT, INCP, Fp.G, Fp.bid);
            pg8::EpiBf16P E{(pg8::bf16_t*)(Fp.ws + WS_PROJ), INCP};
            for (int rep = 0; rep < 1 + (((REPMASK >> 5) | (REPMASK >> 16)) & 1); ++rep) pg8::gemm_phase<pg8::EpiBf16P, pg8::StaticOrder, true, true>(Fp.lds, g, S, E);
                    if (L == 0) { const int n_ = (TTOT / 256) * (INCP / 256), mx_ = (n_ + Fp.G - 1) / Fp.G, my_ = (Fp.bid < n_) ? (n_ - Fp.bid + Fp.G - 1) / Fp.G : 0; if (my_ < mx_) conv_bubble(Fp, QUOTA_P2); }
                    if (L == 1 && Fp.G == 256) { const int n_ = (TTOT / 256) * (INCP / 256), idle0 = n_ % Fp.G;
                        __syncthreads();
                        if (Fp.bid >= idle0 && Fp.bid - idle0 < 64) hy_filter_item(Fp, 1, SEQ, Fp.bid - idle0, (float*)(Fp.ws + WS_KF) + (size_t)HYC * 4096); }
        } SEAM(pb + 1);
        if (EN(3) && IN(pb + 2)) { p3_mixers1(F, L); } SEAM(pb + 2);
        if (EN(4) && IN(pb + 3)) { p4_gla_scan(F, L, bar); } SEAM(pb + 3);
        if (EN(5) && IN(pb + 4)) { p5_mixers2(F, L); if (L == 0) { __syncthreads(); conv_bubble(F, -1, I_OUT); } } SEAM(pb + 4);
        if (EN(6) && IN(pb + 5)) {
            Fr Fp = F; RELAUNDER(Fp);
            pg8::Gemm g{(const pg8::bf16_t*)(Fp.ws + WS_MIX), (const pg8::bf16_t*)(Fp.ws + WS_WOUT) + (size_t)L * DM * DM, nrows, DM, DM};
            pg8::StaticOrder S; S.init(nrows, DM, Fp.G, Fp.bid);
            pg8::EpiBf16P E{(pg8::bf16_t*)(Fp.ws + WS_Y), DM};
            for (int rep = 0; rep < 1 + (((REPMASK >> 5) | (REPMASK >> 17)) & 1); ++rep) pg8::gemm_phase<pg8::EpiBf16P, pg8::StaticOrder, true, true>(Fp.lds, g, S, E);
                    if (L == 0) { const int n_ = (nrows / 256) * (DM / 256), mx_ = (n_ + Fp.G - 1) / Fp.G, my_ = (Fp.bid < n_) ? (n_ - Fp.bid + Fp.G - 1) / Fp.G : 0;
                        if (Fp.G == 256) { const int r = Fp.bid - (n_ % Fp.G); mod_items(Fp, (r >= 0 && r < 128) ? 128 + r : NLAYER * 128, Fp.G, NLAYER * 128); }
                        if (my_ < mx_) conv_bubble(Fp, QUOTA_P6); }
        } SEAM(pb + 5);
        if (EN(7) && IN(pb + 6)) { Fr Fp = F; RELAUNDER(Fp); for (int rep = ((REPMASK >> 9) & 1) ? 0 : 1; rep < 2; ++rep) { _Pragma("unroll 1") for (int it = Fp.bid; it < nrows / 16; it += Fp.G) p7_item(Fp, L, it, rep == 1); } } SEAM(pb + 6);
        if (EN(9) && IN(pb + 8)) {
            Fr Fp = F; RELAUNDER(Fp);
            LAS int* tab = (LAS int*)(Fp.lds + LDSCTL_OFF + 128); moe_tables(Fp, L, tab); const int ntiles = __builtin_amdgcn_readfirstlane(tab[MT_NT]);
            const int NUP = ntiles * 4, NU = NUP + ntiles * 8;
            GAS unsigned* mq = Fp.ctl + CW_MQ + L * 64; GAS unsigned* done = Fp.ctl + CW_DONE + L * 1536;
            volatile LAS int* slot = (volatile LAS int*)(Fp.lds + LDSCTL_OFF + 96);
            const size_t ws_act = L ? WS_ACT1 : WS_ACT;
            pg8::EpiAct EU{(pg8::bf16_t*)(Fp.ws + ws_act), (const float*)(Fp.ws + WS_XG + 2 * MiB)};
            pg8::EpiDn ED{(pg8::bf16_t*)(Fp.ws + WS_DN)};
            pg8::MoeCtx MX{(const pg8::bf16_t*)(Fp.ws + WS_H), (const int*)(Fp.ws + WS_XG), INP(IN_WUP) + (size_t)L * NEXP * DM * 1024, INP(IN_WDN) + (size_t)L * NEXP * DEXP * DM, NUP, NU};
            pg8::f32x4 wv[8]; bool wpre = false;
            int Lc = Fp.bid;
            while (Lc < NU) {
                int nxt = 0, Ln = NU;
                if (Fp.tid == 0) nxt = Fp.G + (int)__hip_atomic_fetch_add(mq, 1u, __ATOMIC_RELAXED, __HIP_MEMORY_SCOPE_AGENT);
                if (Lc < NUP) {
                    const int t = Lc >> 2, j = Lc & 3;
                    pg8::moe_unit<true, pg8::EpiAct>(Fp.lds, MX.H, MX.rlist, MX.Wup, tab, t, j, EU, wv, wpre, MX, nxt, slot, Ln);
                    asm volatile("s_waitcnt vmcnt(0)" ::: "memory");
                    __syncthreads();
                    if (Fp.tid == 0) (void)__hip_atomic_fetch_add(done + t * 8, 1u, __ATOMIC_RELAXED, __HIP_MEMORY_SCOPE_AGENT);
                } else {
                    const int d = Lc - NUP, t = d >> 3, j = d & 7;
                    if (Fp.tid == 0) { unsigned sp = 0;
                        while (__hip_atomic_load(done + t * 8, __ATOMIC_RELAXED, __HIP_MEMORY_SCOPE_AGENT) < 4u) { __builtin_amdgcn_s_sleep(2); if (++sp > (1u << 18)) break; }
                        __builtin_amdgcn_fence(__ATOMIC_ACQUIRE, "agent");
                        asm volatile("s_waitcnt vmcnt(0)" ::: "memory"); }
                    __syncthreads();
                    pg8::moe_unit<false, pg8::EpiDn>(Fp.lds, (const pg8::bf16_t*)(Fp.ws + ws_act), nullptr, MX.Wdn, tab, t, j, ED, wv, wpre, MX, nxt, slot, Ln);
                }
                Lc = Ln;
            }
            if (L == 0) conv_bubble(Fp, QUOTA_P9);
        } SEAM(pb + 8);
        if (EN(11) && IN(pb + 10)) { p11_ln2(F, L, nrows, (L == NLAYER - 1) ? (float*)F.out : (float*)(F.ws + WS_X2)); if ((REPMASK >> 6) & 1) p11_ln2(F, L, nrows, (L == NLAYER - 1) ? (float*)F.out : (float*)(F.ws + WS_X2)); }
        if (L + 1 < NLAYER) { if (IN(pb + 10)) { __syncthreads(); conv_bubble(F, -1); } SEAM(pb + 10); }
    }
__global__ void __launch_bounds__(NTHR, 2) fwd_kernel(Args args) {
    extern __shared__ __attribute__((aligned(16))) unsigned char lds_raw[];
    Fr F;
    F.lds = (LAS unsigned char*)lds_raw;
    F.tid = threadIdx.x; F.lane = F.tid & 63; F.wave = __builtin_amdgcn_readfirstlane(F.tid >> 6);
    F.G = gridDim.x; F.bid = blockIdx.x;
    F.in = (const GAS float* const KAS*)__builtin_amdgcn_kernarg_segment_ptr();
    F.out = (GAS float*)args.out; F.ws = (GAS unsigned char*)args.ws; F.ctl = (GAS unsigned*)(args.ws + WS_CTL);
    for (int u = F.tid; u < (LDS_BYTES - LDSCTL_OFF) / 4; u += NTHR) ((LAS unsigned*)(F.lds + LDSCTL_OFF))[u] = 0u;
    __syncthreads();
    XcdBarrier bar; bar.bar = (unsigned*)(F.ctl + CW_BAR); bar.x = 0; bar.st = nullptr;
    if (args.use_bar) bar = xcd_barrier_post((unsigned*)(F.ctl + CW_BAR), (volatile LAS unsigned*)(F.lds + LDSCTL_OFF + 32));
    const int lo = args.ph_lo, hi = args.ph_hi;
    if (EN(0) && IN(0)) { p0_prologue(F); if ((REPMASK >> 3) & 1) { __syncthreads(); p0_prologue(F); } } SEAM(0);
    layer_phases<0>(F, bar, lo, hi);
    layer_phases<1>(F, bar, lo, hi);
#undef IN
#undef SEAM
}

#ifndef MK_ONE_LAUNCH
#define MK_ONE_LAUNCH 0
#endif
extern "C" void kernel_launch(void* const* d_in, const int* in_sizes, int n_in, void* d_out, int out_size, void* d_ws, size_t ws_size, hipStream_t stream) {
    static int grid = 0;
    if (grid == 0) {
        if (n_in != 33 || out_size != TLAT * DM || ws_size < WS_END) { fprintf(stderr, "kernel_launch: unexpected shapes: n_in %d out %d ws %zu (need %zu)\n", n_in, out_size, ws_size, (size_t)WS_END); grid = -1; return; }
        int dev = 0, cus = 0, per_cu = 0;
        if (hipGetDevice(&dev) != hipSuccess || hipDeviceGetAttribute(&cus, hipDeviceAttributeMultiprocessorCount, dev) != hipSuccess) { grid = -1; return; }
        if (hipFuncSetAttribute((const void*)fwd_kernel, hipFuncAttributeMaxDynamicSharedMemorySize, LDS_BYTES) != hipSuccess) { fprintf(stderr, "kernel_launch: hipFuncSetAttribute failed\n"); grid = -1; return; }
        if (hipOccupancyMaxActiveBlocksPerMultiprocessor(&per_cu, (const void*)fwd_kernel, NTHR, LDS_BYTES) != hipSuccess || per_cu < 1) fprintf(stderr, "kernel_launch: occupancy query says %d\n", per_cu);
        (void)hipGetLastError();
        grid = cus;
    }
    if (grid < 0) return;
    if (hipMemsetAsync((char*)d_ws + WS_CTL, 0, CTL_ZERO_BYTES, stream) != hipSuccess) return;
    Args a{};
    for (int i = 0; i < 33; ++i) a.in[i] = (const float*)d_in[i];
    a.out = (float*)d_out; a.ws = (unsigned char*)d_ws; a.pad = 0;
#if MK_ONE_LAUNCH
    a.ph_lo = 0; a.ph_hi = N_PHASES; a.use_bar = 1;
    hipLaunchKernelGGL(fwd_kernel, dim3(grid), dim3(NTHR), LDS_BYTES, stream, a);
    if ((REPMASK >> 15) & 1) {
        (void)hipMemsetAsync((char*)d_ws + WS_CTL, 0, CTL_ZERO_BYTES, stream);
        hipLaunchKernelGGL(fwd_kernel, dim3(grid), dim3(NTHR), LDS_BYTES, stream, a); }
#else
    for (int p = 0; p < N_PHASES; ++p) { a.ph_lo = p; a.ph_hi = p + 1; a.use_bar = 0;
        hipLaunchKernelGGL(fwd_kernel, dim3(grid), dim3(NTHR), LDS_BYTES, stream, a); }
#endif
}
```
